# Optimizing an MI355X kernel written in HIP

```python
import math
import jax
import jax.numpy as jnp
from jax import lax
import numpy as np

D_MODEL = 1024
BATCH = 16
SEQ = 2048
DEPTH = 2

GRID_W = 64
CTX_LEN = 256
N_EVEN = (DEPTH + 1) // 2
N_ODD = DEPTH // 2

A_WIDTH = D_MODEL // 2
DIFF_HEADS = 4
DIFF_DH = 64
DIFF_VDIM = 2 * DIFF_DH
DIFF_QK = DIFF_HEADS * 2 * DIFF_DH
B_WIDTH = DIFF_HEADS * DIFF_VDIM
EVEN_IN = 3 * A_WIDTH + 2 * DIFF_QK + B_WIDTH
EVEN_MIX = A_WIDTH + B_WIDTH

C_WIDTH = D_MODEL // 2
C_GROUPS = 4
C_GROUP_DIM = C_WIDTH // C_GROUPS
NA_HEADS = 8
NA_DH = 64
D_WIDTH = NA_HEADS * NA_DH
ODD_IN = C_WIDTH + 3 * D_WIDTH
ODD_MIX = C_WIDTH + D_WIDTH
NA_KR_MAX = 8
NA_KC = 16

D_FF = 2816
N_EXPERTS = 8
TOP_K = 2
D_FF_EXPERT = 3584

ROPE_THETA = 10000.0
LN_EPS = 1e-5
RMS_EPS = 1e-5
Q_BLOCK = 128
NEG_INF = -1e30
DEEPNORM_ALPHA = (2 * DEPTH) ** 0.25
DEEPNORM_BETA = (8 * DEPTH) ** -0.25

kernel_name = 'hybrid_diffusion_conv_diffattn_fnet_natten_moe'


def layer_norm(x, g, b):
    xf = x.astype(jnp.float32)
    mu = jnp.mean(xf, axis=-1, keepdims=True)
    var = jnp.mean(jnp.square(xf - mu), axis=-1, keepdims=True)
    return ((xf - mu) * lax.rsqrt(var + LN_EPS) * g + b).astype(x.dtype)


def adaln(cond, w_mod, b_mod):
    m = (jax.nn.silu(cond) @ w_mod + b_mod)[..., None, :]
    return jnp.split(m, 6, axis=-1)


def modulate(x, shift, scale):
    return x * (1 + scale) + shift


def short_conv3(u, w):
    up = jnp.pad(u, ((0, 0), (1, 1), (0, 0)))
    return up[:, :-2] * w[0] + up[:, 1:-1] * w[1] + up[:, 2:] * w[2]


def short_conv_mixer(pa, w_conv):
    bg, cg, val = jnp.split(pa, 3, axis=-1)
    return bg * short_conv3(cg * val, w_conv)


def axial_rope(n_tok, head_dim):
    t = jnp.arange(n_tok, dtype=jnp.int32)
    row = (t // GRID_W).astype(jnp.float32)
    col = (t % GRID_W).astype(jnp.float32)
    n_freq = head_dim // 4
    inv_freq = ROPE_THETA ** (-jnp.arange(n_freq, dtype=jnp.float32) / n_freq)
    ang = jnp.concatenate([row[:, None] * inv_freq, col[:, None] * inv_freq], axis=-1)
    return jnp.cos(ang), jnp.sin(ang)


def apply_rope(x, cos, sin):
    shape = (1, cos.shape[0]) + (1,) * (x.ndim - 3) + (cos.shape[1],)
    c = cos.reshape(shape)
    s = sin.reshape(shape)
    x1, x2 = jnp.split(x.astype(jnp.float32), 2, axis=-1)
    return jnp.concatenate([x1 * c - x2 * s, x1 * s + x2 * c], axis=-1).astype(x.dtype)


def diff_attend(q, k, v, lam):
    s = jnp.einsum('bqhcd,bkhcd->bhcqk', q, k, preferred_element_type=jnp.float32) * (DIFF_DH ** -0.5)
    p = jax.nn.softmax(s, axis=-1)
    a = p[:, :, 0] - lam * p[:, :, 1]
    return jnp.einsum('bhqk,bkhe->bqhe', a.astype(v.dtype), v, preferred_element_type=jnp.float32)


def diff_head_norm(o, g, lam_init, dtype):
    ms = jnp.mean(jnp.square(o), axis=-1, keepdims=True)
    return (o * lax.rsqrt(ms + RMS_EPS) * g * (1.0 - lam_init)).astype(dtype)


def diff_attention_latent(q, k_all, v_all, lam):
    b, l, h, _, dh = q.shape
    nb = l // Q_BLOCK
    qb = q.reshape(b, nb, Q_BLOCK, h, 2, dh).swapaxes(0, 1)
    ob = lax.map(lambda qi: diff_attend(qi, k_all, v_all, lam), qb)
    return ob.swapaxes(0, 1).reshape(b, l, h, DIFF_VDIM)


def even_mixer(h_lat, h_ctx, w_in, w_conv, lam, sub_g, lam_init, w_o, need_ctx):
    b, l, _ = h_lat.shape
    lc = h_ctx.shape[1]
    dt = h_lat.dtype
    a_end = 3 * A_WIDTH
    if need_ctx:
        pa_ctx, q_ctx, kv_ctx = jnp.split(h_ctx @ w_in, [a_end, a_end + DIFF_QK], axis=-1)
    else:
        kv_ctx = h_ctx @ w_in[:, a_end + DIFF_QK:]
    k_ctx, v_ctx = jnp.split(kv_ctx, [DIFF_QK], axis=-1)
    k_ctx = k_ctx.reshape(b, lc, DIFF_HEADS, 2, DIFF_DH)
    v_ctx = v_ctx.reshape(b, lc, DIFF_HEADS, DIFF_VDIM)
    pa, q, k, v = jnp.split(h_lat @ w_in, [a_end, a_end + DIFF_QK, a_end + 2 * DIFF_QK], axis=-1)
    cos, sin = axial_rope(l, DIFF_DH)
    q = apply_rope(q.reshape(b, l, DIFF_HEADS, 2, DIFF_DH), cos, sin)
    k = apply_rope(k.reshape(b, l, DIFF_HEADS, 2, DIFF_DH), cos, sin)
    v = v.reshape(b, l, DIFF_HEADS, DIFF_VDIM)
    k_all = jnp.concatenate([k_ctx, k], axis=1)
    v_all = jnp.concatenate([v_ctx, v], axis=1)
    o = diff_attention_latent(q, k_all, v_all, lam)
    o = diff_head_norm(o, sub_g, lam_init, dt).reshape(b, l, B_WIDTH)
    y_lat = jnp.concatenate([short_conv_mixer(pa, w_conv), o], axis=-1) @ w_o
    y_ctx = None
    if need_ctx:
        o_c = diff_attend(q_ctx.reshape(b, lc, DIFF_HEADS, 2, DIFF_DH), k_ctx, v_ctx, lam)
        o_c = diff_head_norm(o_c, sub_g, lam_init, dt).reshape(b, lc, B_WIDTH)
        y_ctx = jnp.concatenate([short_conv_mixer(pa_ctx, w_conv), o_c], axis=-1) @ w_o
    return y_lat, y_ctx


def fourier_mix(u):
    b, l, _ = u.shape
    g = u.astype(jnp.float32).reshape(b, l, C_GROUPS, C_GROUP_DIM)
    mu = jnp.mean(g, axis=-1, keepdims=True)
    var = jnp.mean(jnp.square(g - mu), axis=-1, keepdims=True)
    g = (g - mu) * lax.rsqrt(var + LN_EPS)
    f = jnp.real(jnp.fft.fft2(g, axes=(1, 3), norm='ortho'))
    return f.reshape(b, l, C_WIDTH).astype(u.dtype)


def neighbourhood_attention(q, k, v, k_ctx, v_ctx, rpb):
    b, l, _ = q.shape
    rows = l // GRID_W
    kr = min(NA_KR_MAX, rows)
    h, dh = NA_HEADS, NA_DH
    scale = dh ** -0.5
    qg = q.reshape(b, rows, GRID_W, h, dh)
    kg = k.reshape(b, rows, GRID_W, h, dh)
    vg = v.reshape(b, rows, GRID_W, h, dh)
    cols = jnp.arange(GRID_W)
    col_start = jnp.clip(cols - NA_KC // 2, 0, GRID_W - NA_KC)
    col_valid = (cols[None, :] >= col_start[:, None]) & (cols[None, :] < col_start[:, None] + NA_KC)
    dc_idx = jnp.clip(cols[None, :] - cols[:, None] + NA_KC - 1, 0, 2 * NA_KC - 2)
    rpb_c = rpb[:, :, dc_idx].astype(jnp.float32)

    def row_fn(r):
        rs = jnp.clip(r - kr // 2, 0, rows - kr)
        q_r = lax.dynamic_index_in_dim(qg, r, axis=1, keepdims=False)
        k_r = lax.dynamic_slice_in_dim(kg, rs, kr, axis=1)
        v_r = lax.dynamic_slice_in_dim(vg, rs, kr, axis=1)
        dr_idx = rs + jnp.arange(kr) - r + NA_KR_MAX - 1
        bias = jnp.take(rpb_c, dr_idx, axis=1).transpose(0, 2, 1, 3)
        s_loc = jnp.einsum('bqhd,bjkhd->bhqjk', q_r, k_r, preferred_element_type=jnp.float32) * scale
        s_loc = jnp.where(col_valid[:, None, :], s_loc + bias[None], NEG_INF)
        s_ctx = jnp.einsum('bqhd,bkhd->bhqk', q_r, k_ctx, preferred_element_type=jnp.float32) * scale
        s = jnp.concatenate([s_loc.reshape(b, h, GRID_W, kr * GRID_W), s_ctx], axis=-1)
        p = jax.nn.softmax(s, axis=-1).astype(v.dtype)
        p_loc = p[..., :kr * GRID_W].reshape(b, h, GRID_W, kr, GRID_W)
        p_ctx = p[..., kr * GRID_W:]
        return (jnp.einsum('bhqjk,bjkhd->bqhd', p_loc, v_r, preferred_element_type=jnp.float32)
                + jnp.einsum('bhqk,bkhd->bqhd', p_ctx, v_ctx, preferred_element_type=jnp.float32))

    o = lax.map(row_fn, jnp.arange(rows))
    return o.transpose(1, 0, 2, 3, 4).reshape(b, l, h * dh).astype(q.dtype)


def odd_mixer(h_lat, h_ctx, w_in, rpb, w_o, need_ctx):
    b, l, _ = h_lat.shape
    lc = h_ctx.shape[1]
    if need_ctx:
        pc_ctx, q_ctx, kv_ctx = jnp.split(h_ctx @ w_in, [C_WIDTH, C_WIDTH + D_WIDTH], axis=-1)
    else:
        kv_ctx = h_ctx @ w_in[:, C_WIDTH + D_WIDTH:]
    k_ctx, v_ctx = jnp.split(kv_ctx, [D_WIDTH], axis=-1)
    k_ctx = k_ctx.reshape(b, lc, NA_HEADS, NA_DH)
    v_ctx = v_ctx.reshape(b, lc, NA_HEADS, NA_DH)
    pc, q, k, v = jnp.split(h_lat @ w_in, [C_WIDTH, C_WIDTH + D_WIDTH, C_WIDTH + 2 * D_WIDTH], axis=-1)
    o = neighbourhood_attention(q, k, v, k_ctx, v_ctx, rpb)
    y_lat = jnp.concatenate([fourier_mix(pc), o], axis=-1) @ w_o
    y_ctx = None
    if need_ctx:
        qc = q_ctx.reshape(b, lc, NA_HEADS, NA_DH)
        s = jnp.einsum('bqhd,bkhd->bhqk', qc, k_ctx, preferred_element_type=jnp.float32) * (NA_DH ** -0.5)
        p = jax.nn.softmax(s, axis=-1).astype(v_ctx.dtype)
        o_c = jnp.einsum('bhqk,bkhd->bqhd', p, v_ctx).reshape(b, lc, D_WIDTH)
        y_ctx = jnp.concatenate([fourier_mix(pc_ctx), o_c], axis=-1) @ w_o
    return y_lat, y_ctx


def swiglu(h, w_gate, w_up, w_down):
    return (jax.nn.silu(h @ w_gate) * (h @ w_up)) @ w_down


def moe_swiglu(h, w_router, w_gate, w_up, w_down):
    logits = jnp.einsum('bld,de->ble', h, w_router, preferred_element_type=jnp.float32)
    top_v, top_i = lax.top_k(logits, TOP_K)
    top_p = jax.nn.softmax(top_v, axis=-1)
    gates = jnp.sum(jax.nn.one_hot(top_i, N_EXPERTS, dtype=jnp.float32) * top_p[..., None], axis=-2).astype(h.dtype)
    out = jnp.zeros_like(h)
    for e in range(N_EXPERTS):
        out = out + gates[..., e:e + 1] * swiglu(h, w_gate[e], w_up[e], w_down[e])
    return out


def setup_inputs(seed: int = 0) -> dict:
    key = jax.random.key(seed)
    ks = jax.random.split(key, 32)
    d = D_MODEL
    beta = DEEPNORM_BETA

    def nrm(k, shape, scale):
        return jax.random.normal(k, shape, jnp.float32) * scale

    return {
        'x': nrm(ks[0], (BATCH, SEQ, d), 1.0),
        'c': nrm(ks[1], (BATCH, d), 1.0),
        'ctx': nrm(ks[2], (BATCH, CTX_LEN, d), 1.0),
        'c_ctx': nrm(ks[3], (d,), 1.0),
        'w_mod': nrm(ks[4], (DEPTH, d, 6 * d), d ** -0.5),
        'b_mod': nrm(ks[5], (DEPTH, 6 * d), 0.02),
        'ln_g': 1.0 + nrm(ks[6], (DEPTH, 2, d), 0.02),
        'ln_b': nrm(ks[7], (DEPTH, 2, d), 0.02),
        'e_w_in': nrm(ks[8], (N_EVEN, d, EVEN_IN), d ** -0.5),
        'e_conv': nrm(ks[9], (N_EVEN, 3, A_WIDTH), 3 ** -0.5),
        'e_lam_q1': nrm(ks[10], (N_EVEN, DIFF_DH), 0.1),
        'e_lam_k1': nrm(ks[11], (N_EVEN, DIFF_DH), 0.1),
        'e_lam_q2': nrm(ks[12], (N_EVEN, DIFF_DH), 0.1),
        'e_lam_k2': nrm(ks[13], (N_EVEN, DIFF_DH), 0.1),
        'e_subln_g': 1.0 + nrm(ks[14], (N_EVEN, DIFF_VDIM), 0.02),
        'e_w_o': nrm(ks[15], (N_EVEN, EVEN_MIX, d), beta * EVEN_MIX ** -0.5),
        'e_ffn_gate': nrm(ks[16], (N_EVEN, d, D_FF), d ** -0.5),
        'e_ffn_up': nrm(ks[17], (N_EVEN, d, D_FF), d ** -0.5),
        'e_ffn_down': nrm(ks[18], (N_EVEN, D_FF, d), beta * D_FF ** -0.5),
        'o_w_in': nrm(ks[19], (N_ODD, d, ODD_IN), d ** -0.5),
        'o_rpb': nrm(ks[20], (N_ODD, NA_HEADS, 2 * NA_KR_MAX - 1, 2 * NA_KC - 1), 0.1),
        'o_w_o': nrm(ks[21], (N_ODD, ODD_MIX, d), beta * ODD_MIX ** -0.5),
        'o_router': nrm(ks[22], (N_ODD, d, N_EXPERTS), d ** -0.5),
        'o_exp_gate': nrm(ks[23], (N_ODD, N_EXPERTS, d, D_FF_EXPERT), d ** -0.5),
        'o_exp_up': nrm(ks[24], (N_ODD, N_EXPERTS, d, D_FF_EXPERT), d ** -0.5),
        'o_exp_down': nrm(ks[25], (N_ODD, N_EXPERTS, D_FF_EXPERT, d), beta * D_FF_EXPERT ** -0.5),
    }


def reference(x, c, ctx, c_ctx, w_mod, b_mod, ln_g, ln_b,
              e_w_in, e_conv, e_lam_q1, e_lam_k1, e_lam_q2, e_lam_k2, e_subln_g, e_w_o,
              e_ffn_gate, e_ffn_up, e_ffn_down,
              o_w_in, o_rpb, o_w_o, o_router, o_exp_gate, o_exp_up, o_exp_down):
    alpha = DEEPNORM_ALPHA
    x_lat, x_ctx = x, ctx
    for i in range(DEPTH):
        j = i // 2
        even = i % 2 == 0
        need_ctx = i < DEPTH - 1
        sh1, sc1, g1, sh2, sc2, g2 = adaln(c, w_mod[i], b_mod[i])
        csh1, csc1, cg1, csh2, csc2, cg2 = adaln(c_ctx, w_mod[i], b_mod[i])

        h_lat = modulate(x_lat, sh1, sc1)
        h_ctx = modulate(x_ctx, csh1, csc1)
        if even:
            lam_init = 0.8 - 0.6 * math.exp(-0.3 * i)
            f32 = jnp.float32
            lam = (jnp.exp(jnp.sum(e_lam_q1[j].astype(f32) * e_lam_k1[j].astype(f32)))
                   - jnp.exp(jnp.sum(e_lam_q2[j].astype(f32) * e_lam_k2[j].astype(f32))) + lam_init)
            y_lat, y_ctx = even_mixer(h_lat, h_ctx, e_w_in[j], e_conv[j], lam, e_subln_g[j], lam_init,
                                      e_w_o[j], need_ctx)
        else:
            y_lat, y_ctx = odd_mixer(h_lat, h_ctx, o_w_in[j], o_rpb[j], o_w_o[j], need_ctx)
        x_lat = layer_norm(alpha * x_lat + g1 * y_lat, ln_g[i, 0], ln_b[i, 0])

        h_lat = modulate(x_lat, sh2, sc2)
        if even:
            f_lat = swiglu(h_lat, e_ffn_gate[j], e_ffn_up[j], e_ffn_down[j])
        else:
            f_lat = moe_swiglu(h_lat, o_router[j], o_exp_gate[j], o_exp_up[j], o_exp_down[j])
        x_lat = layer_norm(alpha * x_lat + g2 * f_lat, ln_g[i, 1], ln_b[i, 1])

        if need_ctx:
            x_ctx = layer_norm(alpha * x_ctx + cg1 * y_ctx, ln_g[i, 0], ln_b[i, 0])
            h_ctx = modulate(x_ctx, csh2, csc2)
            if even:
                f_ctx = swiglu(h_ctx, e_ffn_gate[j], e_ffn_up[j], e_ffn_down[j])
            else:
                f_ctx = moe_swiglu(h_ctx, o_router[j], o_exp_gate[j], o_exp_up[j], o_exp_down[j])
            x_ctx = layer_norm(alpha * x_ctx + cg2 * f_ctx, ln_g[i, 1], ln_b[i, 1])
    return x_lat
```

```cpp
#include <hip/hip_runtime.h>
#include <cstdio>
#include <cstdint>

#ifndef MK_LAUNCH_PER_PHASE
#define MK_LAUNCH_PER_PHASE 0
#endif

#define GAS __attribute__((address_space(1)))
#define LAS __attribute__((address_space(3)))
typedef unsigned short bf16;
typedef short bf16x8 __attribute__((ext_vector_type(8)));
typedef short s16x4 __attribute__((ext_vector_type(4)));
typedef float f32x4 __attribute__((ext_vector_type(4)));
typedef float f32x16 __attribute__((ext_vector_type(16)));
typedef unsigned u32x4 __attribute__((ext_vector_type(4)));
typedef unsigned u32x2 __attribute__((ext_vector_type(2)));

constexpr int NB = 16, SEQ = 2048, DM = 1024, LC = 256, GW = 64;
constexpr int ML = NB * SEQ;
constexpr int MC = NB * LC;
constexpr int MT = ML + MC;
constexpr int E_IN = 3072, FF = 2816, O_IN = 2048, NEXP = 8, FFE = 3584;
constexpr int NCOND = 17;
constexpr float LN_EPS = 1e-5f, RMS_EPS = 1e-5f;
constexpr float ALPHA = 1.41421356237309515f;
constexpr int MOE_CH = 66, MOE_NCH = 4;

constexpr size_t MiB = 1u << 20;
constexpr size_t WS_CTL = 0, CTL_ZERO_BYTES = 2 * MiB;
constexpr size_t WS_MODS = 2 * MiB;
constexpr size_t WS_ROPE = 3 * MiB;
constexpr size_t WS_TOK  = 4 * MiB;
constexpr size_t WS_LIST = 5 * MiB;
constexpr size_t WS_GN   = 6 * MiB;
constexpr size_t WS_MISC = 7 * MiB;
constexpr size_t WS_WEIN = 8 * MiB;
constexpr size_t WS_WEO  = 14 * MiB;
constexpr size_t WS_WGU  = 16 * MiB;
constexpr size_t WS_WDN  = 27 * MiB;
constexpr size_t WS_WOIN = 33 * MiB;
constexpr size_t WS_WOO  = 37 * MiB;
constexpr size_t WS_DFTC = 39 * MiB;
constexpr size_t WS_DFTL = 40 * MiB;
constexpr size_t WS_XC   = 56 * MiB;
constexpr size_t WS_H    = 72 * MiB;
constexpr size_t WS_CAT  = 144 * MiB;
constexpr size_t WS_Y    = 216 * MiB;
constexpr size_t WS_YS   = 144 * MiB;
constexpr size_t WS_BIG  = 288 * MiB;
constexpr size_t WS_EWGU = WS_BIG + 116 * MiB;
constexpr size_t WS_EWDN = WS_EWGU + 112 * MiB;
constexpr size_t WS_END  = WS_EWDN + 56 * MiB;
static_assert(WS_END <= 589 * MiB, "workspace");
static_assert((size_t)MOE_CH * 256 * FFE * 2 <= 116 * MiB, "HID2 chunk");

constexpr int CW_BAR = 4096;
constexpr int CW_CNT = 64;
constexpr int NWAVES = 8;
constexpr int RING_BYTES = 131072;
constexpr int MISC_OFF = RING_BYTES + 320;
constexpr int LDS_BYTES = 147456;

__device__ __forceinline__ unsigned f2bf(float f) { unsigned u = __builtin_bit_cast(unsigned, f); return (u + 0x7fffu + ((u >> 16) & 1u)) >> 16; }
__device__ __forceinline__ unsigned pk2(float lo, float hi) { return f2bf(lo) | (f2bf(hi) << 16); }
__device__ __forceinline__ unsigned cvt_pk_bf16(float lo, float hi) { unsigned r; asm volatile("v_cvt_pk_bf16_f32 %0, %1, %2" : "=v"(r) : "v"(lo), "v"(hi)); return r; }
__device__ __forceinline__ float bf_lo(unsigned w) { return __builtin_bit_cast(float, w << 16); }
__device__ __forceinline__ float bf_hi(unsigned w) { return __builtin_bit_cast(float, w & 0xffff0000u); }
__device__ __forceinline__ float wave_sum(float v) {
#pragma unroll
    for (int o = 1; o < 64; o <<= 1) v += __shfl_xor(v, o);
    return v;
}
__device__ __forceinline__ float silu_f(float g) { return g / (1.f + __expf(-g)); }

#define XB_TMO      128
#define XB_XCNT(j)  (256  + 64 * (j))
#define XB_XSUB(j)  (1280 + 64 * (j))
#define XB_XGEN(j)  (2304 + 64 * (j))
#define XB_TOP      3328
#define XB_TOPGEN   3392
#define XCD_BAR_WORDS 3456
#define XB_SPIN_CAP (1u << 18)
__device__ __forceinline__ unsigned xb_ld(unsigned* p)              { return __hip_atomic_load(p, __ATOMIC_RELAXED, __HIP_MEMORY_SCOPE_AGENT); }
__device__ __forceinline__ unsigned xb_add(unsigned* p, unsigned v) { return __hip_atomic_fetch_add(p, v, __ATOMIC_RELAXED, __HIP_MEMORY_SCOPE_AGENT); }
__device__ __forceinline__ unsigned xb_xcc_id() { return (unsigned)__builtin_amdgcn_s_getreg((3 << 11) | 20) & 0xFu; }
#define XB_SPIN(cond, bar) do { unsigned _sp = 0; while (cond) { __builtin_amdgcn_s_sleep(1); \
    if ((++_sp & 255u) == 0u) { if (xb_ld(&(bar)[XB_TMO])) break; if (_sp > XB_SPIN_CAP) { atomicAdd(&(bar)[XB_TMO], 1u); break; } } } } while (0)
struct XcdBarrier { unsigned* bar; unsigned x; volatile LAS unsigned* st; };
__device__ __forceinline__ XcdBarrier xcd_barrier_post(unsigned* bar, volatile LAS unsigned* st) {
    XcdBarrier b; b.bar = bar; b.x = xb_xcc_id(); b.st = st;
    if (threadIdx.x == 0) (void)xb_add(&bar[XB_XCNT(b.x)], 1u);
    return b;
}
__device__ __forceinline__ void xcd_barrier_complete(unsigned* bar, unsigned x, unsigned& nloc, unsigned& nx) {
    const unsigned G = gridDim.x * gridDim.y * gridDim.z;
    unsigned sum, cnt, mine, sp = 0u;
    for (;;) {
        sum = 0u; cnt = 0u; mine = 0u;
#pragma unroll
        for (unsigned j = 0; j < 16; ++j) { const unsigned c = xb_ld(&bar[XB_XCNT(j)]); sum += c; cnt += (c > 0u) ? 1u : 0u; mine = (j == x) ? c : mine; }
        if (sum == G) break;
        __builtin_amdgcn_s_sleep(1);
        if ((++sp & 255u) == 0u) { if (xb_ld(&bar[XB_TMO])) break; if (sp > XB_SPIN_CAP) { atomicAdd(&bar[XB_TMO], 1u); break; } }
    }
    nloc = mine > 0u ? mine : 1u; nx = cnt > 0u ? cnt : 1u;
}
__device__ __forceinline__ void xcd_barrier(const XcdBarrier& b) {
    asm volatile("s_waitcnt vmcnt(0)" ::: "memory");
    __syncthreads();
    if (threadIdx.x == 0) {
        unsigned* bar = b.bar;
        __builtin_amdgcn_s_waitcnt(0);
        unsigned nloc = b.st[0], nx = b.st[1];
        if (nloc == 0u) { xcd_barrier_complete(bar, b.x, nloc, nx); b.st[0] = nloc; b.st[1] = nx; }
        const unsigned old = xb_add(&bar[XB_XSUB(b.x)], 1u);
        const unsigned gen = old / nloc;
        if (old + 1u == (gen + 1u) * nloc) {
            __builtin_amdgcn_fence(__ATOMIC_RELEASE, "agent");
            asm volatile("s_waitcnt vmcnt(0)" ::: "memory");
            const unsigned og = xb_add(&bar[XB_TOP], 1u);
            const unsigned tg = og / nx;
            if (og + 1u == (tg + 1u) * nx) xb_add(&bar[XB_TOPGEN], 1u);
            else XB_SPIN(xb_ld(&bar[XB_TOPGEN]) == tg, bar);
            __builtin_amdgcn_fence(__ATOMIC_ACQUIRE, "agent");
            xb_add(&bar[XB_XGEN(b.x)], 1u);
            asm volatile("s_waitcnt vmcnt(0)" ::: "memory");
        } else {
            XB_SPIN(xb_ld(&bar[XB_XGEN(b.x)]) == gen, bar);
            __builtin_amdgcn_fence(__ATOMIC_ACQUIRE, "agent");
            asm volatile("s_waitcnt vmcnt(0)" ::: "memory");
        }
    }
    __syncthreads();
}

namespace pg8 {
constexpr int BM = 256, BK = 64, HALF = 128, HTB = HALF * BK * 2, STAGE_BYTES = 8 * HTB, NXCD = 8, WGM = 8;
__host__ __device__ __forceinline__ int lds_byte(int r, int c) { const int st = (r >> 4) * 2 + (c >> 5), rr = r & 15, cc = c & 31, ob = rr * 64 + cc * 2; return st * 1024 + (ob ^ (((ob >> 9) & 1) << 5)); }
__host__ __device__ __forceinline__ void stage_rc(int b, int& R, int& C) { const int st = b / 1024, sb = b % 1024, swz = sb ^ (((sb >> 9) & 1) << 5); R = (st >> 1) * 16 + swz / 64; C = (st & 1) * 32 + (swz % 64) / 2; }
__host__ __device__ __forceinline__ int perm32(int rho) { const int n = rho >> 4, i = rho & 15; return 8 * (i >> 2) + 4 * n + (i & 3); }

struct Unit { int pm, pn; int orow0, ocol0; unsigned long long bofs; int aux; };
struct Gemm { const bf16* A; const bf16* Bt; int lda, ldb, K; };

template <class Epi, class Sched>
__device__ __forceinline__ void gemm_phase(LAS unsigned char* lds, const Gemm g, const Sched& S, const Epi& E) {
    const int tid = threadIdx.x, wid = __builtin_amdgcn_readfirstlane(tid >> 6), lane = tid & 63, wr = wid >> 2, wc = wid & 3, fr = lane & 15, fq = lane >> 4;
    const int K = g.K, nt = K / BK;
    int Rr[2]; unsigned Cb[2], voffB[2];
#pragma unroll
    for (int i = 0; i < 2; ++i) { int R, C; stage_rc(tid * 16 + i * 8192, R, C); const int Rb = (R & ~31) + perm32(R & 31);
        Rr[i] = R; Cb[i] = (unsigned)C * 2u; voffB[i] = (unsigned)(Rb * g.ldb + C) * 2u; }
    const size_t kstep = (size_t)(BK * 2);
    const size_t hstepB = (size_t)HALF * g.ldb * 2;
    const unsigned lda2 = (unsigned)g.lda * 2u;
    const unsigned ldsw = (unsigned)wid * 1024u;
    const int aoff = lds_byte(wr * 64 + fr, fq * 8), boff = lds_byte(wc * 32 + fr, fq * 8);
#define PG8_SA(b, h) (((b) * 2 + (h)) * HTB)
#define PG8_SB(b, h) ((4 + (b) * 2 + (h)) * HTB)
#define PG8_STAGE(bufoff, gbase, voff) do { _Pragma("unroll") for (int _i = 0; _i < 2; ++_i) \
        __builtin_amdgcn_global_load_lds((const unsigned*)((const char*)(gbase) + (voff)[_i]), (LAS unsigned*)(lds + (bufoff) + ldsw + _i * 8192), 16, 0, 0); } while (0)
#define PG8_LDA(dst, b, h) do { _Pragma("unroll") for (int m = 0; m < 4; ++m) _Pragma("unroll") for (int k = 0; k < 2; ++k) dst[m][k] = *(const LAS bf16x8*)(lds + PG8_SA(b, h) + aoff + m * 2048 + k * 1024); } while (0)
#define PG8_LDB(dst, b, h) do { _Pragma("unroll") for (int n = 0; n < 2; ++n) _Pragma("unroll") for (int k = 0; k < 2; ++k) dst[n][k] = *(const LAS bf16x8*)(lds + PG8_SB(b, h) + boff + n * 2048 + k * 1024); } while (0)
#define PG8_MMA(ai, bj, At, Bt) do { __builtin_amdgcn_s_setprio(1); _Pragma("unroll") for (int m = 0; m < 4; ++m) _Pragma("unroll") for (int n = 0; n < 2; ++n) _Pragma("unroll") for (int k = 0; k < 2; ++k) \
        acc[ai][bj][m][n] = __builtin_amdgcn_mfma_f32_16x16x32_bf16(Bt[n][k], At[m][k], acc[ai][bj][m][n], 0, 0, 0); __builtin_amdgcn_s_setprio(0); } while (0)
#define PG8_WAIT_V(n) asm volatile("s_waitcnt vmcnt(" #n ")" ::: "memory")
#define PG8_WAIT_L(n) asm volatile("s_waitcnt lgkmcnt(" #n ")" ::: "memory")
#define PG8_BAR __builtin_amdgcn_s_barrier()
#define PG8_SCHED __builtin_amdgcn_sched_barrier(0)
#define PG8_AOFF(dst, u) do { _Pragma("unroll") for (int _h = 0; _h < 2; ++_h) _Pragma("unroll") for (int _i = 0; _i < 2; ++_i) \
        dst[_h][_i] = (unsigned)S.arow(u, _h * HALF + Rr[_i]) * lda2 + Cb[_i]; } while (0)
    Unit cur, nxt; int ui = 0;
    if (!S.next(0, cur)) return;
    f32x4 acc[2][2][4][2];
#pragma unroll
    for (int a = 0; a < 2; ++a)
#pragma unroll
        for (int b = 0; b < 2; ++b)
#pragma unroll
            for (int m = 0; m < 4; ++m)
#pragma unroll
                for (int n = 0; n < 2; ++n) acc[a][b][m][n] = (f32x4){0.f, 0.f, 0.f, 0.f};
    bf16x8 At[4][2], B0[2][2], B1[2][2];
    unsigned aoc[2][2], aon[2][2];
    PG8_AOFF(aoc, cur);
    const char* const Ab = (const char*)g.A;
    const char* cB = (const char*)g.Bt + cur.bofs;
    PG8_STAGE(PG8_SB(0, 0), cB, voffB); PG8_STAGE(PG8_SB(0, 1), cB + hstepB, voffB); PG8_STAGE(PG8_SA(0, 0), Ab, aoc[0]); PG8_STAGE(PG8_SA(0, 1), Ab, aoc[1]);
    if (wr == 1) PG8_BAR;
    PG8_WAIT_V(2); PG8_BAR;
    PG8_STAGE(PG8_SB(1, 0), cB + kstep, voffB); PG8_STAGE(PG8_SA(1, 0), Ab + kstep, aoc[0]); PG8_STAGE(PG8_SB(1, 1), cB + hstepB + kstep, voffB);
    PG8_WAIT_V(6); PG8_BAR;
    for (;;) {
        const bool has_next = S.next(ui + 1, nxt);
        const char* nB = has_next ? (const char*)g.Bt + nxt.bofs : cB;
        if (has_next) { PG8_AOFF(aon, nxt); } else {
#pragma unroll
            for (int h = 0; h < 2; ++h)
#pragma unroll
                for (int i = 0; i < 2; ++i) aon[h][i] = aoc[h][i]; }
#pragma unroll 1
        for (int t = 0; t < nt; t += 2) {
            const bool last = (t == nt - 2);
            const char* a1 = Ab + (size_t)(t + 1) * kstep;
            const char* a2 = last ? Ab : Ab + (size_t)(t + 2) * kstep; const char* b2 = last ? nB : cB + (size_t)(t + 2) * kstep;
            const char* a3 = a2 + kstep; const char* b3 = b2 + kstep;
            unsigned ao2[2][2];
#pragma unroll
            for (int h = 0; h < 2; ++h)
#pragma unroll
                for (int i = 0; i < 2; ++i) ao2[h][i] = last ? aon[h][i] : aoc[h][i];
            PG8_LDB(B0, 0, 0); PG8_LDB(B1, 0, 1); PG8_SCHED; PG8_LDA(At, 0, 0); PG8_STAGE(PG8_SA(1, 1), a1, aoc[1]);
            PG8_WAIT_V(8); PG8_WAIT_L(0); PG8_BAR; PG8_MMA(0, 0, At, B0); PG8_MMA(0, 1, At, B1); PG8_BAR; PG8_SCHED;
            PG8_LDA(At, 0, 1); PG8_STAGE(PG8_SB(0, 0), b2, voffB); PG8_STAGE(PG8_SB(0, 1), b2 + hstepB, voffB); PG8_STAGE(PG8_SA(0, 0), a2, ao2[0]);
            PG8_WAIT_V(8); PG8_WAIT_L(0); PG8_BAR; PG8_MMA(1, 0, At, B0); PG8_MMA(1, 1, At, B1); PG8_BAR; PG8_SCHED;
            PG8_LDB(B0, 1, 0); PG8_LDB(B1, 1, 1); PG8_SCHED; PG8_LDA(At, 1, 0); PG8_STAGE(PG8_SA(0, 1), a2, ao2[1]);
            PG8_WAIT_V(8); PG8_WAIT_L(0); PG8_BAR; PG8_MMA(0, 0, At, B0); PG8_MMA(0, 1, At, B1); PG8_BAR; PG8_SCHED;
            PG8_LDA(At, 1, 1); PG8_STAGE(PG8_SB(1, 0), b3, voffB); PG8_STAGE(PG8_SB(1, 1), b3 + hstepB, voffB); PG8_STAGE(PG8_SA(1, 0), a3, ao2[0]);
            PG8_WAIT_V(8); PG8_WAIT_L(0); PG8_BAR; PG8_MMA(1, 0, At, B0); PG8_MMA(1, 1, At, B1); PG8_BAR; PG8_SCHED;
        }
        if (wr == 0) PG8_BAR;
        E(acc, cur, wr, wc, fr, fq);
        if (!has_next) break;
#pragma unroll
        for (int a = 0; a < 2; ++a)
#pragma unroll
            for (int b = 0; b < 2; ++b)
#pragma unroll
                for (int m = 0; m < 4; ++m)
#pragma unroll
                    for (int n = 0; n < 2; ++n) acc[a][b][m][n] = (f32x4){0.f, 0.f, 0.f, 0.f};
        cur = nxt; cB = nB; ++ui;
#pragma unroll
        for (int h = 0; h < 2; ++h)
#pragma unroll
            for (int i = 0; i < 2; ++i) aoc[h][i] = aon[h][i];
        if (wr == 1) PG8_BAR;
    }
    PG8_WAIT_V(0);
    PG8_BAR;
#undef PG8_SA
#undef PG8_SB
#undef PG8_STAGE
#undef PG8_LDA
#undef PG8_LDB
#undef PG8_MMA
#undef PG8_WAIT_V
#undef PG8_WAIT_L
#undef PG8_BAR
#undef PG8_SCHED
#undef PG8_AOFF
}

struct DenseOrder {
    int nM, nN, nwg, G, c; int ocw; unsigned long long bstep;
    __device__ __forceinline__ void init(int nM_, int nN_, int G_, int c_, int ocw_, int ldb) { nM = nM_; nN = nN_; nwg = nM * nN; G = G_; c = c_; ocw = ocw_; bstep = (unsigned long long)BM * ldb * 2; }
    __device__ __forceinline__ bool next(int i, Unit& u) const {
        const long L = (long)i * G + c; if (L >= nwg) return false;
        int wgid = (int)L; { const int q = nwg / NXCD, r = nwg % NXCD, xcd = wgid % NXCD, off = wgid / NXCD; wgid = (xcd < r ? xcd * (q + 1) : r * (q + 1) + (xcd - r) * q) + off; }
        const int nig = WGM * nN, gid = wgid / nig, fm = gid * WGM, gsz = (nM - fm) < WGM ? (nM - fm) : WGM;
        u.pm = fm + ((wgid % nig) % gsz); u.pn = (wgid % nig) / gsz;
        u.orow0 = u.pm * BM; u.ocol0 = u.pn * ocw; u.bofs = (unsigned long long)u.pn * bstep; u.aux = 0; return true;
    }
    __device__ __forceinline__ int arow(const Unit& u, int r) const { return u.pm * BM + r; }
};
}

struct EpiPlain {
    bf16* O; int ldc; float scale;
    __device__ __forceinline__ void operator()(const f32x4 (&acc)[2][2][4][2], const pg8::Unit& u, int wr, int wc, int fr, int fq) const {
        const int row0 = u.orow0 + wr * 64 + fr, col0 = u.ocol0 + wc * 32 + 8 * fq;
#pragma unroll
        for (int ai = 0; ai < 2; ++ai)
#pragma unroll
            for (int m = 0; m < 4; ++m) { bf16* rowp = O + (size_t)(row0 + ai * 128 + m * 16) * ldc + col0;
#pragma unroll
                for (int bj = 0; bj < 2; ++bj) { const f32x4 v0 = acc[ai][bj][m][0] * scale, v1 = acc[ai][bj][m][1] * scale;
                    u32x4 w; w.x = cvt_pk_bf16(v0[0], v0[1]); w.y = cvt_pk_bf16(v0[2], v0[3]); w.z = cvt_pk_bf16(v1[0], v1[1]); w.w = cvt_pk_bf16(v1[2], v1[3]);
                    *(u32x4*)(rowp + bj * 128) = w; } }
    }
};
struct EpiSwiglu {
    bf16* O; int ldc;
    __device__ __forceinline__ void operator()(const f32x4 (&acc)[2][2][4][2], const pg8::Unit& u, int wr, int wc, int fr, int fq) const {
        const int row0 = u.orow0 + wr * 64 + fr, col0 = u.ocol0 + wc * 32 + 8 * fq;
#pragma unroll
        for (int ai = 0; ai < 2; ++ai)
#pragma unroll
            for (int m = 0; m < 4; ++m) { bf16* rowp = O + (size_t)(row0 + ai * 128 + m * 16) * ldc + col0;
                float r[8];
#pragma unroll
                for (int n = 0; n < 2; ++n)
#pragma unroll
                    for (int j = 0; j < 4; ++j) { const float gt = acc[ai][0][m][n][j], up = acc[ai][1][m][n][j]; r[n * 4 + j] = silu_f(gt) * up; }
                u32x4 w; w.x = cvt_pk_bf16(r[0], r[1]); w.y = cvt_pk_bf16(r[2], r[3]); w.z = cvt_pk_bf16(r[4], r[5]); w.w = cvt_pk_bf16(r[6], r[7]);
                *(u32x4*)rowp = w; }
    }
};
struct EpiDftC {
    bf16* PQt; const float* gn;
    __device__ __forceinline__ void operator()(const f32x4 (&acc)[2][2][4][2], const pg8::Unit& u, int wr, int wc, int fr, int fq) const {
        const int gi = u.pm, jrow = wr * 64 + fr;
        const int tok0 = u.pn * 256 + wc * 32 + 8 * fq;
#pragma unroll
        for (int bj = 0; bj < 2; ++bj) {
            const int tk = tok0 + bj * 128; const int b = tk >> 11, l = tk & 2047;
            bf16* base = PQt + ((size_t)(b * 512 + gi * 128 + jrow)) * 4096 + l;
            float mu[8], rs[8];
            { const f32x4* p = (const f32x4*)(gn + ((size_t)gi * ML + tk) * 2);
#pragma unroll
              for (int j = 0; j < 4; ++j) { const f32x4 t = p[j]; mu[2 * j] = t[0]; rs[2 * j] = t[1]; mu[2 * j + 1] = t[2]; rs[2 * j + 1] = t[3]; } }
#pragma unroll
            for (int ai = 0; ai < 2; ++ai) {
#pragma unroll
                for (int m = 0; m < 4; ++m) {
                    const float dc = (ai == 0 && m == 0 && jrow == 0) ? 128.f : 0.f;
                    float r[8];
#pragma unroll
                    for (int n = 0; n < 2; ++n)
#pragma unroll
                        for (int j = 0; j < 4; ++j) r[n * 4 + j] = rs[n * 4 + j] * (acc[ai][bj][m][n][j] - mu[n * 4 + j] * dc);
                    u32x4 w; w.x = cvt_pk_bf16(r[0], r[1]); w.y = cvt_pk_bf16(r[2], r[3]); w.z = cvt_pk_bf16(r[4], r[5]); w.w = cvt_pk_bf16(r[6], r[7]);
                    *(u32x4*)(base + (size_t)m * 16 * 4096 + ai * 2048) = w; }
                asm volatile("" ::: "memory"); }
        }
    }
};

struct Frame {
    LAS unsigned char* lds;
    int tid, lane, wave, G, vcu, gw, NGW;
    const float* in[26];
    float* out; unsigned char* ws;
};
#define IN_X 0
#define IN_C 1
#define IN_CTX 2
#define IN_CCTX 3
#define IN_WMOD 4
#define IN_BMOD 5
#define IN_LNG 6
#define IN_LNB 7
#define IN_EWIN 8
#define IN_ECONV 9
#define IN_LQ1 10
#define IN_LK1 11
#define IN_LQ2 12
#define IN_LK2 13
#define IN_SUBG 14
#define IN_EWO 15
#define IN_EGATE 16
#define IN_EUP 17
#define IN_EDOWN 18
#define IN_OWIN 19
#define IN_RPB 20
#define IN_OWO 21
#define IN_ROUTER 22
#define IN_XGATE 23
#define IN_XUP 24
#define IN_XDOWN 25

__device__ __forceinline__ const float* mods_ptr(const Frame& F, int layer, int cond, int which) { return (const float*)(F.ws + WS_MODS) + ((size_t)(layer * NCOND + cond) * 6 + which) * DM; }
__device__ __forceinline__ int cond_of_row(int row) { return row < ML ? (row >> 11) : NCOND - 1; }

__device__ __forceinline__ void conv_item(const float* W, int K, int N, bf16* WT, int mode, LAS float* scr, int item, int lane) {
    const int nblk = N / 32, kb = item / nblk, nb = item % nblk, k0 = 64 * kb, n0 = 32 * nb;
#pragma unroll 8
    for (int i = 0; i < 32; ++i) { const int kk = 2 * i + (lane >> 5); scr[kk * 33 + (lane & 31)] = W[(size_t)(k0 + kk) * N + n0 + (lane & 31)]; }
    asm volatile("s_waitcnt lgkmcnt(0)" ::: "memory");
    const int d0 = (mode == 0) ? n0 : ((n0 >> 7) * 256 + (n0 & 127) + (mode == 2 ? 128 : 0));
    const int c = lane & 7;
#pragma unroll
    for (int j = 0; j < 4; ++j) { const int n = (lane >> 3) + 8 * j; const LAS float* s = scr + (8 * c) * 33 + n;
        u32x4 o; o.x = pk2(s[0 * 33], s[1 * 33]); o.y = pk2(s[2 * 33], s[3 * 33]); o.z = pk2(s[4 * 33], s[5 * 33]); o.w = pk2(s[6 * 33], s[7 * 33]);
        *(u32x4*)(WT + (size_t)(d0 + n) * K + k0 + 8 * c) = o; }
    asm volatile("s_waitcnt lgkmcnt(0)" ::: "memory");
}

__device__ __forceinline__ void p0_prologue(Frame& F) {
    const int tid = F.tid, lane = F.lane, wave = F.wave;
    if ((int)blockIdx.x < 192) {
        LAS float* S = (LAS float*)F.lds;
        LAS float* red = (LAS float*)(F.lds + 17 * 1024 * 4);
        for (int i = tid; i < NCOND * DM; i += 512) { const int j = i >> 10, k = i & 1023; const float v = (j < 16) ? F.in[IN_C][j * DM + k] : F.in[IN_CCTX][k]; S[i] = silu_f(v); }
        __syncthreads();
        const int item = blockIdx.x, layer = item / 96, n = (item % 96) * 64 + lane;
        const float* W = F.in[IN_WMOD] + (size_t)layer * DM * 6144;
        float acc[NCOND];
#pragma unroll
        for (int j = 0; j < NCOND; ++j) acc[j] = 0.f;
        for (int k = wave * 128; k < wave * 128 + 128; ++k) { const float w = W[(size_t)k * 6144 + n];
#pragma unroll
            for (int j = 0; j < NCOND; ++j) acc[j] += S[j * DM + k] * w; }
#pragma unroll
        for (int j = 0; j < NCOND; ++j) red[(wave * NCOND + j) * 64 + lane] = acc[j];
        __syncthreads();
        for (int i = tid; i < NCOND * 64; i += 512) { const int j = i >> 6, l = i & 63; float s = 0.f;
#pragma unroll
            for (int w = 0; w < 8; ++w) s += red[(w * NCOND + j) * 64 + l];
            const int nn = (item % 96) * 64 + l;
            ((float*)(F.ws + WS_MODS))[(size_t)(layer * NCOND + j) * 6144 + nn] = s + F.in[IN_BMOD][layer * 6144 + nn]; }
        __syncthreads();
    }
    {
        LAS float* scr = (LAS float*)(F.lds + wave * 16384);
        constexpr int I_EIN = 16 * 96, I_EO = 16 * 32, I_G = 16 * 88, I_DN = 44 * 32, I_OIN = 16 * 64, I_OO = 16 * 32;
        constexpr int NIT = I_EIN + I_EO + 2 * I_G + I_DN + I_OIN + I_OO;
        for (int it = F.gw; it < NIT; it += F.NGW) {
            int r = it;
            if (r < I_EIN) { conv_item(F.in[IN_EWIN], DM, E_IN, (bf16*)(F.ws + WS_WEIN), 0, scr, r, lane); continue; } r -= I_EIN;
            if (r < I_EO) { conv_item(F.in[IN_EWO], DM, DM, (bf16*)(F.ws + WS_WEO), 0, scr, r, lane); continue; } r -= I_EO;
            if (r < I_G) { conv_item(F.in[IN_EGATE], DM, FF, (bf16*)(F.ws + WS_WGU), 1, scr, r, lane); continue; } r -= I_G;
            if (r < I_G) { conv_item(F.in[IN_EUP], DM, FF, (bf16*)(F.ws + WS_WGU), 2, scr, r, lane); continue; } r -= I_G;
            if (r < I_DN) { conv_item(F.in[IN_EDOWN], FF, DM, (bf16*)(F.ws + WS_WDN), 0, scr, r, lane); continue; } r -= I_DN;
            if (r < I_OIN) { conv_item(F.in[IN_OWIN], DM, O_IN, (bf16*)(F.ws + WS_WOIN), 0, scr, r, lane); continue; } r -= I_OIN;
            conv_item(F.in[IN_OWO], DM, DM, (bf16*)(F.ws + WS_WOO), 0, scr, r, lane);
        }
    }
    {
        const size_t gt = (size_t)blockIdx.x * 512 + tid, NT = (size_t)F.G * 512;
        bf16* DL = (bf16*)(F.ws + WS_DFTL);
        for (size_t i = gt; i < (size_t)2048 * 4096 / 8; i += NT) {
            const int k = (int)(i >> 9), l0 = (int)(i & 511) * 8; unsigned w[4];
#pragma unroll
            for (int j = 0; j < 8; j += 2) { float v[2];
#pragma unroll
                for (int q = 0; q < 2; ++q) { const int lp = l0 + j + q, l = lp & 2047; const int ph = (k * l) & 2047; float s, c; sincospif((float)ph * (1.f / 1024.f), &s, &c); v[q] = (lp < 2048) ? c : -s; }
                w[j >> 1] = pk2(v[0], v[1]); }
            *(u32x4*)(DL + (size_t)k * 4096 + l0) = (u32x4){w[0], w[1], w[2], w[3]};
        }
        bf16* DC = (bf16*)(F.ws + WS_DFTC);
        for (size_t i = gt; i < (size_t)4 * 256 * 256; i += NT) {
            const int gi = (int)(i >> 16), mp = (int)(i >> 8) & 255, c2 = (int)i & 255; const int pq = mp >> 7, j = mp & 127, cg = c2 >> 7, c = c2 & 127;
            float v = 0.f;
            if (cg == (gi & 1)) { const int ph = (c * j) & 127; float s, cs; sincospif((float)ph * (1.f / 64.f), &s, &cs); v = pq ? s : cs; }
            DC[i] = (bf16)f2bf(v);
        }
        float* RP = (float*)(F.ws + WS_ROPE);
        for (size_t i = gt; i < (size_t)2048 * 32; i += NT) {
            const int t = (int)(i >> 5), j = (int)i & 31; const float pos = (j < 16) ? (float)(t >> 6) : (float)(t & 63);
            const float invf = powf(10000.f, -(float)(j & 15) / 16.f); const float ang = pos * invf;
            RP[i * 2] = cosf(ang); RP[i * 2 + 1] = sinf(ang);
        }
        if (gt == 0) {
            float s1 = 0.f, s2 = 0.f;
            for (int d = 0; d < 64; ++d) { s1 += F.in[IN_LQ1][d] * F.in[IN_LK1][d]; s2 += F.in[IN_LQ2][d] * F.in[IN_LK2][d]; }
            const float lam_init = 0.2f;
            ((float*)(F.ws + WS_MISC))[0] = expf(s1) - expf(s2) + lam_init;
        }
    }
}

__device__ __forceinline__ void conv_experts(Frame& F) {
    LAS float* scr = (LAS float*)(F.lds + F.wave * 16384);
    constexpr int I_G = 16 * 112, I_D = 56 * 32;
    constexpr int NIT = NEXP * (2 * I_G + I_D);
    for (int it = F.gw; it < NIT; it += F.NGW) {
        const int e = it / (2 * I_G + I_D); int r = it % (2 * I_G + I_D);
        bf16* gu = (bf16*)(F.ws + WS_EWGU) + (size_t)e * 7168 * DM;
        if (r < I_G) { conv_item(F.in[IN_XGATE] + (size_t)e * DM * FFE, DM, FFE, gu, 1, scr, r, F.lane); continue; } r -= I_G;
        if (r < I_G) { conv_item(F.in[IN_XUP] + (size_t)e * DM * FFE, DM, FFE, gu, 2, scr, r, F.lane); continue; } r -= I_G;
        conv_item(F.in[IN_XDOWN] + (size_t)e * FFE * DM, FFE, DM, (bf16*)(F.ws + WS_EWDN) + (size_t)e * DM * FFE, 0, scr, r, F.lane);
    }
}

__device__ __forceinline__ void ld_row_f32(const float* p, int lane, f32x4 (&v)[4]) {
#pragma unroll
    for (int j = 0; j < 4; ++j) v[j] = *(const f32x4*)(p + 4 * lane + 256 * j);
}
__device__ __forceinline__ void ld_row_bf16(const bf16* p, int lane, f32x4 (&v)[4]) {
#pragma unroll
    for (int j = 0; j < 4; ++j) { const u32x2 w = *(const u32x2*)(p + 4 * lane + 256 * j); v[j] = (f32x4){bf_lo(w.x), bf_hi(w.x), bf_lo(w.y), bf_hi(w.y)}; }
}
__device__ __forceinline__ void st_row_f32(float* p, int lane, const f32x4 (&v)[4]) {
#pragma unroll
    for (int j = 0; j < 4; ++j) *(f32x4*)(p + 4 * lane + 256 * j) = v[j];
}
__device__ __forceinline__ void st_row_bf16(bf16* p, int lane, const f32x4 (&v)[4]) {
#pragma unroll
    for (int j = 0; j < 4; ++j) { u32x2 w; w.x = pk2(v[j][0], v[j][1]); w.y = pk2(v[j][2], v[j][3]); *(u32x2*)(p + 4 * lane + 256 * j) = w; }
}
__device__ __forceinline__ void ln_row(f32x4 (&v)[4], const float* g, const float* b, int lane) {
    float s = 0.f;
#pragma unroll
    for (int j = 0; j < 4; ++j) s += (v[j][0] + v[j][1]) + (v[j][2] + v[j][3]);
    const float mean = wave_sum(s) * (1.f / DM); float s2 = 0.f;
#pragma unroll
    for (int j = 0; j < 4; ++j) { v[j] = v[j] - mean; s2 += (v[j][0] * v[j][0] + v[j][1] * v[j][1]) + (v[j][2] * v[j][2] + v[j][3] * v[j][3]); }
    const float rstd = rsqrtf(wave_sum(s2) * (1.f / DM) + LN_EPS);
    f32x4 gg[4], bb[4]; ld_row_f32(g, lane, gg); ld_row_f32(b, lane, bb);
#pragma unroll
    for (int j = 0; j < 4; ++j) v[j] = v[j] * rstd * gg[j] + bb[j];
}
__device__ __forceinline__ void modulate_row(f32x4 (&h)[4], const f32x4 (&x)[4], const float* sh, const float* sc, int lane) {
    f32x4 a[4], c[4]; ld_row_f32(sh, lane, a); ld_row_f32(sc, lane, c);
#pragma unroll
    for (int j = 0; j < 4; ++j) h[j] = x[j] * (1.f + c[j]) + a[j];
}

__device__ __forceinline__ void p1_modulate(Frame& F) {
    bf16* H = (bf16*)(F.ws + WS_H);
    for (int row = F.gw; row < MT; row += F.NGW) {
        const int cond = cond_of_row(row);
        const float* xr = row < ML ? F.in[IN_X] + (size_t)row * DM : F.in[IN_CTX] + (size_t)(row - ML) * DM;
        f32x4 x[4], h[4]; ld_row_f32(xr, F.lane, x);
        modulate_row(h, x, mods_ptr(F, 0, cond, 0), mods_ptr(F, 0, cond, 1), F.lane);
        st_row_bf16(H + (size_t)row * DM, F.lane, h);
    }
}

__device__ __forceinline__ void p3_rope_conv(Frame& F) {
    bf16* P = (bf16*)(F.ws + WS_BIG); bf16* CAT = (bf16*)(F.ws + WS_CAT);
    const float* RP = (const float*)(F.ws + WS_ROPE);
    const float* wc = F.in[IN_ECONV];
    const int lane = F.lane;
    for (int row = F.gw; row < MT; row += F.NGW) {
        bf16* pr = P + (size_t)row * E_IN;
        if (row < ML) {
            const int t = row & 2047;
            const int d4 = 4 * (lane & 7);
            f32x4 cs[2];
            { const float* rp = RP + ((size_t)t * 32 + d4) * 2; cs[0] = *(const f32x4*)rp; cs[1] = *(const f32x4*)(rp + 4); }
            const float c0 = cs[0][0], s0 = cs[0][1], c1 = cs[0][2], s1 = cs[0][3], c2 = cs[1][0], s2 = cs[1][1], c3 = cs[1][2], s3 = cs[1][3];
#pragma unroll
            for (int pass = 0; pass < 2; ++pass) {
                bf16* gp = pr + 1536 + (pass * 8 + (lane >> 3)) * 64 + d4;
                const u32x2 a = *(const u32x2*)gp, b = *(const u32x2*)(gp + 32);
                const float x10 = bf_lo(a.x), x11 = bf_hi(a.x), x12 = bf_lo(a.y), x13 = bf_hi(a.y);
                const float x20 = bf_lo(b.x), x21 = bf_hi(b.x), x22 = bf_lo(b.y), x23 = bf_hi(b.y);
                u32x2 oa, ob;
                oa.x = pk2(x10 * c0 - x20 * s0, x11 * c1 - x21 * s1); oa.y = pk2(x12 * c2 - x22 * s2, x13 * c3 - x23 * s3);
                ob.x = pk2(x10 * s0 + x20 * c0, x11 * s1 + x21 * c1); ob.y = pk2(x12 * s2 + x22 * c2, x13 * s3 + x23 * c3);
                *(u32x2*)gp = oa; *(u32x2*)(gp + 32) = ob;
            }
        }
        const int t = row < ML ? (row & 2047) : ((row - ML) & 255); const int Ls = row < ML ? SEQ : LC;
        const int ch = 8 * lane;
        float cv[3][8];
#pragma unroll
        for (int dt = 0; dt < 3; ++dt) {
            const int tt = t + dt - 1;
            if (tt >= 0 && tt < Ls) { const bf16* q = P + (size_t)(row + dt - 1) * E_IN; const u32x4 cg = *(const u32x4*)(q + 512 + ch), vl = *(const u32x4*)(q + 1024 + ch);
#pragma unroll
                for (int j = 0; j < 4; ++j) { cv[dt][2 * j] = bf_lo(cg[j]) * bf_lo(vl[j]); cv[dt][2 * j + 1] = bf_hi(cg[j]) * bf_hi(vl[j]); } }
            else {
#pragma unroll
                for (int j = 0; j < 8; ++j) cv[dt][j] = 0.f; }
        }
        const u32x4 bg = *(const u32x4*)(pr + ch);
        float w0[8], w1[8], w2[8];
#pragma unroll
        for (int j = 0; j < 8; ++j) { w0[j] = wc[ch + j]; w1[j] = wc[512 + ch + j]; w2[j] = wc[1024 + ch + j]; }
        float o[8];
#pragma unroll
        for (int j = 0; j < 8; ++j) { const float bgv = (j & 1) ? bf_hi(bg[j >> 1]) : bf_lo(bg[j >> 1]); o[j] = bgv * (cv[0][j] * w0[j] + cv[1][j] * w1[j] + cv[2][j] * w2[j]); }
        u32x4 w; w.x = pk2(o[0], o[1]); w.y = pk2(o[2], o[3]); w.z = pk2(o[4], o[5]); w.w = pk2(o[6], o[7]);
        *(u32x4*)(CAT + (size_t)row * DM + ch) = w;
    }
}

__device__ __forceinline__ int crow(int r, int hi) { return (r & 3) + 8 * (r >> 2) + 4 * hi; }
__device__ __forceinline__ s16x4 vtr(const LAS unsigned char* p) { return __builtin_bit_cast(s16x4, __builtin_amdgcn_ds_read_tr16_b64_v4i16((LAS s16x4*)p)); }
__device__ __forceinline__ float xhalf_max(float v) { return fmaxf(v, __shfl_xor(v, 32)); }
__device__ __forceinline__ bf16x8 pack8(const f32x16& p, int s) {
    u32x4 w; w.x = cvt_pk_bf16(p[8 * s + 0], p[8 * s + 1]); w.y = cvt_pk_bf16(p[8 * s + 2], p[8 * s + 3]); w.z = cvt_pk_bf16(p[8 * s + 4], p[8 * s + 5]); w.w = cvt_pk_bf16(p[8 * s + 6], p[8 * s + 7]);
    return __builtin_bit_cast(bf16x8, w);
}
__device__ __forceinline__ int koff(int row, int ch) { return row * 128 + ((ch ^ ((row >> 1) & 7)) << 4); }
__device__ __forceinline__ int voff128(int row, int ch) { return 256 * row + 16 * (ch ^ (((row & 3) << 2) | ((row >> 2) & 3))); }
__device__ __forceinline__ int voff64(int row, int ch) { return 128 * row + 16 * (ch ^ (((row >> 1) & 1) << 2)); }

__device__ __forceinline__ void p4_diff_attn(Frame& F) {
    const bf16* P = (const bf16*)(F.ws + WS_BIG); bf16* CAT = (bf16*)(F.ws + WS_CAT);
    const float lam = ((const float*)(F.ws + WS_MISC))[0];
    const float* subg = F.in[IN_SUBG];
    const int tid = F.tid, lane = F.lane, wave = F.wave, r32 = lane & 31, hi = lane >> 5;
    const int comp = wave >> 2, qb = wave & 3;
    LAS unsigned char* lds = F.lds;
    constexpr int STG = 32768;
    constexpr float C2 = 0.125f * 1.4426950408889634f;
    constexpr int NU_LAT = NB * 4 * 16, NU = NU_LAT + NB * 4 * 2;
    for (int un = F.vcu; un < NU; un += F.G) {
        int b, h, qrow0, j0, j1;
        if (un < NU_LAT) { b = un >> 6; h = (un >> 4) & 3; qrow0 = b * SEQ + (un & 15) * 128; j0 = 0; j1 = 36; }
        else { const int v = un - NU_LAT; b = v >> 3; h = (v >> 1) & 3; qrow0 = ML + b * LC + (v & 1) * 128; j0 = 0; j1 = 4; }
        bf16x8 qf[4];
        { const bf16* qp = P + (size_t)(qrow0 + qb * 32 + r32) * E_IN + 1536 + h * 128 + comp * 64 + hi * 8;
#pragma unroll
          for (int ds = 0; ds < 4; ++ds) qf[ds] = *(const bf16x8*)(qp + ds * 16); }
        f32x16 o[4];
#pragma unroll
        for (int e = 0; e < 4; ++e) o[e] = (f32x16){};
        float mrun = -INFINITY, lrun = 0.f;
        u32x4 sk1, sk2, sv[2];
        const int krow = tid >> 3, kch = tid & 7;
#define DA_LOAD(j) do { const int rowb = ((j) < 4) ? (ML + b * LC + (j) * 64) : (b * SEQ + ((j) - 4) * 64); \
            const bf16* kp = P + (size_t)(rowb + krow) * E_IN + 2048 + h * 128 + kch * 8; sk1 = *(const u32x4*)kp; sk2 = *(const u32x4*)(kp + 64); \
            _Pragma("unroll") for (int i = 0; i < 2; ++i) { const int idx = tid + 512 * i; sv[i] = *(const u32x4*)(P + (size_t)(rowb + (idx >> 4)) * E_IN + 2560 + h * 128 + (idx & 15) * 8); } } while (0)
#define DA_STORE(st) do { LAS unsigned char* sb = lds + (st) * STG; *(LAS u32x4*)(sb + koff(krow, kch)) = sk1; *(LAS u32x4*)(sb + 8192 + koff(krow, kch)) = sk2; \
            _Pragma("unroll") for (int i = 0; i < 2; ++i) { const int idx = tid + 512 * i; *(LAS u32x4*)(sb + 16384 + voff128(idx >> 4, idx & 15)) = sv[i]; } } while (0)
        __syncthreads();
        DA_LOAD(j0); DA_STORE(0);
        __syncthreads();
        for (int j = j0; j < j1; ++j) {
            const int st = (j - j0) & 1;
            if (j + 1 < j1) DA_LOAD(j + 1);
            const LAS unsigned char* kb_ = lds + st * STG + comp * 8192;
            const LAS unsigned char* vb_ = lds + st * STG + 16384;
            f32x16 p[2];
#pragma unroll
            for (int kb = 0; kb < 2; ++kb) { p[kb] = (f32x16){};
#pragma unroll
                for (int ds = 0; ds < 4; ++ds) { const bf16x8 kf = *(const LAS bf16x8*)(kb_ + koff(kb * 32 + r32, ds * 2 + hi)); p[kb] = __builtin_amdgcn_mfma_f32_32x32x16_bf16(kf, qf[ds], p[kb], 0, 0, 0); } }
            float mx = p[0][0];
#pragma unroll
            for (int r = 0; r < 16; ++r) { mx = fmaxf(mx, p[0][r]); mx = fmaxf(mx, p[1][r]); }
            mx = xhalf_max(mx) * C2;
            const float mnew = fmaxf(mrun, mx); const float al = __builtin_amdgcn_exp2f(mrun - mnew); mrun = mnew;
            float ps = 0.f;
#pragma unroll
            for (int kb = 0; kb < 2; ++kb)
#pragma unroll
                for (int r = 0; r < 16; ++r) { const float e = __builtin_amdgcn_exp2f(p[kb][r] * C2 - mnew); p[kb][r] = e; ps += e; }
            lrun = lrun * al + ps;
#pragma unroll
            for (int e = 0; e < 4; ++e) o[e] = o[e] * al;
#pragma unroll
            for (int kb = 0; kb < 2; ++kb)
#pragma unroll
                for (int s = 0; s < 2; ++s) { const bf16x8 pf = pack8(p[kb], s);
                    const int rb = kb * 32 + 16 * s + 4 * hi + ((lane & 15) >> 2);
#pragma unroll
                    for (int e = 0; e < 4; ++e) { const int c0 = 4 * e + 2 * ((lane >> 4) & 1) + ((lane & 3) >> 1);
                        const s16x4 lo = vtr(vb_ + voff128(rb, c0) + 8 * (lane & 1)), hh = vtr(vb_ + voff128(rb + 8, c0) + 8 * (lane & 1));
                        const bf16x8 vf = (bf16x8){lo[0], lo[1], lo[2], lo[3], hh[0], hh[1], hh[2], hh[3]};
                        o[e] = __builtin_amdgcn_mfma_f32_32x32x16_bf16(vf, pf, o[e], 0, 0, 0); } }
            if (j + 1 < j1) DA_STORE(st ^ 1);
            __syncthreads();
        }
        const float linv = 1.f / (lrun + __shfl_xor(lrun, 32));
        LAS float* X = (LAS float*)(lds + qb * 16384);
        if (comp == 1) {
#pragma unroll
            for (int e = 0; e < 4; ++e)
#pragma unroll
                for (int r = 0; r < 16; ++r) X[(e * 16 + r) * 64 + lane] = o[e][r] * linv; }
        __syncthreads();
        if (comp == 0) {
            float ss = 0.f;
#pragma unroll
            for (int e = 0; e < 4; ++e)
#pragma unroll
                for (int r = 0; r < 16; ++r) { const float v = o[e][r] * linv - lam * X[(e * 16 + r) * 64 + lane]; o[e][r] = v; ss += v * v; }
            ss += __shfl_xor(ss, 32);
            const float rn = rsqrtf(ss * (1.f / 128.f) + RMS_EPS) * 0.8f;
            bf16* op = CAT + (size_t)(qrow0 + qb * 32 + r32) * DM + 512 + h * 128;
#pragma unroll
            for (int e = 0; e < 4; ++e)
#pragma unroll
                for (int r4 = 0; r4 < 4; ++r4) { const int ec = 32 * e + 8 * r4 + 4 * hi; const f32x4 g = *(const f32x4*)(subg + ec);
                    u32x2 w; w.x = pk2(o[e][4 * r4] * rn * g[0], o[e][4 * r4 + 1] * rn * g[1]); w.y = pk2(o[e][4 * r4 + 2] * rn * g[2], o[e][4 * r4 + 3] * rn * g[3]);
                    *(u32x2*)(op + ec) = w; }
        }
#undef DA_LOAD
#undef DA_STORE
    }
    __syncthreads();
}

__device__ __forceinline__ void p11_na_attn(Frame& F) {
    const bf16* P2 = (const bf16*)(F.ws + WS_BIG); bf16* CAT = (bf16*)(F.ws + WS_CAT);
    const int lane = F.lane, wave = F.wave, r32 = lane & 31, hi = lane >> 5;
    {
        float* GN = (float*)(F.ws + WS_GN);
        for (int row = F.gw; row < ML; row += F.NGW) {
            const u32x4 w = *(const u32x4*)(P2 + (size_t)row * O_IN + 8 * lane);
            float v[8];
#pragma unroll
            for (int j = 0; j < 4; ++j) { v[2 * j] = bf_lo(w[j]); v[2 * j + 1] = bf_hi(w[j]); }
            float s = 0.f;
#pragma unroll
            for (int j = 0; j < 8; ++j) s += v[j];
#pragma unroll
            for (int o = 1; o < 16; o <<= 1) s += __shfl_xor(s, o);
            const float mean = s * (1.f / 128.f); float q = 0.f;
#pragma unroll
            for (int j = 0; j < 8; ++j) { const float d = v[j] - mean; q += d * d; }
#pragma unroll
            for (int o = 1; o < 16; o <<= 1) q += __shfl_xor(q, o);
            if ((lane & 15) == 0) { float* g = GN + ((size_t)(lane >> 4) * ML + row) * 2; g[0] = mean; g[1] = rsqrtf(q * (1.f / 128.f) + LN_EPS); }
        }
    }
    LAS float* TAB = (LAS float*)(F.lds + 1024);
    __syncthreads();
    for (int i = F.tid; i < 8 * 15 * 32; i += 512) { const int dc = i & 31; TAB[i] = (dc < 31) ? F.in[IN_RPB][(i >> 5) * 31 + dc] : 0.f; }
    __syncthreads();
    LAS unsigned char* vt = F.lds + 32768 + wave * 8192;
    constexpr float C2 = 0.125f * 1.4426950408889634f, LOG2E = 1.4426950408889634f;
    constexpr int NWU = NB * 32 * 8 * 2;
    for (int wu = F.vcu * NWAVES + wave; wu < NWU; wu += F.G * NWAVES) {
        const int qh = wu & 1, h = (wu >> 1) & 7, r = (wu >> 4) & 31, b = wu >> 9;
        const int rs = min(max(r - 4, 0), 24);
        const int qc = qh * 32 + r32, cs = min(max(qc - 8, 0), 48);
        const int qrow = b * SEQ + r * 64 + qc;
        bf16x8 qf[4];
        { const bf16* qp = P2 + (size_t)qrow * O_IN + 512 + h * 64 + hi * 8;
#pragma unroll
          for (int ds = 0; ds < 4; ++ds) qf[ds] = *(const bf16x8*)(qp + ds * 16); }
        f32x16 o[2]; o[0] = (f32x16){}; o[1] = (f32x16){};
        float mrun = -INFINITY, lrun = 0.f;
        bf16x8 kf[2][4], kn[2][4]; u32x4 vn[8];
#define NA_ROWB(j) (((j) < 8) ? (b * SEQ + (rs + (j)) * 64) : (ML + b * LC + ((j) - 8) * 64))
#define NA_LOADK(dst, j) do { const bf16* kp = P2 + (size_t)(NA_ROWB(j) + r32) * O_IN + 1024 + h * 64 + hi * 8; \
            _Pragma("unroll") for (int kb = 0; kb < 2; ++kb) _Pragma("unroll") for (int ds = 0; ds < 4; ++ds) dst[kb][ds] = *(const bf16x8*)(kp + (size_t)kb * 32 * O_IN + ds * 16); } while (0)
#define NA_LOADV(j) do { const bf16* vp = P2 + (size_t)NA_ROWB(j) * O_IN + 1536 + h * 64; \
            _Pragma("unroll") for (int i = 0; i < 8; ++i) { const int idx = lane + 64 * i; vn[i] = *(const u32x4*)(vp + (size_t)(idx >> 3) * O_IN + (idx & 7) * 8); } } while (0)
#define NA_STOREV() do { _Pragma("unroll") for (int i = 0; i < 8; ++i) { const int idx = lane + 64 * i; *(LAS u32x4*)(vt + voff64(idx >> 3, idx & 7)) = vn[i]; } } while (0)
        NA_LOADK(kf, 0); NA_LOADV(0); NA_STOREV();
        for (int j = 0; j < 12; ++j) {
            if (j + 1 < 12) { NA_LOADK(kn, j + 1); NA_LOADV(j + 1); }
            f32x16 p[2];
#pragma unroll
            for (int kb = 0; kb < 2; ++kb) { p[kb] = (f32x16){};
#pragma unroll
                for (int ds = 0; ds < 4; ++ds) p[kb] = __builtin_amdgcn_mfma_f32_32x32x16_bf16(kf[kb][ds], qf[ds], p[kb], 0, 0, 0); }
            if (j < 8) {
                const int dr = rs + j - r + 7;
                const LAS float* tb = TAB + (h * 15 + dr) * 32 + (15 - qc + 4 * hi);
                const int kd = 4 * hi - cs;
#pragma unroll
                for (int kb = 0; kb < 2; ++kb)
#pragma unroll
                    for (int rr = 0; rr < 16; ++rr) { const int kc0 = kb * 32 + (rr & 3) + 8 * (rr >> 2);
                        const float bias = tb[kc0]; const bool ok = (unsigned)(kc0 + kd) < 16u;
                        p[kb][rr] = ok ? (p[kb][rr] * C2 + bias * LOG2E) : -INFINITY; }
            } else {
#pragma unroll
                for (int kb = 0; kb < 2; ++kb)
#pragma unroll
                    for (int rr = 0; rr < 16; ++rr) p[kb][rr] *= C2;
            }
            float mx = p[0][0];
#pragma unroll
            for (int rr = 0; rr < 16; ++rr) { mx = fmaxf(mx, p[0][rr]); mx = fmaxf(mx, p[1][rr]); }
            mx = xhalf_max(mx);
            const float mnew = fmaxf(mrun, mx); const float al = __builtin_amdgcn_exp2f(mrun - mnew); mrun = mnew;
            float ps = 0.f;
#pragma unroll
            for (int kb = 0; kb < 2; ++kb)
#pragma unroll
                for (int rr = 0; rr < 16; ++rr) { const float e = __builtin_amdgcn_exp2f(p[kb][rr] - mnew); p[kb][rr] = e; ps += e; }
            lrun = lrun * al + ps;
            o[0] = o[0] * al; o[1] = o[1] * al;
#pragma unroll
            for (int kb = 0; kb < 2; ++kb)
#pragma unroll
                for (int s = 0; s < 2; ++s) { const bf16x8 pf = pack8(p[kb], s);
                    const int rb = kb * 32 + 16 * s + 4 * hi + ((lane & 15) >> 2);
#pragma unroll
                    for (int e = 0; e < 2; ++e) { const int c0 = 4 * e + 2 * ((lane >> 4) & 1) + ((lane & 3) >> 1);
                        const s16x4 lo = vtr(vt + voff64(rb, c0) + 8 * (lane & 1)), hh = vtr(vt + voff64(rb + 8, c0) + 8 * (lane & 1));
                        const bf16x8 vf = (bf16x8){lo[0], lo[1], lo[2], lo[3], hh[0], hh[1], hh[2], hh[3]};
                        o[e] = __builtin_amdgcn_mfma_f32_32x32x16_bf16(vf, pf, o[e], 0, 0, 0); } }
            if (j + 1 < 12) {
                NA_STOREV();
#pragma unroll
                for (int kb = 0; kb < 2; ++kb)
#pragma unroll
                    for (int ds = 0; ds < 4; ++ds) kf[kb][ds] = kn[kb][ds];
            }
        }
        const float linv = 1.f / (lrun + __shfl_xor(lrun, 32));
        bf16* op = CAT + (size_t)qrow * DM + 512 + h * 64;
#pragma unroll
        for (int e = 0; e < 2; ++e)
#pragma unroll
            for (int r4 = 0; r4 < 4; ++r4) { const int ec = 32 * e + 8 * r4 + 4 * hi;
                u32x2 w; w.x = pk2(o[e][4 * r4] * linv, o[e][4 * r4 + 1] * linv); w.y = pk2(o[e][4 * r4 + 2] * linv, o[e][4 * r4 + 3] * linv);
                *(u32x2*)(op + ec) = w; }
#undef NA_ROWB
#undef NA_LOADK
#undef NA_LOADV
#undef NA_STOREV
    }
    __syncthreads();
}

__device__ __forceinline__ void p6_ln1_even(Frame& F) {
    const bf16* Y = (const bf16*)(F.ws + WS_Y); bf16* H = (bf16*)(F.ws + WS_H); float* XC = (float*)(F.ws + WS_XC);
    const float* lg = F.in[IN_LNG] + 0 * DM; const float* lb = F.in[IN_LNB] + 0 * DM;
    for (int row = F.gw; row < MT; row += F.NGW) {
        const int cond = cond_of_row(row);
        const float* xr = row < ML ? F.in[IN_X] + (size_t)row * DM : F.in[IN_CTX] + (size_t)(row - ML) * DM;
        f32x4 x[4], y[4], g[4], h[4]; ld_row_f32(xr, F.lane, x); ld_row_bf16(Y + (size_t)row * DM, F.lane, y); ld_row_f32(mods_ptr(F, 0, cond, 2), F.lane, g);
#pragma unroll
        for (int j = 0; j < 4; ++j) x[j] = ALPHA * x[j] + g[j] * y[j];
        ln_row(x, lg, lb, F.lane);
        st_row_f32(row < ML ? F.out + (size_t)row * DM : XC + (size_t)(row - ML) * DM, F.lane, x);
        modulate_row(h, x, mods_ptr(F, 0, cond, 3), mods_ptr(F, 0, cond, 4), F.lane);
        st_row_bf16(H + (size_t)row * DM, F.lane, h);
    }
}
__device__ __forceinline__ void p9_ln2_even(Frame& F) {
    const bf16* Fd = (const bf16*)(F.ws + WS_Y); bf16* H = (bf16*)(F.ws + WS_H); const float* XC = (const float*)(F.ws + WS_XC);
    const float* lg = F.in[IN_LNG] + 1 * DM; const float* lb = F.in[IN_LNB] + 1 * DM;
    for (int row = F.gw; row < MT; row += F.NGW) {
        const int cond = cond_of_row(row);
        const float* xr = row < ML ? F.out + (size_t)row * DM : XC + (size_t)(row - ML) * DM;
        f32x4 x[4], y[4], g[4], h[4]; ld_row_f32(xr, F.lane, x); ld_row_bf16(Fd + (size_t)row * DM, F.lane, y); ld_row_f32(mods_ptr(F, 0, cond, 5), F.lane, g);
#pragma unroll
        for (int j = 0; j < 4; ++j) x[j] = ALPHA * x[j] + g[j] * y[j];
        ln_row(x, lg, lb, F.lane);
        if (row < ML) st_row_f32(F.out + (size_t)row * DM, F.lane, x);
        modulate_row(h, x, mods_ptr(F, 1, cond, 0), mods_ptr(F, 1, cond, 1), F.lane);
        st_row_bf16(H + (size_t)row * DM, F.lane, h);
    }
}
__device__ __forceinline__ void p15_ln1_odd(Frame& F) {
    const bf16* Y = (const bf16*)(F.ws + WS_Y); bf16* H = (bf16*)(F.ws + WS_H);
    const float* lg = F.in[IN_LNG] + 2 * DM; const float* lb = F.in[IN_LNB] + 2 * DM;
    const float* wr = F.in[IN_ROUTER];
    unsigned* cnt = (unsigned*)(F.ws + WS_CTL) + CW_CNT; int* TOK = (int*)(F.ws + WS_TOK); int* LIST = (int*)(F.ws + WS_LIST);
    for (int row = F.gw; row < ML; row += F.NGW) {
        const int cond = row >> 11;
        f32x4 x[4], y[4], g[4], h[4]; ld_row_f32(F.out + (size_t)row * DM, F.lane, x); ld_row_bf16(Y + (size_t)row * DM, F.lane, y); ld_row_f32(mods_ptr(F, 1, cond, 2), F.lane, g);
#pragma unroll
        for (int j = 0; j < 4; ++j) x[j] = ALPHA * x[j] + g[j] * y[j];
        ln_row(x, lg, lb, F.lane);
        st_row_f32(F.out + (size_t)row * DM, F.lane, x);
        modulate_row(h, x, mods_ptr(F, 1, cond, 3), mods_ptr(F, 1, cond, 4), F.lane);
        st_row_bf16(H + (size_t)row * DM, F.lane, h);
        float lg8[8];
#pragma unroll
        for (int e = 0; e < 8; ++e) lg8[e] = 0.f;
#pragma unroll
        for (int j = 0; j < 4; ++j)
#pragma unroll
            for (int q = 0; q < 4; ++q) { const int d = 4 * F.lane + 256 * j + q; const f32x4 w0 = *(const f32x4*)(wr + (size_t)d * 8), w1 = *(const f32x4*)(wr + (size_t)d * 8 + 4); const float hv = h[j][q];
#pragma unroll
                for (int e = 0; e < 4; ++e) { lg8[e] += hv * w0[e]; lg8[4 + e] += hv * w1[e]; } }
#pragma unroll
        for (int e = 0; e < 8; ++e) lg8[e] = wave_sum(lg8[e]);
        if (F.lane == 0) {
            int e0 = 0; float v0 = lg8[0];
#pragma unroll
            for (int e = 1; e < 8; ++e) if (lg8[e] > v0) { v0 = lg8[e]; e0 = e; }
            int e1 = -1; float v1 = -INFINITY;
#pragma unroll
            for (int e = 0; e < 8; ++e) if (e != e0 && lg8[e] > v1) { v1 = lg8[e]; e1 = e; }
            const float p1 = 1.f / (1.f + __expf(v0 - v1)), p0 = 1.f - p1;
            const int pos0 = (int)atomicAdd(cnt + e0, 1u), pos1 = (int)atomicAdd(cnt + e1, 1u);
            LIST[e0 * ML + pos0] = row; LIST[e1 * ML + pos1] = row;
            int* tk = TOK + (size_t)row * 8; tk[0] = e0; tk[1] = pos0; tk[2] = e1; tk[3] = pos1; tk[4] = __builtin_bit_cast(int, p0); tk[5] = __builtin_bit_cast(int, p1);
        }
    }
}
__device__ __forceinline__ void p24_final(Frame& F) {
    const bf16* YS = (const bf16*)(F.ws + WS_YS);
    const float* lg = F.in[IN_LNG] + 3 * DM; const float* lb = F.in[IN_LNB] + 3 * DM;
    const unsigned* cnt = (const unsigned*)(F.ws + WS_CTL) + CW_CNT; const int* TOK = (const int*)(F.ws + WS_TOK);
    int pbase[8]; { int a = 0;
#pragma unroll
        for (int e = 0; e < 8; ++e) { pbase[e] = a; a += ((int)cnt[e] + 255) >> 8; } }
    for (int row = F.gw; row < ML; row += F.NGW) {
        const int cond = row >> 11;
        const int* tk = TOK + (size_t)row * 8; const int e0 = tk[0], pos0 = tk[1], e1 = tk[2], pos1 = tk[3]; const float p0 = __builtin_bit_cast(float, tk[4]), p1 = __builtin_bit_cast(float, tk[5]);
        int pb0 = 0, pb1 = 0;
#pragma unroll
        for (int e = 0; e < 8; ++e) { pb0 = (e == e0) ? pbase[e] : pb0; pb1 = (e == e1) ? pbase[e] : pb1; }
        const size_t s0 = (size_t)pb0 * 256 + pos0, s1 = (size_t)pb1 * 256 + pos1;
        f32x4 x[4], ya[4], yb[4], g[4]; ld_row_f32(F.out + (size_t)row * DM, F.lane, x); ld_row_bf16(YS + s0 * DM, F.lane, ya); ld_row_bf16(YS + s1 * DM, F.lane, yb); ld_row_f32(mods_ptr(F, 1, cond, 5), F.lane, g);
#pragma unroll
        for (int j = 0; j < 4; ++j) x[j] = ALPHA * x[j] + g[j] * (p0 * ya[j] + p1 * yb[j]);
        ln_row(x, lg, lb, F.lane);
        st_row_f32(F.out + (size_t)row * DM, F.lane, x);
    }
}

struct MoeOrder {
    int cum[9]; int cnt[8]; int p0, p1, nN, nwg, G, c; int gather; const int* list; unsigned long long bstep; int ocw;
    __device__ __forceinline__ void init(const unsigned* counts, int chunk, int nN_, int G_, int c_, int gather_, const int* list_, int ldb, int ocw_) {
        int a = 0;
#pragma unroll
        for (int e = 0; e < 8; ++e) { cnt[e] = (int)counts[e]; cum[e] = a; a += (cnt[e] + 255) >> 8; }
        cum[8] = a;
        p0 = chunk * MOE_CH; p1 = min(p0 + MOE_CH, a); if (p1 < p0) p1 = p0;
        nN = nN_; nwg = (p1 - p0) * nN; G = G_; c = c_; gather = gather_; list = list_; bstep = (unsigned long long)256 * ldb * 2; ocw = ocw_;
    }
    __device__ __forceinline__ bool next(int i, pg8::Unit& u) const {
        const long L = (long)i * G + c; if (L >= nwg) return false;
        int wgid = (int)L; { const int q = nwg / 8, r = nwg % 8, xcd = wgid % 8, off = wgid / 8; wgid = (xcd < r ? xcd * (q + 1) : r * (q + 1) + (xcd - r) * q) + off; }
        const int nM = p1 - p0, nig = 8 * nN, gid = wgid / nig, fm = gid * 8, gsz = (nM - fm) < 8 ? (nM - fm) : 8;
        const int pml = fm + ((wgid % nig) % gsz), pn = (wgid % nig) / gsz;
        const int pm = p0 + pml; int e = 0;
#pragma unroll
        for (int k = 1; k < 8; ++k) e += (pm >= cum[k]) ? 1 : 0;
        int ce = 0, cme = 0;
#pragma unroll
        for (int k = 0; k < 8; ++k) { ce = (k == e) ? cnt[k] : ce; cme = (k == e) ? cum[k] : cme; }
        u.pm = pm; u.pn = pn; u.aux = e | ((pm - cme) << 4) | (ce << 12);
        u.bofs = (unsigned long long)(e * nN + pn) * bstep;
        u.orow0 = gather ? pml * 256 : pm * 256; u.ocol0 = pn * ocw;
        return true;
    }
    __device__ __forceinline__ int arow(const pg8::Unit& u, int r) const {
        if (gather) { const int e = u.aux & 15, lp = (u.aux >> 4) & 255, ce = u.aux >> 12; const int idx = lp * 256 + r; return idx < ce ? list[e * ML + idx] : 0; }
        return (u.pm - p0) * 256 + r;
    }
};
struct DftCOrder {
    int G, c;
    __device__ __forceinline__ bool next(int i, pg8::Unit& u) const {
        const int L = i * G + c; if (L >= 512) return false;
        u.pm = L & 3; u.pn = L >> 2; u.orow0 = 0; u.ocol0 = 0; u.aux = 0;
        u.bofs = ((unsigned long long)u.pn * 256 * O_IN + (u.pm >> 1) * 256) * 2; return true;
    }
    __device__ __forceinline__ int arow(const pg8::Unit& u, int r) const { return u.pm * 256 + r; }
};
struct DftLOrder {
    int G, vcu;
    __device__ __forceinline__ bool next(int i, pg8::Unit& u) const {
        const int L = i * G + vcu; if (L >= 256) return false;
        const int b = L >> 4; u.pm = (L >> 1) & 7; u.pn = L & 1; u.orow0 = b * SEQ + u.pm * 256; u.ocol0 = u.pn * 256; u.aux = 0;
        u.bofs = ((unsigned long long)(b * 512 + u.pn * 256) * 4096) * 2; return true;
    }
    __device__ __forceinline__ int arow(const pg8::Unit& u, int r) const { return u.pm * 256 + r; }
};

constexpr int NPH = 17 + 2 * MOE_NCH;
struct Args { const float* in[26]; float* out; unsigned char* ws; int ph_lo, ph_hi; int use_bar, pad; };

__global__ void __launch_bounds__(NWAVES * 64, 2) fwd(Args args) {
    extern __shared__ __attribute__((aligned(16))) unsigned char lds_raw[];
    Frame F;
    F.lds = (LAS unsigned char*)lds_raw;
    F.tid = threadIdx.x; F.lane = F.tid & 63; F.wave = __builtin_amdgcn_readfirstlane(F.tid >> 6);
    F.G = gridDim.x; { const int bx = blockIdx.x; F.vcu = (F.G % 8 == 0) ? (bx % 8) * (F.G / 8) + bx / 8 : bx; }
    F.gw = F.vcu * NWAVES + F.wave; F.NGW = F.G * NWAVES;
#pragma unroll
    for (int i = 0; i < 26; ++i) F.in[i] = args.in[i];
    F.out = args.out; F.ws = args.ws;
    volatile LAS unsigned* MISC = (volatile LAS unsigned*)(F.lds + MISC_OFF);
    for (int u = F.tid; u < (LDS_BYTES - RING_BYTES) / 4; u += NWAVES * 64) ((LAS unsigned*)(F.lds + RING_BYTES))[u] = 0u;
    __syncthreads();
    unsigned* ctl = (unsigned*)(args.ws + WS_CTL);
    XcdBarrier bar; bar.bar = ctl + CW_BAR; bar.x = 0; bar.st = nullptr;
    if (args.use_bar) bar = xcd_barrier_post(ctl + CW_BAR, MISC + 8);
    const int lo = args.ph_lo, hi = args.ph_hi;
#ifndef PH_MASK
#define PH_MASK 0xffffffffu
#endif
#define IN(k) (((PH_MASK >> ((k) > 16 ? 16 + (((k) - 16) & 1) : (k))) & 1u) && lo <= (k) && (k) < hi)
#define SEAM(k) do { if (IN(k) && IN((k) + 1)) xcd_barrier(bar); } while (0)
    bf16* const H = (bf16*)(F.ws + WS_H); bf16* const CAT = (bf16*)(F.ws + WS_CAT); bf16* const Y = (bf16*)(F.ws + WS_Y); bf16* const BIG = (bf16*)(F.ws + WS_BIG);

    if (IN(0)) { p0_prologue(F); SEAM(0); }
    if (IN(1)) { p1_modulate(F); SEAM(1); }
    if (IN(2)) {
        pg8::Gemm g{H, (const bf16*)(F.ws + WS_WEIN), DM, DM, DM}; pg8::DenseOrder S; S.init(MT / 256, E_IN / 256, F.G, blockIdx.x, 256, DM);
        EpiPlain E{BIG, E_IN, 1.f}; pg8::gemm_phase(F.lds, g, S, E); SEAM(2); }
    if (IN(3)) { p3_rope_conv(F); SEAM(3); }
    if (IN(4)) { p4_diff_attn(F); SEAM(4); }
    if (IN(5)) {
        pg8::Gemm g{CAT, (const bf16*)(F.ws + WS_WEO), DM, DM, DM}; pg8::DenseOrder S; S.init(MT / 256, DM / 256, F.G, blockIdx.x, 256, DM);
        EpiPlain E{Y, DM, 1.f}; pg8::gemm_phase(F.lds, g, S, E); SEAM(5); }
    if (IN(6)) { p6_ln1_even(F); SEAM(6); }
    if (IN(7)) {
        pg8::Gemm g{H, (const bf16*)(F.ws + WS_WGU), DM, DM, DM}; pg8::DenseOrder S; S.init(MT / 256, 2 * FF / 256, F.G, blockIdx.x, 128, DM);
        EpiSwiglu E{BIG, FF}; pg8::gemm_phase(F.lds, g, S, E); SEAM(7); }
    if (IN(8)) {
        pg8::Gemm g{BIG, (const bf16*)(F.ws + WS_WDN), FF, FF, FF}; pg8::DenseOrder S; S.init(MT / 256, DM / 256, F.G, blockIdx.x, 256, FF);
        EpiPlain E{Y, DM, 1.f}; pg8::gemm_phase(F.lds, g, S, E); SEAM(8); }
    if (IN(9)) { p9_ln2_even(F); SEAM(9); }
    if (IN(10)) {
        pg8::Gemm g{H, (const bf16*)(F.ws + WS_WOIN), DM, DM, DM}; pg8::DenseOrder S; S.init(MT / 256, O_IN / 256, F.G, blockIdx.x, 256, DM);
        EpiPlain E{BIG, O_IN, 1.f}; pg8::gemm_phase(F.lds, g, S, E); SEAM(10); }
    if (IN(11)) { p11_na_attn(F); SEAM(11); }
    if (IN(12)) {
        pg8::Gemm g{(const bf16*)(F.ws + WS_DFTC), BIG, 256, O_IN, 256}; DftCOrder S{F.G, (int)blockIdx.x};
        EpiDftC E{Y, (const float*)(F.ws + WS_GN)}; pg8::gemm_phase(F.lds, g, S, E); SEAM(12); }
    if (IN(13)) {
        pg8::Gemm g{(const bf16*)(F.ws + WS_DFTL), Y, 4096, 4096, 4096}; DftLOrder S{F.G, F.vcu};
        EpiPlain E{CAT, DM, 1.f / 512.f}; pg8::gemm_phase(F.lds, g, S, E); SEAM(13); }
    if (IN(14)) {
        pg8::Gemm g{CAT, (const bf16*)(F.ws + WS_WOO), DM, DM, DM}; pg8::DenseOrder S; S.init(ML / 256, DM / 256, F.G, blockIdx.x, 256, DM);
        EpiPlain E{Y, DM, 1.f}; pg8::gemm_phase(F.lds, g, S, E);
        __syncthreads(); conv_experts(F); SEAM(14); }
    if (IN(15)) { p15_ln1_odd(F); SEAM(15); }
    for (int ch = 0; ch < MOE_NCH; ++ch) {
        if (IN(16 + 2 * ch)) {
            pg8::Gemm g{H, (const bf16*)(F.ws + WS_EWGU), DM, DM, DM}; MoeOrder S; S.init((const unsigned*)ctl + CW_CNT, ch, 2 * FFE / 256, F.G, blockIdx.x, 1, (const int*)(F.ws + WS_LIST), DM, 128);
            EpiSwiglu E{BIG, FFE}; pg8::gemm_phase(F.lds, g, S, E); SEAM(16 + 2 * ch); }
        if (IN(17 + 2 * ch)) {
            pg8::Gemm g{BIG, (const bf16*)(F.ws + WS_EWDN), FFE, FFE, FFE}; MoeOrder S; S.init((const unsigned*)ctl + CW_CNT, ch, DM / 256, F.G, blockIdx.x, 0, nullptr, FFE, 256);
            EpiPlain E{(bf16*)(F.ws + WS_YS), DM, 1.f}; pg8::gemm_phase(F.lds, g, S, E); SEAM(17 + 2 * ch); }
    }
    if (IN(NPH - 1)) { p24_final(F); }
#undef IN
#undef SEAM
}

extern "C" void kernel_launch(void* const* d_in, const int* in_sizes, int n_in, void* d_out, int out_size, void* d_ws, size_t ws_size, hipStream_t stream) {
    static int grid = 0;
    if (grid == 0) {
        if (n_in != 26 || out_size != ML * DM || ws_size < WS_END) { fprintf(stderr, "kernel_launch: unexpected problem (n_in %d out %d ws %zu)\n", n_in, out_size, ws_size); grid = -1; return; }
        int dev = 0, cus = 0;
        if (hipGetDevice(&dev) != hipSuccess || hipDeviceGetAttribute(&cus, hipDeviceAttributeMultiprocessorCount, dev) != hipSuccess) { grid = -1; return; }
        if (hipFuncSetAttribute((const void*)fwd, hipFuncAttributeMaxDynamicSharedMemorySize, LDS_BYTES) != hipSuccess) { grid = -1; return; }
        grid = cus;
    }
    if (grid < 0) return;
    (void)hipMemsetAsync((char*)d_ws + WS_CTL, 0, CTL_ZERO_BYTES, stream);
    Args a{};
    for (int i = 0; i < 26; ++i) a.in[i] = (const float*)d_in[i];
    a.out = (float*)d_out; a.ws = (unsigned char*)d_ws;
#if MK_LAUNCH_PER_PHASE
    a.use_bar = 0;
    for (int ph = 0; ph < NPH; ++ph) { a.ph_lo = ph; a.ph_hi = ph + 1; hipLaunchKernelGGL(fwd, dim3(grid), dim3(NWAVES * 64), LDS_BYTES, stream, a); }
#else
    a.use_bar = 1; a.ph_lo = 0; a.ph_hi = NPH;
    hipLaunchKernelGGL(fwd, dim3(grid), dim3(NWAVES * 64), LDS_BYTES, stream, a);
#endif
}
```

```cpp
#include <hip/hip_runtime.h>
#include <cstdio>
#include <cstdint>

#ifndef MK_LAUNCH_PER_PHASE
#define MK_LAUNCH_PER_PHASE 0
#endif

#define GAS __attribute__((address_space(1)))
#define LAS __attribute__((address_space(3)))
typedef unsigned short bf16;
typedef short bf16x8 __attribute__((ext_vector_type(8)));
typedef short s16x4 __attribute__((ext_vector_type(4)));
typedef float f32x4 __attribute__((ext_vector_type(4)));
typedef float f32x16 __attribute__((ext_vector_type(16)));
typedef unsigned u32x4 __attribute__((ext_vector_type(4)));
typedef unsigned u32x2 __attribute__((ext_vector_type(2)));

constexpr int NB = 16, SEQ = 2048, DM = 1024, LC = 256, GW = 64;
constexpr int ML = NB * SEQ;
constexpr int MC = NB * LC;
constexpr int MT = ML + MC;
constexpr int E_IN = 3072, FF = 2816, O_IN = 2048, NEXP = 8, FFE = 3584;
constexpr int NCOND = 17;
constexpr float LN_EPS = 1e-5f, RMS_EPS = 1e-5f;
constexpr float ALPHA = 1.41421356237309515f;
constexpr int MOE_CH = 64, MOE_NCH = 5;

constexpr size_t MiB = 1u << 20;
constexpr size_t WS_CTL = 0, CTL_ZERO_BYTES = 2 * MiB;
constexpr size_t WS_MODS = 2 * MiB;
constexpr size_t WS_ROPE = 3 * MiB;
constexpr size_t WS_TOK  = 4 * MiB;
constexpr size_t WS_LIST = 5 * MiB;
constexpr size_t WS_GN   = 6 * MiB;
constexpr size_t WS_MISC = 7 * MiB;
constexpr size_t WS_WEIN = 8 * MiB;
constexpr size_t WS_WEO  = 14 * MiB;
constexpr size_t WS_WGU  = 16 * MiB;
constexpr size_t WS_WDN  = 27 * MiB;
constexpr size_t WS_WOIN = 33 * MiB;
constexpr size_t WS_WOO  = 37 * MiB;
constexpr size_t WS_DFTC = 39 * MiB;
constexpr size_t WS_DFTL = 40 * MiB;
constexpr size_t WS_XC   = 56 * MiB;
constexpr size_t WS_H    = 72 * MiB;
constexpr size_t WS_CAT  = 144 * MiB;
constexpr size_t WS_Y    = 216 * MiB;
constexpr size_t WS_YS   = 144 * MiB;
constexpr size_t WS_BIG  = 288 * MiB;
constexpr size_t WS_EWGU = WS_BIG + 112 * MiB;
constexpr size_t WS_EWDN = WS_EWGU + 112 * MiB;
constexpr size_t WS_END  = WS_EWDN + 56 * MiB;
static_assert(WS_END <= 589 * MiB, "workspace");
static_assert((size_t)MOE_CH * 256 * FFE * 2 <= 112 * MiB, "HID2 chunk");

constexpr int CW_BAR = 4096;
constexpr int CW_CNT = 64;
constexpr int NWAVES = 8;
constexpr int RING_BYTES = 131072;
constexpr int MISC_OFF = RING_BYTES + 320;
constexpr int LDS_BYTES = 147456;

__device__ __forceinline__ unsigned f2bf(float f) { unsigned u = __builtin_bit_cast(unsigned, f); return (u + 0x7fffu + ((u >> 16) & 1u)) >> 16; }
__device__ __forceinline__ unsigned pk2(float lo, float hi) { return f2bf(lo) | (f2bf(hi) << 16); }
__device__ __forceinline__ unsigned cvt_pk_bf16(float lo, float hi) { unsigned r; asm volatile("v_cvt_pk_bf16_f32 %0, %1, %2" : "=v"(r) : "v"(lo), "v"(hi)); return r; }
__device__ __forceinline__ float bf_lo(unsigned w) { return __builtin_bit_cast(float, w << 16); }
__device__ __forceinline__ float bf_hi(unsigned w) { return __builtin_bit_cast(float, w & 0xffff0000u); }
__device__ __forceinline__ float wave_sum(float v) {
#pragma unroll
    for (int o = 1; o < 64; o <<= 1) v += __shfl_xor(v, o);
    return v;
}
__device__ __forceinline__ float silu_f(float g) { return g / (1.f + __expf(-g)); }

#define XB_TMO      128
#define XB_XCNT(j)  (256  + 64 * (j))
#define XB_XSUB(j)  (1280 + 64 * (j))
#define XB_XGEN(j)  (2304 + 64 * (j))
#define XB_TOP      3328
#define XB_TOPGEN   3392
#define XCD_BAR_WORDS 3456
#define XB_SPIN_CAP (1u << 18)
__device__ __forceinline__ unsigned xb_ld(unsigned* p)              { return __hip_atomic_load(p, __ATOMIC_RELAXED, __HIP_MEMORY_SCOPE_AGENT); }
__device__ __forceinline__ unsigned xb_add(unsigned* p, unsigned v) { return __hip_atomic_fetch_add(p, v, __ATOMIC_RELAXED, __HIP_MEMORY_SCOPE_AGENT); }
__device__ __forceinline__ unsigned xb_xcc_id() { return (unsigned)__builtin_amdgcn_s_getreg((3 << 11) | 20) & 0xFu; }
#define XB_SPIN(cond, bar) do { unsigned _sp = 0; while (cond) { __builtin_amdgcn_s_sleep(1); \
    if ((++_sp & 255u) == 0u) { if (xb_ld(&(bar)[XB_TMO])) break; if (_sp > XB_SPIN_CAP) { atomicAdd(&(bar)[XB_TMO], 1u); break; } } } } while (0)
struct XcdBarrier { unsigned* bar; unsigned x; volatile LAS unsigned* st; };
__device__ __forceinline__ XcdBarrier xcd_barrier_post(unsigned* bar, volatile LAS unsigned* st) {
    XcdBarrier b; b.bar = bar; b.x = xb_xcc_id(); b.st = st;
    if (threadIdx.x == 0) (void)xb_add(&bar[XB_XCNT(b.x)], 1u);
    return b;
}
__device__ __forceinline__ void xcd_barrier_complete(unsigned* bar, unsigned x, unsigned& nloc, unsigned& nx) {
    const unsigned G = gridDim.x * gridDim.y * gridDim.z;
    unsigned sum, cnt, mine, sp = 0u;
    for (;;) {
        sum = 0u; cnt = 0u; mine = 0u;
#pragma unroll
        for (unsigned j = 0; j < 16; ++j) { const unsigned c = xb_ld(&bar[XB_XCNT(j)]); sum += c; cnt += (c > 0u) ? 1u : 0u; mine = (j == x) ? c : mine; }
        if (sum == G) break;
        __builtin_amdgcn_s_sleep(1);
        if ((++sp & 255u) == 0u) { if (xb_ld(&bar[XB_TMO])) break; if (sp > XB_SPIN_CAP) { atomicAdd(&bar[XB_TMO], 1u); break; } }
    }
    nloc = mine > 0u ? mine : 1u; nx = cnt > 0u ? cnt : 1u;
}
__device__ __forceinline__ void xcd_barrier(const XcdBarrier& b) {
    asm volatile("s_waitcnt vmcnt(0)" ::: "memory");
    __syncthreads();
    if (threadIdx.x == 0) {
        unsigned* bar = b.bar;
        __builtin_amdgcn_s_waitcnt(0);
        unsigned nloc = b.st[0], nx = b.st[1];
        if (nloc == 0u) { xcd_barrier_complete(bar, b.x, nloc, nx); b.st[0] = nloc; b.st[1] = nx; }
        const unsigned old = xb_add(&bar[XB_XSUB(b.x)], 1u);
        const unsigned gen = old / nloc;
        if (old + 1u == (gen + 1u) * nloc) {
            __builtin_amdgcn_fence(__ATOMIC_RELEASE, "agent");
            asm volatile("s_waitcnt vmcnt(0)" ::: "memory");
            const unsigned og = xb_add(&bar[XB_TOP], 1u);
            const unsigned tg = og / nx;
            if (og + 1u == (tg + 1u) * nx) xb_add(&bar[XB_TOPGEN], 1u);
            else XB_SPIN(xb_ld(&bar[XB_TOPGEN]) == tg, bar);
            __builtin_amdgcn_fence(__ATOMIC_ACQUIRE, "agent");
            xb_add(&bar[XB_XGEN(b.x)], 1u);
            asm volatile("s_waitcnt vmcnt(0)" ::: "memory");
        } else {
            XB_SPIN(xb_ld(&bar[XB_XGEN(b.x)]) == gen, bar);
            __builtin_amdgcn_fence(__ATOMIC_ACQUIRE, "agent");
            asm volatile("s_waitcnt vmcnt(0)" ::: "memory");
        }
    }
    __syncthreads();
}

namespace pg8 {
constexpr int BM = 256, BK = 64, HALF = 128, HTB = HALF * BK * 2, STAGE_BYTES = 8 * HTB, NXCD = 8, WGM = 8;
__host__ __device__ __forceinline__ int lds_byte(int r, int c) { const int st = (r >> 4) * 2 + (c >> 5), rr = r & 15, cc = c & 31, ob = rr * 64 + cc * 2; return st * 1024 + (ob ^ (((ob >> 9) & 1) << 5)); }
__host__ __device__ __forceinline__ void stage_rc(int b, int& R, int& C) { const int st = b / 1024, sb = b % 1024, swz = sb ^ (((sb >> 9) & 1) << 5); R = (st >> 1) * 16 + swz / 64; C = (st & 1) * 32 + (swz % 64) / 2; }
__host__ __device__ __forceinline__ int perm32(int rho) { const int n = rho >> 4, i = rho & 15; return 8 * (i >> 2) + 4 * n + (i & 3); }

struct Unit { int pm, pn; int orow0, ocol0; unsigned long long bofs; int aux; };
struct Gemm { const bf16* A; const bf16* Bt; int lda, ldb, K; };

template <class Epi, class Sched>
__device__ __forceinline__ void gemm_phase(LAS unsigned char* lds, const Gemm g, const Sched& S, const Epi& E) {
    const int tid = threadIdx.x, wid = __builtin_amdgcn_readfirstlane(tid >> 6), lane = tid & 63, wr = wid >> 2, wc = wid & 3, fr = lane & 15, fq = lane >> 4;
    const int K = g.K, nt = K / BK;
    int Rr[2]; unsigned Cb[2], voffB[2];
#pragma unroll
    for (int i = 0; i < 2; ++i) { int R, C; stage_rc(tid * 16 + i * 8192, R, C); const int Rb = (R & ~31) + perm32(R & 31);
        Rr[i] = R; Cb[i] = (unsigned)C * 2u; voffB[i] = (unsigned)(Rb * g.ldb + C) * 2u; }
    const size_t kstep = (size_t)(BK * 2);
    const size_t hstepB = (size_t)HALF * g.ldb * 2;
    const unsigned lda2 = (unsigned)g.lda * 2u;
    const unsigned ldsw = (unsigned)wid * 1024u;
    const int aoff = lds_byte(wr * 64 + fr, fq * 8), boff = lds_byte(wc * 32 + fr, fq * 8);
#define PG8_SA(b, h) (((b) * 2 + (h)) * HTB)
#define PG8_SB(b, h) ((4 + (b) * 2 + (h)) * HTB)
#define PG8_STAGE(bufoff, gbase, voff) do { _Pragma("unroll") for (int _i = 0; _i < 2; ++_i) \
        __builtin_amdgcn_global_load_lds((const unsigned*)((const char*)(gbase) + (voff)[_i]), (LAS unsigned*)(lds + (bufoff) + ldsw + _i * 8192), 16, 0, 0); } while (0)
#define PG8_LDA(dst, b, h) do { _Pragma("unroll") for (int m = 0; m < 4; ++m) _Pragma("unroll") for (int k = 0; k < 2; ++k) dst[m][k] = *(const LAS bf16x8*)(lds + PG8_SA(b, h) + aoff + m * 2048 + k * 1024); } while (0)
#define PG8_LDB(dst, b, h) do { _Pragma("unroll") for (int n = 0; n < 2; ++n) _Pragma("unroll") for (int k = 0; k < 2; ++k) dst[n][k] = *(const LAS bf16x8*)(lds + PG8_SB(b, h) + boff + n * 2048 + k * 1024); } while (0)
#define PG8_MMA(ai, bj, At, Bt) do { __builtin_amdgcn_s_setprio(1); _Pragma("unroll") for (int m = 0; m < 4; ++m) _Pragma("unroll") for (int n = 0; n < 2; ++n) _Pragma("unroll") for (int k = 0; k < 2; ++k) \
        acc[ai][bj][m][n] = __builtin_amdgcn_mfma_f32_16x16x32_bf16(Bt[n][k], At[m][k], acc[ai][bj][m][n], 0, 0, 0); __builtin_amdgcn_s_setprio(0); } while (0)
#define PG8_WAIT_V(n) asm volatile("s_waitcnt vmcnt(" #n ")" ::: "memory")
#define PG8_WAIT_L(n) asm volatile("s_waitcnt lgkmcnt(" #n ")" ::: "memory")
#define PG8_BAR __builtin_amdgcn_s_barrier()
#define PG8_SCHED __builtin_amdgcn_sched_barrier(0)
#define PG8_AOFF(dst, u) do { _Pragma("unroll") for (int _h = 0; _h < 2; ++_h) _Pragma("unroll") for (int _i = 0; _i < 2; ++_i) \
        dst[_h][_i] = (unsigned)S.arow(u, _h * HALF + Rr[_i]) * lda2 + Cb[_i]; } while (0)
    Unit cur, nxt; int ui = 0;
    if (!S.next(0, cur)) return;
    f32x4 acc[2][2][4][2];
#pragma unroll
    for (int a = 0; a < 2; ++a)
#pragma unroll
        for (int b = 0; b < 2; ++b)
#pragma unroll
            for (int m = 0; m < 4; ++m)
#pragma unroll
                for (int n = 0; n < 2; ++n) acc[a][b][m][n] = (f32x4){0.f, 0.f, 0.f, 0.f};
    bf16x8 At[4][2], B0[2][2], B1[2][2];
    unsigned aoc[2][2], aon[2][2];
    PG8_AOFF(aoc, cur);
    const char* const Ab = (const char*)g.A;
    const char* cB = (const char*)g.Bt + cur.bofs;
    PG8_STAGE(PG8_SB(0, 0), cB, voffB); PG8_STAGE(PG8_SB(0, 1), cB + hstepB, voffB); PG8_STAGE(PG8_SA(0, 0), Ab, aoc[0]); PG8_STAGE(PG8_SA(0, 1), Ab, aoc[1]);
    if (wr == 1) PG8_BAR;
    PG8_WAIT_V(2); PG8_BAR;
    PG8_STAGE(PG8_SB(1, 0), cB + kstep, voffB); PG8_STAGE(PG8_SA(1, 0), Ab + kstep, aoc[0]); PG8_STAGE(PG8_SB(1, 1), cB + hstepB + kstep, voffB);
    PG8_WAIT_V(6); PG8_BAR;
    for (;;) {
        const bool has_next = S.next(ui + 1, nxt);
        const char* nB = has_next ? (const char*)g.Bt + nxt.bofs : cB;
        if (has_next) { PG8_AOFF(aon, nxt); } else {
#pragma unroll
            for (int h = 0; h < 2; ++h)
#pragma unroll
                for (int i = 0; i < 2; ++i) aon[h][i] = aoc[h][i]; }
#pragma unroll 1
        for (int t = 0; t < nt; t += 2) {
            const bool last = (t == nt - 2);
            const char* a1 = Ab + (size_t)(t + 1) * kstep;
            const char* a2 = last ? Ab : Ab + (size_t)(t + 2) * kstep; const char* b2 = last ? nB : cB + (size_t)(t + 2) * kstep;
            const char* a3 = a2 + kstep; const char* b3 = b2 + kstep;
            unsigned ao2[2][2];
#pragma unroll
            for (int h = 0; h < 2; ++h)
#pragma unroll
                for (int i = 0; i < 2; ++i) ao2[h][i] = last ? aon[h][i] : aoc[h][i];
            PG8_LDB(B0, 0, 0); PG8_LDB(B1, 0, 1); PG8_SCHED; PG8_LDA(At, 0, 0); PG8_STAGE(PG8_SA(1, 1), a1, aoc[1]);
            PG8_WAIT_V(8); PG8_WAIT_L(0); PG8_BAR; PG8_MMA(0, 0, At, B0); PG8_MMA(0, 1, At, B1); PG8_BAR; PG8_SCHED;
            PG8_LDA(At, 0, 1); PG8_STAGE(PG8_SB(0, 0), b2, voffB); PG8_STAGE(PG8_SB(0, 1), b2 + hstepB, voffB); PG8_STAGE(PG8_SA(0, 0), a2, ao2[0]);
            PG8_WAIT_V(8); PG8_WAIT_L(0); PG8_BAR; PG8_MMA(1, 0, At, B0); PG8_MMA(1, 1, At, B1); PG8_BAR; PG8_SCHED;
            PG8_LDB(B0, 1, 0); PG8_LDB(B1, 1, 1); PG8_SCHED; PG8_LDA(At, 1, 0); PG8_STAGE(PG8_SA(0, 1), a2, ao2[1]);
            PG8_WAIT_V(8); PG8_WAIT_L(0); PG8_BAR; PG8_MMA(0, 0, At, B0); PG8_MMA(0, 1, At, B1); PG8_BAR; PG8_SCHED;
            PG8_LDA(At, 1, 1); PG8_STAGE(PG8_SB(1, 0), b3, voffB); PG8_STAGE(PG8_SB(1, 1), b3 + hstepB, voffB); PG8_STAGE(PG8_SA(1, 0), a3, ao2[0]);
            PG8_WAIT_V(8); PG8_WAIT_L(0); PG8_BAR; PG8_MMA(1, 0, At, B0); PG8_MMA(1, 1, At, B1); PG8_BAR; PG8_SCHED;
        }
        if (wr == 0) PG8_BAR;
        E(acc, cur, wr, wc, fr, fq);
        if (!has_next) break;
#pragma unroll
        for (int a = 0; a < 2; ++a)
#pragma unroll
            for (int b = 0; b < 2; ++b)
#pragma unroll
                for (int m = 0; m < 4; ++m)
#pragma unroll
                    for (int n = 0; n < 2; ++n) acc[a][b][m][n] = (f32x4){0.f, 0.f, 0.f, 0.f};
        cur = nxt; cB = nB; ++ui;
#pragma unroll
        for (int h = 0; h < 2; ++h)
#pragma unroll
            for (int i = 0; i < 2; ++i) aoc[h][i] = aon[h][i];
        if (wr == 1) PG8_BAR;
    }
    PG8_WAIT_V(0);
    PG8_BAR;
#undef PG8_SA
#undef PG8_SB
#undef PG8_STAGE
#undef PG8_LDA
#undef PG8_LDB
#undef PG8_MMA
#undef PG8_WAIT_V
#undef PG8_WAIT_L
#undef PG8_BAR
#undef PG8_SCHED
#undef PG8_AOFF
}

struct DenseOrder {
    int nM, nN, nwg, G, c; int ocw; unsigned long long bstep;
    __device__ __forceinline__ void init(int nM_, int nN_, int G_, int c_, int ocw_, int ldb) { nM = nM_; nN = nN_; nwg = nM * nN; G = G_; c = c_; ocw = ocw_; bstep = (unsigned long long)BM * ldb * 2; }
    __device__ __forceinline__ bool next(int i, Unit& u) const {
        const long L = (long)i * G + c; if (L >= nwg) return false;
        int wgid = (int)L; { const int q = nwg / NXCD, r = nwg % NXCD, xcd = wgid % NXCD, off = wgid / NXCD; wgid = (xcd < r ? xcd * (q + 1) : r * (q + 1) + (xcd - r) * q) + off; }
        const int nig = WGM * nN, gid = wgid / nig, fm = gid * WGM, gsz = (nM - fm) < WGM ? (nM - fm) : WGM;
        u.pm = fm + ((wgid % nig) % gsz); u.pn = (wgid % nig) / gsz;
        u.orow0 = u.pm * BM; u.ocol0 = u.pn * ocw; u.bofs = (unsigned long long)u.pn * bstep; u.aux = 0; return true;
    }
    __device__ __forceinline__ int arow(const Unit& u, int r) const { return u.pm * BM + r; }
};
}

struct EpiPlain {
    bf16* O; int ldc; float scale;
    __device__ __forceinline__ void operator()(const f32x4 (&acc)[2][2][4][2], const pg8::Unit& u, int wr, int wc, int fr, int fq) const {
        const int row0 = u.orow0 + wr * 64 + fr, col0 = u.ocol0 + wc * 32 + 8 * fq;
#pragma unroll
        for (int ai = 0; ai < 2; ++ai)
#pragma unroll
            for (int m = 0; m < 4; ++m) { bf16* rowp = O + (size_t)(row0 + ai * 128 + m * 16) * ldc + col0;
#pragma unroll
                for (int bj = 0; bj < 2; ++bj) { const f32x4 v0 = acc[ai][bj][m][0] * scale, v1 = acc[ai][bj][m][1] * scale;
                    u32x4 w; w.x = cvt_pk_bf16(v0[0], v0[1]); w.y = cvt_pk_bf16(v0[2], v0[3]); w.z = cvt_pk_bf16(v1[0], v1[1]); w.w = cvt_pk_bf16(v1[2], v1[3]);
                    *(u32x4*)(rowp + bj * 128) = w; } }
    }
};
struct EpiSwiglu {
    bf16* O; int ldc;
    __device__ __forceinline__ void operator()(const f32x4 (&acc)[2][2][4][2], const pg8::Unit& u, int wr, int wc, int fr, int fq) const {
        const int row0 = u.orow0 + wr * 64 + fr, col0 = u.ocol0 + wc * 32 + 8 * fq;
#pragma unroll
        for (int ai = 0; ai < 2; ++ai)
#pragma unroll
            for (int m = 0; m < 4; ++m) { bf16* rowp = O + (size_t)(row0 + ai * 128 + m * 16) * ldc + col0;
                float r[8];
#pragma unroll
                for (int n = 0; n < 2; ++n)
#pragma unroll
                    for (int j = 0; j < 4; ++j) { const float gt = acc[ai][0][m][n][j], up = acc[ai][1][m][n][j]; r[n * 4 + j] = silu_f(gt) * up; }
                u32x4 w; w.x = cvt_pk_bf16(r[0], r[1]); w.y = cvt_pk_bf16(r[2], r[3]); w.z = cvt_pk_bf16(r[4], r[5]); w.w = cvt_pk_bf16(r[6], r[7]);
                *(u32x4*)rowp = w; }
    }
};
struct EpiDftC {
    bf16* PQt; const float* gn;
    __device__ __forceinline__ void operator()(const f32x4 (&acc)[2][2][4][2], const pg8::Unit& u, int wr, int wc, int fr, int fq) const {
        const int gi = u.pm, jrow = wr * 64 + fr;
        const int tok0 = u.pn * 256 + wc * 32 + 8 * fq;
#pragma unroll
        for (int bj = 0; bj < 2; ++bj) {
            const int tk = tok0 + bj * 128; const int b = tk >> 11, l = tk & 2047;
            bf16* base = PQt + ((size_t)(b * 512 + gi * 128 + jrow)) * 4096 + l;
            float mu[8], rs[8];
            { const f32x4* p = (const f32x4*)(gn + ((size_t)gi * ML + tk) * 2);
#pragma unroll
              for (int j = 0; j < 4; ++j) { const f32x4 t = p[j]; mu[2 * j] = t[0]; rs[2 * j] = t[1]; mu[2 * j + 1] = t[2]; rs[2 * j + 1] = t[3]; } }
#pragma unroll
            for (int ai = 0; ai < 2; ++ai) {
#pragma unroll
                for (int m = 0; m < 4; ++m) {
                    const float dc = (ai == 0 && m == 0 && jrow == 0) ? 128.f : 0.f;
                    float r[8];
#pragma unroll
                    for (int n = 0; n < 2; ++n)
#pragma unroll
                        for (int j = 0; j < 4; ++j) r[n * 4 + j] = rs[n * 4 + j] * (acc[ai][bj][m][n][j] - mu[n * 4 + j] * dc);
                    u32x4 w; w.x = cvt_pk_bf16(r[0], r[1]); w.y = cvt_pk_bf16(r[2], r[3]); w.z = cvt_pk_bf16(r[4], r[5]); w.w = cvt_pk_bf16(r[6], r[7]);
                    *(u32x4*)(base + (size_t)m * 16 * 4096 + ai * 2048) = w; }
                asm volatile("" ::: "memory"); }
        }
    }
};

struct Frame {
    LAS unsigned char* lds;
    int tid, lane, wave, G, vcu, gw, NGW;
    const float* in[26];
    float* out; unsigned char* ws;
};
#define IN_X 0
#define IN_C 1
#define IN_CTX 2
#define IN_CCTX 3
#define IN_WMOD 4
#define IN_BMOD 5
#define IN_LNG 6
#define IN_LNB 7
#define IN_EWIN 8
#define IN_ECONV 9
#define IN_LQ1 10
#define IN_LK1 11
#define IN_LQ2 12
#define IN_LK2 13
#define IN_SUBG 14
#define IN_EWO 15
#define IN_EGATE 16
#define IN_EUP 17
#define IN_EDOWN 18
#define IN_OWIN 19
#define IN_RPB 20
#define IN_OWO 21
#define IN_ROUTER 22
#define IN_XGATE 23
#define IN_XUP 24
#define IN_XDOWN 25

__device__ __forceinline__ const float* mods_ptr(const Frame& F, int layer, int cond, int which) { return (const float*)(F.ws + WS_MODS) + ((size_t)(layer * NCOND + cond) * 6 + which) * DM; }
__device__ __forceinline__ int cond_of_row(int row) { return row < ML ? (row >> 11) : NCOND - 1; }

__device__ __forceinline__ void conv_item(const float* W, int K, int N, bf16* WT, int mode, LAS float* scr, int item, int lane) {
    const int nblk = N / 32, kb = item / nblk, nb = item % nblk, k0 = 64 * kb, n0 = 32 * nb;
#pragma unroll 8
    for (int i = 0; i < 32; ++i) { const int kk = 2 * i + (lane >> 5); scr[kk * 33 + (lane & 31)] = W[(size_t)(k0 + kk) * N + n0 + (lane & 31)]; }
    asm volatile("s_waitcnt lgkmcnt(0)" ::: "memory");
    const int d0 = (mode == 0) ? n0 : ((n0 >> 7) * 256 + (n0 & 127) + (mode == 2 ? 128 : 0));
    const int c = lane & 7;
#pragma unroll
    for (int j = 0; j < 4; ++j) { const int n = (lane >> 3) + 8 * j; const LAS float* s = scr + (8 * c) * 33 + n;
        u32x4 o; o.x = pk2(s[0 * 33], s[1 * 33]); o.y = pk2(s[2 * 33], s[3 * 33]); o.z = pk2(s[4 * 33], s[5 * 33]); o.w = pk2(s[6 * 33], s[7 * 33]);
        *(u32x4*)(WT + (size_t)(d0 + n) * K + k0 + 8 * c) = o; }
    asm volatile("s_waitcnt lgkmcnt(0)" ::: "memory");
}

__device__ __forceinline__ void p0_prologue(Frame& F) {
    const int tid = F.tid, lane = F.lane, wave = F.wave;
    if ((int)blockIdx.x < 192) {
        LAS float* S = (LAS float*)F.lds;
        LAS float* red = (LAS float*)(F.lds + 17 * 1024 * 4);
        for (int i = tid; i < NCOND * DM; i += 512) { const int j = i >> 10, k = i & 1023; const float v = (j < 16) ? F.in[IN_C][j * DM + k] : F.in[IN_CCTX][k]; S[i] = silu_f(v); }
        __syncthreads();
        const int item = blockIdx.x, layer = item / 96, n = (item % 96) * 64 + lane;
        const float* W = F.in[IN_WMOD] + (size_t)layer * DM * 6144;
        float acc[NCOND];
#pragma unroll
        for (int j = 0; j < NCOND; ++j) acc[j] = 0.f;
        for (int k = wave * 128; k < wave * 128 + 128; ++k) { const float w = W[(size_t)k * 6144 + n];
#pragma unroll
            for (int j = 0; j < NCOND; ++j) acc[j] += S[j * DM + k] * w; }
#pragma unroll
        for (int j = 0; j < NCOND; ++j) red[(wave * NCOND + j) * 64 + lane] = acc[j];
        __syncthreads();
        for (int i = tid; i < NCOND * 64; i += 512) { const int j = i >> 6, l = i & 63; float s = 0.f;
#pragma unroll
            for (int w = 0; w < 8; ++w) s += red[(w * NCOND + j) * 64 + l];
            const int nn = (item % 96) * 64 + l;
            ((float*)(F.ws + WS_MODS))[(size_t)(layer * NCOND + j) * 6144 + nn] = s + F.in[IN_BMOD][layer * 6144 + nn]; }
        __syncthreads();
    }
    {
        LAS float* scr = (LAS float*)(F.lds + wave * 16384);
        constexpr int I_EIN = 16 * 96, I_EO = 16 * 32, I_G = 16 * 88, I_DN = 44 * 32, I_OIN = 16 * 64, I_OO = 16 * 32;
        constexpr int NIT = I_EIN + I_EO + 2 * I_G + I_DN + I_OIN + I_OO;
        for (int it = F.gw; it < NIT; it += F.NGW) {
            int r = it;
            if (r < I_EIN) { conv_item(F.in[IN_EWIN], DM, E_IN, (bf16*)(F.ws + WS_WEIN), 0, scr, r, lane); continue; } r -= I_EIN;
            if (r < I_EO) { conv_item(F.in[IN_EWO], DM, DM, (bf16*)(F.ws + WS_WEO), 0, scr, r, lane); continue; } r -= I_EO;
            if (r < I_G) { conv_item(F.in[IN_EGATE], DM, FF, (bf16*)(F.ws + WS_WGU), 1, scr, r, lane); continue; } r -= I_G;
            if (r < I_G) { conv_item(F.in[IN_EUP], DM, FF, (bf16*)(F.ws + WS_WGU), 2, scr, r, lane); continue; } r -= I_G;
            if (r < I_DN) { conv_item(F.in[IN_EDOWN], FF, DM, (bf16*)(F.ws + WS_WDN), 0, scr, r, lane); continue; } r -= I_DN;
            if (r < I_OIN) { conv_item(F.in[IN_OWIN], DM, O_IN, (bf16*)(F.ws + WS_WOIN), 0, scr, r, lane); continue; } r -= I_OIN;
            conv_item(F.in[IN_OWO], DM, DM, (bf16*)(F.ws + WS_WOO), 0, scr, r, lane);
        }
    }
    {
        const size_t gt = (size_t)blockIdx.x * 512 + tid, NT = (size_t)F.G * 512;
        bf16* DL = (bf16*)(F.ws + WS_DFTL);
        for (size_t i = gt; i < (size_t)2048 * 4096 / 8; i += NT) {
            const int k = (int)(i >> 9), l0 = (int)(i & 511) * 8; unsigned w[4];
#pragma unroll
            for (int j = 0; j < 8; j += 2) { float v[2];
#pragma unroll
                for (int q = 0; q < 2; ++q) { const int lp = l0 + j + q, l = lp & 2047; const int ph = (k * l) & 2047; float s, c; sincospif((float)ph * (1.f / 1024.f), &s, &c); v[q] = (lp < 2048) ? c : -s; }
                w[j >> 1] = pk2(v[0], v[1]); }
            *(u32x4*)(DL + (size_t)k * 4096 + l0) = (u32x4){w[0], w[1], w[2], w[3]};
        }
        bf16* DC = (bf16*)(F.ws + WS_DFTC);
        for (size_t i = gt; i < (size_t)4 * 256 * 256; i += NT) {
            const int gi = (int)(i >> 16), mp = (int)(i >> 8) & 255, c2 = (int)i & 255; const int pq = mp >> 7, j = mp & 127, cg = c2 >> 7, c = c2 & 127;
            float v = 0.f;
            if (cg == (gi & 1)) { const int ph = (c * j) & 127; float s, cs; sincospif((float)ph * (1.f / 64.f), &s, &cs); v = pq ? s : cs; }
            DC[i] = (bf16)f2bf(v);
        }
        float* RP = (float*)(F.ws + WS_ROPE);
        for (size_t i = gt; i < (size_t)2048 * 32; i += NT) {
            const int t = (int)(i >> 5), j = (int)i & 31; const float pos = (j < 16) ? (float)(t >> 6) : (float)(t & 63);
            const float invf = powf(10000.f, -(float)(j & 15) / 16.f); const float ang = pos * invf;
            RP[i * 2] = cosf(ang); RP[i * 2 + 1] = sinf(ang);
        }
        if (gt == 0) {
            float s1 = 0.f, s2 = 0.f;
            for (int d = 0; d < 64; ++d) { s1 += F.in[IN_LQ1][d] * F.in[IN_LK1][d]; s2 += F.in[IN_LQ2][d] * F.in[IN_LK2][d]; }
            const float lam_init = 0.2f;
            ((float*)(F.ws + WS_MISC))[0] = expf(s1) - expf(s2) + lam_init;
        }
    }
}

__device__ __forceinline__ void conv_experts(Frame& F) {
    LAS float* scr = (LAS float*)(F.lds + F.wave * 16384);
    constexpr int I_G = 16 * 112, I_D = 56 * 32;
    constexpr int NIT = NEXP * (2 * I_G + I_D);
    for (int it = F.gw; it < NIT; it += F.NGW) {
        const int e = it / (2 * I_G + I_D); int r = it % (2 * I_G + I_D);
        bf16* gu = (bf16*)(F.ws + WS_EWGU) + (size_t)e * 7168 * DM;
        if (r < I_G) { conv_item(F.in[IN_XGATE] + (size_t)e * DM * FFE, DM, FFE, gu, 1, scr, r, F.lane); continue; } r -= I_G;
        if (r < I_G) { conv_item(F.in[IN_XUP] + (size_t)e * DM * FFE, DM, FFE, gu, 2, scr, r, F.lane); continue; } r -= I_G;
        conv_item(F.in[IN_XDOWN] + (size_t)e * FFE * DM, FFE, DM, (bf16*)(F.ws + WS_EWDN) + (size_t)e * DM * FFE, 0, scr, r, F.lane);
    }
}

__device__ __forceinline__ void ld_row_f32(const float* p, int lane, f32x4 (&v)[4]) {
#pragma unroll
    for (int j = 0; j < 4; ++j) v[j] = *(const f32x4*)(p + 4 * lane + 256 * j);
}
__device__ __forceinline__ void ld_row_bf16(const bf16* p, int lane, f32x4 (&v)[4]) {
#pragma unroll
    for (int j = 0; j < 4; ++j) { const u32x2 w = *(const u32x2*)(p + 4 * lane + 256 * j); v[j] = (f32x4){bf_lo(w.x), bf_hi(w.x), bf_lo(w.y), bf_hi(w.y)}; }
}
__device__ __forceinline__ void st_row_f32(float* p, int lane, const f32x4 (&v)[4]) {
#pragma unroll
    for (int j = 0; j < 4; ++j) *(f32x4*)(p + 4 * lane + 256 * j) = v[j];
}
__device__ __forceinline__ void st_row_bf16(bf16* p, int lane, const f32x4 (&v)[4]) {
#pragma unroll
    for (int j = 0; j < 4; ++j) { u32x2 w; w.x = pk2(v[j][0], v[j][1]); w.y = pk2(v[j][2], v[j][3]); *(u32x2*)(p + 4 * lane + 256 * j) = w; }
}
__device__ __forceinline__ void ln_row(f32x4 (&v)[4], const float* g, const float* b, int lane) {
    float s = 0.f;
#pragma unroll
    for (int j = 0; j < 4; ++j) s += (v[j][0] + v[j][1]) + (v[j][2] + v[j][3]);
    const float mean = wave_sum(s) * (1.f / DM); float s2 = 0.f;
#pragma unroll
    for (int j = 0; j < 4; ++j) { v[j] = v[j] - mean; s2 += (v[j][0] * v[j][0] + v[j][1] * v[j][1]) + (v[j][2] * v[j][2] + v[j][3] * v[j][3]); }
    const float rstd = rsqrtf(wave_sum(s2) * (1.f / DM) + LN_EPS);
    f32x4 gg[4], bb[4]; ld_row_f32(g, lane, gg); ld_row_f32(b, lane, bb);
#pragma unroll
    for (int j = 0; j < 4; ++j) v[j] = v[j] * rstd * gg[j] + bb[j];
}
__device__ __forceinline__ void modulate_row(f32x4 (&h)[4], const f32x4 (&x)[4], const float* sh, const float* sc, int lane) {
    f32x4 a[4], c[4]; ld_row_f32(sh, lane, a); ld_row_f32(sc, lane, c);
#pragma unroll
    for (int j = 0; j < 4; ++j) h[j] = x[j] * (1.f + c[j]) + a[j];
}

__device__ __forceinline__ void p1_modulate(Frame& F) {
    bf16* H = (bf16*)(F.ws + WS_H);
    for (int row = F.gw; row < MT; row += F.NGW) {
        const int cond = cond_of_row(row);
        const float* xr = row < ML ? F.in[IN_X] + (size_t)row * DM : F.in[IN_CTX] + (size_t)(row - ML) * DM;
        f32x4 x[4], h[4]; ld_row_f32(xr, F.lane, x);
        modulate_row(h, x, mods_ptr(F, 0, cond, 0), mods_ptr(F, 0, cond, 1), F.lane);
        st_row_bf16(H + (size_t)row * DM, F.lane, h);
    }
}

__device__ __forceinline__ void p3_rope_conv(Frame& F) {
    bf16* P = (bf16*)(F.ws + WS_BIG); bf16* CAT = (bf16*)(F.ws + WS_CAT);
    const float* RP = (const float*)(F.ws + WS_ROPE);
    const float* wc = F.in[IN_ECONV];
    const int lane = F.lane;
    for (int row = F.gw; row < MT; row += F.NGW) {
        bf16* pr = P + (size_t)row * E_IN;
        if (row < ML) {
            const int t = row & 2047;
            const int d4 = 4 * (lane & 7);
            f32x4 cs[2];
            { const float* rp = RP + ((size_t)t * 32 + d4) * 2; cs[0] = *(const f32x4*)rp; cs[1] = *(const f32x4*)(rp + 4); }
            const float c0 = cs[0][0], s0 = cs[0][1], c1 = cs[0][2], s1 = cs[0][3], c2 = cs[1][0], s2 = cs[1][1], c3 = cs[1][2], s3 = cs[1][3];
#pragma unroll
            for (int pass = 0; pass < 2; ++pass) {
                bf16* gp = pr + 1536 + (pass * 8 + (lane >> 3)) * 64 + d4;
                const u32x2 a = *(const u32x2*)gp, b = *(const u32x2*)(gp + 32);
                const float x10 = bf_lo(a.x), x11 = bf_hi(a.x), x12 = bf_lo(a.y), x13 = bf_hi(a.y);
                const float x20 = bf_lo(b.x), x21 = bf_hi(b.x), x22 = bf_lo(b.y), x23 = bf_hi(b.y);
                u32x2 oa, ob;
                oa.x = pk2(x10 * c0 - x20 * s0, x11 * c1 - x21 * s1); oa.y = pk2(x12 * c2 - x22 * s2, x13 * c3 - x23 * s3);
                ob.x = pk2(x10 * s0 + x20 * c0, x11 * s1 + x21 * c1); ob.y = pk2(x12 * s2 + x22 * c2, x13 * s3 + x23 * c3);
                *(u32x2*)gp = oa; *(u32x2*)(gp + 32) = ob;
            }
        }
        const int t = row < ML ? (row & 2047) : ((row - ML) & 255); const int Ls = row < ML ? SEQ : LC;
        const int ch = 8 * lane;
        float cv[3][8];
#pragma unroll
        for (int dt = 0; dt < 3; ++dt) {
            const int tt = t + dt - 1;
            if (tt >= 0 && tt < Ls) { const bf16* q = P + (size_t)(row + dt - 1) * E_IN; const u32x4 cg = *(const u32x4*)(q + 512 + ch), vl = *(const u32x4*)(q + 1024 + ch);
#pragma unroll
                for (int j = 0; j < 4; ++j) { cv[dt][2 * j] = bf_lo(cg[j]) * bf_lo(vl[j]); cv[dt][2 * j + 1] = bf_hi(cg[j]) * bf_hi(vl[j]); } }
            else {
#pragma unroll
                for (int j = 0; j < 8; ++j) cv[dt][j] = 0.f; }
        }
        const u32x4 bg = *(const u32x4*)(pr + ch);
        float w0[8], w1[8], w2[8];
#pragma unroll
        for (int j = 0; j < 8; ++j) { w0[j] = wc[ch + j]; w1[j] = wc[512 + ch + j]; w2[j] = wc[1024 + ch + j]; }
        float o[8];
#pragma unroll
        for (int j = 0; j < 8; ++j) { const float bgv = (j & 1) ? bf_hi(bg[j >> 1]) : bf_lo(bg[j >> 1]); o[j] = bgv * (cv[0][j] * w0[j] + cv[1][j] * w1[j] + cv[2][j] * w2[j]); }
        u32x4 w; w.x = pk2(o[0], o[1]); w.y = pk2(o[2], o[3]); w.z = pk2(o[4], o[5]); w.w = pk2(o[6], o[7]);
        *(u32x4*)(CAT + (size_t)row * DM + ch) = w;
    }
}

__device__ __forceinline__ int crow(int r, int hi) { return (r & 3) + 8 * (r >> 2) + 4 * hi; }
__device__ __forceinline__ s16x4 vtr(const LAS unsigned char* p) { return __builtin_bit_cast(s16x4, __builtin_amdgcn_ds_read_tr16_b64_v4i16((LAS s16x4*)p)); }
__device__ __forceinline__ float xhalf_max(float v) { return fmaxf(v, __shfl_xor(v, 32)); }
__device__ __forceinline__ bf16x8 pack8(const f32x16& p, int s) {
    u32x4 w; w.x = cvt_pk_bf16(p[8 * s + 0], p[8 * s + 1]); w.y = cvt_pk_bf16(p[8 * s + 2], p[8 * s + 3]); w.z = cvt_pk_bf16(p[8 * s + 4], p[8 * s + 5]); w.w = cvt_pk_bf16(p[8 * s + 6], p[8 * s + 7]);
    return __builtin_bit_cast(bf16x8, w);
}
__device__ __forceinline__ int koff(int row, int ch) { return row * 128 + ((ch ^ ((row >> 1) & 7)) << 4); }
__device__ __forceinline__ int voff128(int row, int ch) { return 256 * row + 16 * (ch ^ (((row & 3) << 2) | ((row >> 2) & 3))); }
__device__ __forceinline__ int voff64(int row, int ch) { return 128 * row + 16 * (ch ^ (((row >> 1) & 1) << 2)); }

__device__ __forceinline__ void p4_diff_attn(Frame& F) {
    const bf16* P = (const bf16*)(F.ws + WS_BIG); bf16* CAT = (bf16*)(F.ws + WS_CAT);
    const float lam = ((const float*)(F.ws + WS_MISC))[0];
    const float* subg = F.in[IN_SUBG];
    const int tid = F.tid, lane = F.lane, wave = F.wave, r32 = lane & 31, hi = lane >> 5;
    const int comp = wave >> 2, qb = wave & 3;
    LAS unsigned char* lds = F.lds;
    constexpr int STG = 32768;
    constexpr float C2 = 0.125f * 1.4426950408889634f;
    constexpr int NU_LAT = NB * 4 * 16, NU = NU_LAT + NB * 4 * 2;
    for (int un = F.vcu; un < NU; un += F.G) {
        int b, h, qrow0, j0, j1;
        if (un < NU_LAT) { b = un >> 6; h = (un >> 4) & 3; qrow0 = b * SEQ + (un & 15) * 128; j0 = 0; j1 = 36; }
        else { const int v = un - NU_LAT; b = v >> 3; h = (v >> 1) & 3; qrow0 = ML + b * LC + (v & 1) * 128; j0 = 0; j1 = 4; }
        bf16x8 qf[4];
        { const bf16* qp = P + (size_t)(qrow0 + qb * 32 + r32) * E_IN + 1536 + h * 128 + comp * 64 + hi * 8;
#pragma unroll
          for (int ds = 0; ds < 4; ++ds) qf[ds] = *(const bf16x8*)(qp + ds * 16); }
        f32x16 o[4];
#pragma unroll
        for (int e = 0; e < 4; ++e) o[e] = (f32x16){};
        float mrun = -INFINITY, lrun = 0.f;
        u32x4 sk1, sk2, sv[2];
        const int krow = tid >> 3, kch = tid & 7;
#define DA_LOAD(j) do { const int rowb = ((j) < 4) ? (ML + b * LC + (j) * 64) : (b * SEQ + ((j) - 4) * 64); \
            const bf16* kp = P + (size_t)(rowb + krow) * E_IN + 2048 + h * 128 + kch * 8; sk1 = *(const u32x4*)kp; sk2 = *(const u32x4*)(kp + 64); \
            _Pragma("unroll") for (int i = 0; i < 2; ++i) { const int idx = tid + 512 * i; sv[i] = *(const u32x4*)(P + (size_t)(rowb + (idx >> 4)) * E_IN + 2560 + h * 128 + (idx & 15) * 8); } } while (0)
#define DA_STORE(st) do { LAS unsigned char* sb = lds + (st) * STG; *(LAS u32x4*)(sb + koff(krow, kch)) = sk1; *(LAS u32x4*)(sb + 8192 + koff(krow, kch)) = sk2; \
            _Pragma("unroll") for (int i = 0; i < 2; ++i) { const int idx = tid + 512 * i; *(LAS u32x4*)(sb + 16384 + voff128(idx >> 4, idx & 15)) = sv[i]; } } while (0)
        __syncthreads();
        DA_LOAD(j0); DA_STORE(0);
        __syncthreads();
        for (int j = j0; j < j1; ++j) {
            const int st = (j - j0) & 1;
            if (j + 1 < j1) DA_LOAD(j + 1);
            const LAS unsigned char* kb_ = lds + st * STG + comp * 8192;
            const LAS unsigned char* vb_ = lds + st * STG + 16384;
            f32x16 p[2];
#pragma unroll
            for (int kb = 0; kb < 2; ++kb) { p[kb] = (f32x16){};
#pragma unroll
                for (int ds = 0; ds < 4; ++ds) { const bf16x8 kf = *(const LAS bf16x8*)(kb_ + koff(kb * 32 + r32, ds * 2 + hi)); p[kb] = __builtin_amdgcn_mfma_f32_32x32x16_bf16(kf, qf[ds], p[kb], 0, 0, 0); } }
            float mx = p[0][0];
#pragma unroll
            for (int r = 0; r < 16; ++r) { mx = fmaxf(mx, p[0][r]); mx = fmaxf(mx, p[1][r]); }
            mx = xhalf_max(mx) * C2;
            const float mnew = fmaxf(mrun, mx); const float al = __builtin_amdgcn_exp2f(mrun - mnew); mrun = mnew;
            float ps = 0.f;
#pragma unroll
            for (int kb = 0; kb < 2; ++kb)
#pragma unroll
                for (int r = 0; r < 16; ++r) { const float e = __builtin_amdgcn_exp2f(p[kb][r] * C2 - mnew); p[kb][r] = e; ps += e; }
            lrun = lrun * al + ps;
#pragma unroll
            for (int e = 0; e < 4; ++e) o[e] = o[e] * al;
#pragma unroll
            for (int kb = 0; kb < 2; ++kb)
#pragma unroll
                for (int s = 0; s < 2; ++s) { const bf16x8 pf = pack8(p[kb], s);
                    const int rb = kb * 32 + 16 * s + 4 * hi + ((lane & 15) >> 2);
#pragma unroll
                    for (int e = 0; e < 4; ++e) { const int c0 = 4 * e + 2 * ((lane >> 4) & 1) + ((lane & 3) >> 1);
                        const s16x4 lo = vtr(vb_ + voff128(rb, c0) + 8 * (lane & 1)), hh = vtr(vb_ + voff128(rb + 8, c0) + 8 * (lane & 1));
                        const bf16x8 vf = (bf16x8){lo[0], lo[1], lo[2], lo[3], hh[0], hh[1], hh[2], hh[3]};
                        o[e] = __builtin_amdgcn_mfma_f32_32x32x16_bf16(vf, pf, o[e], 0, 0, 0); } }
            if (j + 1 < j1) DA_STORE(st ^ 1);
            __syncthreads();
        }
        const float linv = 1.f / (lrun + __shfl_xor(lrun, 32));
        LAS float* X = (LAS float*)(lds + qb * 16384);
        if (comp == 1) {
#pragma unroll
            for (int e = 0; e < 4; ++e)
#pragma unroll
                for (int r = 0; r < 16; ++r) X[(e * 16 + r) * 64 + lane] = o[e][r] * linv; }
        __syncthreads();
        if (comp == 0) {
            float ss = 0.f;
#pragma unroll
            for (int e = 0; e < 4; ++e)
#pragma unroll
                for (int r = 0; r < 16; ++r) { const float v = o[e][r] * linv - lam * X[(e * 16 + r) * 64 + lane]; o[e][r] = v; ss += v * v; }
            ss += __shfl_xor(ss, 32);
            const float rn = rsqrtf(ss * (1.f / 128.f) + RMS_EPS) * 0.8f;
            bf16* op = CAT + (size_t)(qrow0 + qb * 32 + r32) * DM + 512 + h * 128;
#pragma unroll
            for (int e = 0; e < 4; ++e)
#pragma unroll
                for (int r4 = 0; r4 < 4; ++r4) { const int ec = 32 * e + 8 * r4 + 4 * hi; const f32x4 g = *(const f32x4*)(subg + ec);
                    u32x2 w; w.x = pk2(o[e][4 * r4] * rn * g[0], o[e][4 * r4 + 1] * rn * g[1]); w.y = pk2(o[e][4 * r4 + 2] * rn * g[2], o[e][4 * r4 + 3] * rn * g[3]);
                    *(u32x2*)(op + ec) = w; }
        }
#undef DA_LOAD
#undef DA_STORE
    }
    __syncthreads();
}

__device__ __forceinline__ void p11_na_attn(Frame& F) {
    const bf16* P2 = (const bf16*)(F.ws + WS_BIG); bf16* CAT = (bf16*)(F.ws + WS_CAT);
    const int lane = F.lane, wave = F.wave, r32 = lane & 31, hi = lane >> 5;
    {
        float* GN = (float*)(F.ws + WS_GN);
        for (int row = F.gw; row < ML; row += F.NGW) {
            const u32x4 w = *(const u32x4*)(P2 + (size_t)row * O_IN + 8 * lane);
            float v[8];
#pragma unroll
            for (int j = 0; j < 4; ++j) { v[2 * j] = bf_lo(w[j]); v[2 * j + 1] = bf_hi(w[j]); }
            float s = 0.f;
#pragma unroll
            for (int j = 0; j < 8; ++j) s += v[j];
#pragma unroll
            for (int o = 1; o < 16; o <<= 1) s += __shfl_xor(s, o);
            const float mean = s * (1.f / 128.f); float q = 0.f;
#pragma unroll
            for (int j = 0; j < 8; ++j) { const float d = v[j] - mean; q += d * d; }
#pragma unroll
            for (int o = 1; o < 16; o <<= 1) q += __shfl_xor(q, o);
            if ((lane & 15) == 0) { float* g = GN + ((size_t)(lane >> 4) * ML + row) * 2; g[0] = mean; g[1] = rsqrtf(q * (1.f / 128.f) + LN_EPS); }
        }
    }
    LAS float* TAB = (LAS float*)(F.lds + 1024);
    __syncthreads();
    for (int i = F.tid; i < 8 * 15 * 32; i += 512) { const int dc = i & 31; TAB[i] = (dc < 31) ? F.in[IN_RPB][(i >> 5) * 31 + dc] : 0.f; }
    __syncthreads();
    LAS unsigned char* vt = F.lds + 32768 + wave * 8192;
    constexpr float C2 = 0.125f * 1.4426950408889634f, LOG2E = 1.4426950408889634f;
    constexpr int NWU = NB * 32 * 8 * 2;
    for (int wu = F.vcu * NWAVES + wave; wu < NWU; wu += F.G * NWAVES) {
        const int qh = wu & 1, h = (wu >> 1) & 7, r = (wu >> 4) & 31, b = wu >> 9;
        const int rs = min(max(r - 4, 0), 24);
        const int qc = qh * 32 + r32, cs = min(max(qc - 8, 0), 48);
        const int qrow = b * SEQ + r * 64 + qc;
        bf16x8 qf[4];
        { const bf16* qp = P2 + (size_t)qrow * O_IN + 512 + h * 64 + hi * 8;
#pragma unroll
          for (int ds = 0; ds < 4; ++ds) qf[ds] = *(const bf16x8*)(qp + ds * 16); }
        f32x16 o[2]; o[0] = (f32x16){}; o[1] = (f32x16){};
        float mrun = -INFINITY, lrun = 0.f;
        bf16x8 kf[2][4], kn[2][4]; u32x4 vn[8];
#define NA_ROWB(j) (((j) < 8) ? (b * SEQ + (rs + (j)) * 64) : (ML + b * LC + ((j) - 8) * 64))
#define NA_LOADK(dst, j) do { const bf16* kp = P2 + (size_t)(NA_ROWB(j) + r32) * O_IN + 1024 + h * 64 + hi * 8; \
            _Pragma("unroll") for (int kb = 0; kb < 2; ++kb) _Pragma("unroll") for (int ds = 0; ds < 4; ++ds) dst[kb][ds] = *(const bf16x8*)(kp + (size_t)kb * 32 * O_IN + ds * 16); } while (0)
#define NA_LOADV(j) do { const bf16* vp = P2 + (size_t)NA_ROWB(j) * O_IN + 1536 + h * 64; \
            _Pragma("unroll") for (int i = 0; i < 8; ++i) { const int idx = lane + 64 * i; vn[i] = *(const u32x4*)(vp + (size_t)(idx >> 3) * O_IN + (idx & 7) * 8); } } while (0)
#define NA_STOREV() do { _Pragma("unroll") for (int i = 0; i < 8; ++i) { const int idx = lane + 64 * i; *(LAS u32x4*)(vt + voff64(idx >> 3, idx & 7)) = vn[i]; } } while (0)
        NA_LOADK(kf, 0); NA_LOADV(0); NA_STOREV();
        for (int j = 0; j < 12; ++j) {
            if (j + 1 < 12) { NA_LOADK(kn, j + 1); NA_LOADV(j + 1); }
            f32x16 p[2];
#pragma unroll
            for (int kb = 0; kb < 2; ++kb) { p[kb] = (f32x16){};
#pragma unroll
                for (int ds = 0; ds < 4; ++ds) p[kb] = __builtin_amdgcn_mfma_f32_32x32x16_bf16(kf[kb][ds], qf[ds], p[kb], 0, 0, 0); }
            if (j < 8) {
                const int dr = rs + j - r + 7;
                const LAS float* tb = TAB + (h * 15 + dr) * 32 + (15 - qc + 4 * hi);
                const int kd = 4 * hi - cs;
#pragma unroll
                for (int kb = 0; kb < 2; ++kb)
#pragma unroll
                    for (int rr = 0; rr < 16; ++rr) { const int kc0 = kb * 32 + (rr & 3) + 8 * (rr >> 2);
                        const float bias = tb[kc0]; const bool ok = (unsigned)(kc0 + kd) < 16u;
                        p[kb][rr] = ok ? (p[kb][rr] * C2 + bias * LOG2E) : -INFINITY; }
            } else {
#pragma unroll
                for (int kb = 0; kb < 2; ++kb)
#pragma unroll
                    for (int rr = 0; rr < 16; ++rr) p[kb][rr] *= C2;
            }
            float mx = p[0][0];
#pragma unroll
            for (int rr = 0; rr < 16; ++rr) { mx = fmaxf(mx, p[0][rr]); mx = fmaxf(mx, p[1][rr]); }
            mx = xhalf_max(mx);
            const float mnew = fmaxf(mrun, mx); const float al = __builtin_amdgcn_exp2f(mrun - mnew); mrun = mnew;
            float ps = 0.f;
#pragma unroll
            for (int kb = 0; kb < 2; ++kb)
#pragma unroll
                for (int rr = 0; rr < 16; ++rr) { const float e = __builtin_amdgcn_exp2f(p[kb][rr] - mnew); p[kb][rr] = e; ps += e; }
            lrun = lrun * al + ps;
            o[0] = o[0] * al; o[1] = o[1] * al;
#pragma unroll
            for (int kb = 0; kb < 2; ++kb)
#pragma unroll
                for (int s = 0; s < 2; ++s) { const bf16x8 pf = pack8(p[kb], s);
                    const int rb = kb * 32 + 16 * s + 4 * hi + ((lane & 15) >> 2);
#pragma unroll
                    for (int e = 0; e < 2; ++e) { const int c0 = 4 * e + 2 * ((lane >> 4) & 1) + ((lane & 3) >> 1);
                        const s16x4 lo = vtr(vt + voff64(rb, c0) + 8 * (lane & 1)), hh = vtr(vt + voff64(rb + 8, c0) + 8 * (lane & 1));
                        const bf16x8 vf = (bf16x8){lo[0], lo[1], lo[2], lo[3], hh[0], hh[1], hh[2], hh[3]};
                        o[e] = __builtin_amdgcn_mfma_f32_32x32x16_bf16(vf, pf, o[e], 0, 0, 0); } }
            if (j + 1 < 12) {
                NA_STOREV();
#pragma unroll
                for (int kb = 0; kb < 2; ++kb)
#pragma unroll
                    for (int ds = 0; ds < 4; ++ds) kf[kb][ds] = kn[kb][ds];
            }
        }
        const float linv = 1.f / (lrun + __shfl_xor(lrun, 32));
        bf16* op = CAT + (size_t)qrow * DM + 512 + h * 64;
#pragma unroll
        for (int e = 0; e < 2; ++e)
#pragma unroll
            for (int r4 = 0; r4 < 4; ++r4) { const int ec = 32 * e + 8 * r4 + 4 * hi;
                u32x2 w; w.x = pk2(o[e][4 * r4] * linv, o[e][4 * r4 + 1] * linv); w.y = pk2(o[e][4 * r4 + 2] * linv, o[e][4 * r4 + 3] * linv);
                *(u32x2*)(op + ec) = w; }
#undef NA_ROWB
#undef NA_LOADK
#undef NA_LOADV
#undef NA_STOREV
    }
    __syncthreads();
}

__device__ __forceinline__ void p6_ln1_even(Frame& F) {
    const bf16* Y = (const bf16*)(F.ws + WS_Y); bf16* H = (bf16*)(F.ws + WS_H); float* XC = (float*)(F.ws + WS_XC);
    const float* lg = F.in[IN_LNG] + 0 * DM; const float* lb = F.in[IN_LNB] + 0 * DM;
    for (int row = F.gw; row < MT; row += F.NGW) {
        const int cond = cond_of_row(row);
        const float* xr = row < ML ? F.in[IN_X] + (size_t)row * DM : F.in[IN_CTX] + (size_t)(row - ML) * DM;
        f32x4 x[4], y[4], g[4], h[4]; ld_row_f32(xr, F.lane, x); ld_row_bf16(Y + (size_t)row * DM, F.lane, y); ld_row_f32(mods_ptr(F, 0, cond, 2), F.lane, g);
#pragma unroll
        for (int j = 0; j < 4; ++j) x[j] = ALPHA * x[j] + g[j] * y[j];
        ln_row(x, lg, lb, F.lane);
        st_row_f32(row < ML ? F.out + (size_t)row * DM : XC + (size_t)(row - ML) * DM, F.lane, x);
        modulate_row(h, x, mods_ptr(F, 0, cond, 3), mods_ptr(F, 0, cond, 4), F.lane);
        st_row_bf16(H + (size_t)row * DM, F.lane, h);
    }
}
__device__ __forceinline__ void p9_ln2_even(Frame& F) {
    const bf16* Fd = (const bf16*)(F.ws + WS_Y); bf16* H = (bf16*)(F.ws + WS_H); const float* XC = (const float*)(F.ws + WS_XC);
    const float* lg = F.in[IN_LNG] + 1 * DM; const float* lb = F.in[IN_LNB] + 1 * DM;
    for (int row = F.gw; row < MT; row += F.NGW) {
        const int cond = cond_of_row(row);
        const float* xr = row < ML ? F.out + (size_t)row * DM : XC + (size_t)(row - ML) * DM;
        f32x4 x[4], y[4], g[4], h[4]; ld_row_f32(xr, F.lane, x); ld_row_bf16(Fd + (size_t)row * DM, F.lane, y); ld_row_f32(mods_ptr(F, 0, cond, 5), F.lane, g);
#pragma unroll
        for (int j = 0; j < 4; ++j) x[j] = ALPHA * x[j] + g[j] * y[j];
        ln_row(x, lg, lb, F.lane);
        if (row < ML) st_row_f32(F.out + (size_t)row * DM, F.lane, x);
        modulate_row(h, x, mods_ptr(F, 1, cond, 0), mods_ptr(F, 1, cond, 1), F.lane);
        st_row_bf16(H + (size_t)row * DM, F.lane, h);
    }
}
__device__ __forceinline__ void p15_ln1_odd(Frame& F) {
    const bf16* Y = (const bf16*)(F.ws + WS_Y); bf16* H = (bf16*)(F.ws + WS_H);
    const float* lg = F.in[IN_LNG] + 2 * DM; const float* lb = F.in[IN_LNB] + 2 * DM;
    const float* wr = F.in[IN_ROUTER];
    unsigned* cnt = (unsigned*)(F.ws + WS_CTL) + CW_CNT; int* TOK = (int*)(F.ws + WS_TOK); int* LIST = (int*)(F.ws + WS_LIST);
    for (int row = F.gw; row < ML; row += F.NGW) {
        const int cond = row >> 11;
        f32x4 x[4], y[4], g[4], h[4]; ld_row_f32(F.out + (size_t)row * DM, F.lane, x); ld_row_bf16(Y + (size_t)row * DM, F.lane, y); ld_row_f32(mods_ptr(F, 1, cond, 2), F.lane, g);
#pragma unroll
        for (int j = 0; j < 4; ++j) x[j] = ALPHA * x[j] + g[j] * y[j];
        ln_row(x, lg, lb, F.lane);
        st_row_f32(F.out + (size_t)row * DM, F.lane, x);
        modulate_row(h, x, mods_ptr(F, 1, cond, 3), mods_ptr(F, 1, cond, 4), F.lane);
        st_row_bf16(H + (size_t)row * DM, F.lane, h);
        float lg8[8];
#pragma unroll
        for (int e = 0; e < 8; ++e) lg8[e] = 0.f;
#pragma unroll
        for (int j = 0; j < 4; ++j)
#pragma unroll
            for (int q = 0; q < 4; ++q) { const int d = 4 * F.lane + 256 * j + q; const f32x4 w0 = *(const f32x4*)(wr + (size_t)d * 8), w1 = *(const f32x4*)(wr + (size_t)d * 8 + 4); const float hv = h[j][q];
#pragma unroll
                for (int e = 0; e < 4; ++e) { lg8[e] += hv * w0[e]; lg8[4 + e] += hv * w1[e]; } }
#pragma unroll
        for (int e = 0; e < 8; ++e) lg8[e] = wave_sum(lg8[e]);
        if (F.lane == 0) {
            int e0 = 0; float v0 = lg8[0];
#pragma unroll
            for (int e = 1; e < 8; ++e) if (lg8[e] > v0) { v0 = lg8[e]; e0 = e; }
            int e1 = -1; float v1 = -INFINITY;
#pragma unroll
            for (int e = 0; e < 8; ++e) if (e != e0 && lg8[e] > v1) { v1 = lg8[e]; e1 = e; }
            const float p1 = 1.f / (1.f + __expf(v0 - v1)), p0 = 1.f - p1;
            const int pos0 = (int)atomicAdd(cnt + e0, 1u), pos1 = (int)atomicAdd(cnt + e1, 1u);
            LIST[e0 * ML + pos0] = row; LIST[e1 * ML + pos1] = row;
            int* tk = TOK + (size_t)row * 8; tk[0] = e0; tk[1] = pos0; tk[2] = e1; tk[3] = pos1; tk[4] = __builtin_bit_cast(int, p0); tk[5] = __builtin_bit_cast(int, p1);
        }
    }
}
__device__ __forceinline__ void p24_final(Frame& F) {
    const bf16* YS = (const bf16*)(F.ws + WS_YS);
    const float* lg = F.in[IN_LNG] + 3 * DM; const float* lb = F.in[IN_LNB] + 3 * DM;
    const unsigned* cnt = (const unsigned*)(F.ws + WS_CTL) + CW_CNT; const int* TOK = (const int*)(F.ws + WS_TOK);
    int pbase[8]; { int a = 0;
#pragma unroll
        for (int e = 0; e < 8; ++e) { pbase[e] = a; a += ((int)cnt[e] + 255) >> 8; } }
    for (int row = F.gw; row < ML; row += F.NGW) {
        const int cond = row >> 11;
        const int* tk = TOK + (size_t)row * 8; const int e0 = tk[0], pos0 = tk[1], e1 = tk[2], pos1 = tk[3]; const float p0 = __builtin_bit_cast(float, tk[4]), p1 = __builtin_bit_cast(float, tk[5]);
        int pb0 = 0, pb1 = 0;
#pragma unroll
        for (int e = 0; e < 8; ++e) { pb0 = (e == e0) ? pbase[e] : pb0; pb1 = (e == e1) ? pbase[e] : pb1; }
        const size_t s0 = (size_t)pb0 * 256 + pos0, s1 = (size_t)pb1 * 256 + pos1;
        f32x4 x[4], ya[4], yb[4], g[4]; ld_row_f32(F.out + (size_t)row * DM, F.lane, x); ld_row_bf16(YS + s0 * DM, F.lane, ya); ld_row_bf16(YS + s1 * DM, F.lane, yb); ld_row_f32(mods_ptr(F, 1, cond, 5), F.lane, g);
#pragma unroll
        for (int j = 0; j < 4; ++j) x[j] = ALPHA * x[j] + g[j] * (p0 * ya[j] + p1 * yb[j]);
        ln_row(x, lg, lb, F.lane);
        st_row_f32(F.out + (size_t)row * DM, F.lane, x);
    }
}

struct MoeOrder {
    int cum[9]; int cnt[8]; int p0, p1, nN, nwg, G, c; int gather; const int* list; unsigned long long bstep; int ocw;
    __device__ __forceinline__ void init(const unsigned* counts, int chunk, int nN_, int G_, int c_, int gather_, const int* list_, int ldb, int ocw_) {
        int a = 0;
#pragma unroll
        for (int e = 0; e < 8; ++e) { cnt[e] = (int)counts[e]; cum[e] = a; a += (cnt[e] + 255) >> 8; }
        cum[8] = a;
        p0 = chunk * MOE_CH; p1 = min(p0 + MOE_CH, a); if (p1 < p0) p1 = p0;
        nN = nN_; nwg = (p1 - p0) * nN; G = G_; c = c_; gather = gather_; list = list_; bstep = (unsigned long long)256 * ldb * 2; ocw = ocw_;
    }
    __device__ __forceinline__ bool next(int i, pg8::Unit& u) const {
        const long L = (long)i * G + c; if (L >= nwg) return false;
        int wgid = (int)L; { const int q = nwg / 8, r = nwg % 8, xcd = wgid % 8, off = wgid / 8; wgid = (xcd < r ? xcd * (q + 1) : r * (q + 1) + (xcd - r) * q) + off; }
        const int nM = p1 - p0, nig = 8 * nN, gid = wgid / nig, fm = gid * 8, gsz = (nM - fm) < 8 ? (nM - fm) : 8;
        const int pml = fm + ((wgid % nig) % gsz), pn = (wgid % nig) / gsz;
        const int pm = p0 + pml; int e = 0;
#pragma unroll
        for (int k = 1; k < 8; ++k) e += (pm >= cum[k]) ? 1 : 0;
        int ce = 0, cme = 0;
#pragma unroll
        for (int k = 0; k < 8; ++k) { ce = (k == e) ? cnt[k] : ce; cme = (k == e) ? cum[k] : cme; }
        u.pm = pm; u.pn = pn; u.aux = e | ((pm - cme) << 4) | (ce << 12);
        u.bofs = (unsigned long long)(e * nN + pn) * bstep;
        u.orow0 = gather ? pml * 256 : pm * 256; u.ocol0 = pn * ocw;
        return true;
    }
    __device__ __forceinline__ int arow(const pg8::Unit& u, int r) const {
        if (gather) { const int e = u.aux & 15, lp = (u.aux >> 4) & 255, ce = u.aux >> 12; const int idx = lp * 256 + r; return idx < ce ? list[e * ML + idx] : 0; }
        return (u.pm - p0) * 256 + r;
    }
};
struct DftCOrder {
    int G, c;
    __device__ __forceinline__ bool next(int i, pg8::Unit& u) const {
        const int L = i * G + c; if (L >= 512) return false;
        u.pm = L & 3; u.pn = L >> 2; u.orow0 = 0; u.ocol0 = 0; u.aux = 0;
        u.bofs = ((unsigned long long)u.pn * 256 * O_IN + (u.pm >> 1) * 256) * 2; return true;
    }
    __device__ __forceinline__ int arow(const pg8::Unit& u, int r) const { return u.pm * 256 + r; }
};
struct DftLOrder {
    int G, vcu;
    __device__ __forceinline__ bool next(int i, pg8::Unit& u) const {
        const int L = i * G + vcu; if (L >= 256) return false;
        const int b = L >> 4; u.pm = (L >> 1) & 7; u.pn = L & 1; u.orow0 = b * SEQ + u.pm * 256; u.ocol0 = u.pn * 256; u.aux = 0;
        u.bofs = ((unsigned long long)(b * 512 + u.pn * 256) * 4096) * 2; return true;
    }
    __device__ __forceinline__ int arow(const pg8::Unit& u, int r) const { return u.pm * 256 + r; }
};

constexpr int NPH = 17 + 2 * MOE_NCH;
struct Args { const float* in[26]; float* out; unsigned char* ws; int ph_lo, ph_hi; int use_bar, bar_region; };

__global__ void __launch_bounds__(NWAVES * 64, 2) fwd(Args args) {
    extern __shared__ __attribute__((aligned(16))) unsigned char lds_raw[];
    Frame F;
    F.lds = (LAS unsigned char*)lds_raw;
    F.tid = threadIdx.x; F.lane = F.tid & 63; F.wave = __builtin_amdgcn_readfirstlane(F.tid >> 6);
    F.G = gridDim.x; { const int bx = blockIdx.x; F.vcu = (F.G % 8 == 0) ? (bx % 8) * (F.G / 8) + bx / 8 : bx; }
    F.gw = F.vcu * NWAVES + F.wave; F.NGW = F.G * NWAVES;
#pragma unroll
    for (int i = 0; i < 26; ++i) F.in[i] = args.in[i];
    F.out = args.out; F.ws = args.ws;
    volatile LAS unsigned* MISC = (volatile LAS unsigned*)(F.lds + MISC_OFF);
    for (int u = F.tid; u < (LDS_BYTES - RING_BYTES) / 4; u += NWAVES * 64) ((LAS unsigned*)(F.lds + RING_BYTES))[u] = 0u;
    __syncthreads();
    unsigned* ctl = (unsigned*)(args.ws + WS_CTL);
    XcdBarrier bar; bar.bar = ctl + CW_BAR + args.bar_region * XCD_BAR_WORDS; bar.x = 0; bar.st = nullptr;
    if (args.use_bar) bar = xcd_barrier_post(ctl + CW_BAR + args.bar_region * XCD_BAR_WORDS, MISC + 8);
    const int lo = args.ph_lo, hi = args.ph_hi;
#ifndef PH_MASK
#define PH_MASK 0xffffffffu
#endif
#define IN(k) (((PH_MASK >> ((k) > 16 ? 16 + (((k) - 16) & 1) : (k))) & 1u) && lo <= (k) && (k) < hi)
#define SEAM(k) do { if (IN(k) && IN((k) + 1)) xcd_barrier(bar); } while (0)
    bf16* const H = (bf16*)(F.ws + WS_H); bf16* const CAT = (bf16*)(F.ws + WS_CAT); bf16* const Y = (bf16*)(F.ws + WS_Y); bf16* const BIG = (bf16*)(F.ws + WS_BIG);

    if (IN(0)) { p0_prologue(F); SEAM(0); }
    if (IN(1)) { p1_modulate(F); SEAM(1); }
    if (IN(2)) {
        pg8::Gemm g{H, (const bf16*)(F.ws + WS_WEIN), DM, DM, DM}; pg8::DenseOrder S; S.init(MT / 256, E_IN / 256, F.G, blockIdx.x, 256, DM);
        EpiPlain E{BIG, E_IN, 1.f}; pg8::gemm_phase(F.lds, g, S, E); SEAM(2); }
    if (IN(3)) { p3_rope_conv(F); SEAM(3); }
    if (IN(4)) { p4_diff_attn(F); SEAM(4); }
    if (IN(5)) {
        pg8::Gemm g{CAT, (const bf16*)(F.ws + WS_WEO), DM, DM, DM}; pg8::DenseOrder S; S.init(MT / 256, DM / 256, F.G, blockIdx.x, 256, DM);
        EpiPlain E{Y, DM, 1.f}; pg8::gemm_phase(F.lds, g, S, E); SEAM(5); }
    if (IN(6)) { p6_ln1_even(F); SEAM(6); }
    if (IN(7)) {
        pg8::Gemm g{H, (const bf16*)(F.ws + WS_WGU), DM, DM, DM}; pg8::DenseOrder S; S.init(MT / 256, 2 * FF / 256, F.G, blockIdx.x, 128, DM);
        EpiSwiglu E{BIG, FF}; pg8::gemm_phase(F.lds, g, S, E); SEAM(7); }
    if (IN(8)) {
        pg8::Gemm g{BIG, (const bf16*)(F.ws + WS_WDN), FF, FF, FF}; pg8::DenseOrder S; S.init(MT / 256, DM / 256, F.G, blockIdx.x, 256, FF);
        EpiPlain E{Y, DM, 1.f}; pg8::gemm_phase(F.lds, g, S, E); SEAM(8); }
    if (IN(9)) { p9_ln2_even(F); SEAM(9); }
    if (IN(10)) {
        pg8::Gemm g{H, (const bf16*)(F.ws + WS_WOIN), DM, DM, DM}; pg8::DenseOrder S; S.init(MT / 256, O_IN / 256, F.G, blockIdx.x, 256, DM);
        EpiPlain E{BIG, O_IN, 1.f}; pg8::gemm_phase(F.lds, g, S, E); SEAM(10); }
    if (IN(11)) { p11_na_attn(F); SEAM(11); }
    if (IN(12)) {
        pg8::Gemm g{(const bf16*)(F.ws + WS_DFTC), BIG, 256, O_IN, 256}; DftCOrder S{F.G, (int)blockIdx.x};
        EpiDftC E{Y, (const float*)(F.ws + WS_GN)}; pg8::gemm_phase(F.lds, g, S, E); SEAM(12); }
    if (IN(13)) {
        pg8::Gemm g{(const bf16*)(F.ws + WS_DFTL), Y, 4096, 4096, 4096}; DftLOrder S{F.G, F.vcu};
        EpiPlain E{CAT, DM, 1.f / 512.f}; pg8::gemm_phase(F.lds, g, S, E); SEAM(13); }
    if (IN(14)) {
        pg8::Gemm g{CAT, (const bf16*)(F.ws + WS_WOO), DM, DM, DM}; pg8::DenseOrder S; S.init(ML / 256, DM / 256, F.G, blockIdx.x, 256, DM);
        EpiPlain E{Y, DM, 1.f}; pg8::gemm_phase(F.lds, g, S, E);
        __syncthreads(); conv_experts(F); SEAM(14); }
    if (IN(15)) { p15_ln1_odd(F); SEAM(15); }
    for (int ch = 0; ch < MOE_NCH; ++ch) {
        if (IN(16 + 2 * ch)) {
            pg8::Gemm g{H, (const bf16*)(F.ws + WS_EWGU), DM, DM, DM}; MoeOrder S; S.init((const unsigned*)ctl + CW_CNT, ch, 2 * FFE / 256, F.G, blockIdx.x, 1, (const int*)(F.ws + WS_LIST), DM, 128);
            EpiSwiglu E{BIG, FFE}; pg8::gemm_phase(F.lds, g, S, E); SEAM(16 + 2 * ch); }
        if (IN(17 + 2 * ch)) {
            pg8::Gemm g{BIG, (const bf16*)(F.ws + WS_EWDN), FFE, FFE, FFE}; MoeOrder S; S.init((const unsigned*)ctl + CW_CNT, ch, DM / 256, F.G, blockIdx.x, 0, nullptr, FFE, 256);
            EpiPlain E{(bf16*)(F.ws + WS_YS), DM, 1.f}; pg8::gemm_phase(F.lds, g, S, E); SEAM(17 + 2 * ch); }
    }
    if (IN(NPH - 1)) { p24_final(F); }
#undef IN
#undef SEAM
}

extern "C" void kernel_launch(void* const* d_in, const int* in_sizes, int n_in, void* d_out, int out_size, void* d_ws, size_t ws_size, hipStream_t stream) {
    static int grid = 0;
    if (grid == 0) {
        if (n_in != 26 || out_size != ML * DM || ws_size < WS_END) { fprintf(stderr, "kernel_launch: unexpected problem (n_in %d out %d ws %zu)\n", n_in, out_size, ws_size); grid = -1; return; }
        int dev = 0, cus = 0;
        if (hipGetDevice(&dev) != hipSuccess || hipDeviceGetAttribute(&cus, hipDeviceAttributeMultiprocessorCount, dev) != hipSuccess) { grid = -1; return; }
        if (hipFuncSetAttribute((const void*)fwd, hipFuncAttributeMaxDynamicSharedMemorySize, LDS_BYTES) != hipSuccess) { grid = -1; return; }
        grid = cus;
    }
    if (grid < 0) return;
    (void)hipMemsetAsync((char*)d_ws + WS_CTL, 0, CTL_ZERO_BYTES, stream);
    Args a{};
    for (int i = 0; i < 26; ++i) a.in[i] = (const float*)d_in[i];
    a.out = (float*)d_out; a.ws = (unsigned char*)d_ws;
#if MK_LAUNCH_PER_PHASE
    a.use_bar = 0;
    for (int ph = 0; ph < NPH; ++ph) { a.ph_lo = ph; a.ph_hi = ph + 1; hipLaunchKernelGGL(fwd, dim3(grid), dim3(NWAVES * 64), LDS_BYTES, stream, a); }
#elif defined(PROBE_REPEAT)
    a.use_bar = 1; a.ph_lo = 0; a.ph_hi = PROBE_REPEAT + 1; a.bar_region = 0;
    hipLaunchKernelGGL(fwd, dim3(grid), dim3(NWAVES * 64), LDS_BYTES, stream, a);
    a.ph_lo = PROBE_REPEAT; a.ph_hi = NPH; a.bar_region = 1;
    hipLaunchKernelGGL(fwd, dim3(grid), dim3(NWAVES * 64), LDS_BYTES, stream, a);
#else
    a.use_bar = 1; a.ph_lo = 0; a.ph_hi = NPH;
    hipLaunchKernelGGL(fwd, dim3(grid), dim3(NWAVES * 64), LDS_BYTES, stream, a);
#endif
}
```

```cpp
#include <hip/hip_runtime.h>
#include <cstdio>
#include <cstdint>

#ifndef MK_LAUNCH_PER_PHASE
#define MK_LAUNCH_PER_PHASE 0
#endif

#define GAS __attribute__((address_space(1)))
#define LAS __attribute__((address_space(3)))
typedef unsigned short bf16;
typedef short bf16x8 __attribute__((ext_vector_type(8)));
typedef short s16x4 __attribute__((ext_vector_type(4)));
typedef float f32x4 __attribute__((ext_vector_type(4)));
typedef float f32x16 __attribute__((ext_vector_type(16)));
typedef unsigned u32x4 __attribute__((ext_vector_type(4)));
typedef unsigned u32x2 __attribute__((ext_vector_type(2)));

constexpr int NB = 16, SEQ = 2048, DM = 1024, LC = 256, GW = 64;
constexpr int ML = NB * SEQ;
constexpr int MC = NB * LC;
constexpr int MT = ML + MC;
constexpr int E_IN = 3072, FF = 2816, O_IN = 2048, NEXP = 8, FFE = 3584;
constexpr int NCOND = 17;
constexpr float LN_EPS = 1e-5f, RMS_EPS = 1e-5f;
constexpr float ALPHA = 1.41421356237309515f;

constexpr size_t MiB = 1u << 20;
constexpr size_t WS_CTL = 0, CTL_ZERO_BYTES = 2 * MiB;
constexpr size_t WS_MODS = 2 * MiB;
constexpr size_t WS_ROPE = 3 * MiB;
constexpr size_t WS_TOK  = 4 * MiB;
constexpr size_t WS_LIST = 5 * MiB;
constexpr size_t WS_GN   = 6 * MiB;
constexpr size_t WS_MISC = 7 * MiB;
constexpr size_t WS_WEIN = 8 * MiB;
constexpr size_t WS_WEO  = 14 * MiB;
constexpr size_t WS_WGU  = 16 * MiB;
constexpr size_t WS_WDN  = 27 * MiB;
constexpr size_t WS_WOIN = 33 * MiB;
constexpr size_t WS_WOO  = 37 * MiB;
constexpr size_t WS_DFTC = 39 * MiB;
constexpr size_t WS_DFTL = 40 * MiB;
constexpr size_t WS_XC   = 56 * MiB;
constexpr size_t WS_H    = 72 * MiB;
constexpr size_t WS_CAT  = 144 * MiB;
constexpr size_t WS_Y    = 216 * MiB;
constexpr size_t WS_YS   = 144 * MiB;
constexpr size_t WS_BIG  = 288 * MiB;
constexpr size_t WS_H8   = WS_H;
constexpr size_t WS_EWDN = WS_H + 32 * MiB;
constexpr size_t WS_EWGU = WS_BIG + 231 * MiB;
constexpr size_t WS_END  = WS_EWGU + 56 * MiB;
static_assert(WS_END <= 589 * MiB, "workspace");
static_assert((size_t)264 * 256 * FFE <= 231 * MiB, "HID2");
static_assert(WS_EWDN + 28 * MiB <= WS_CAT, "EWDN inside the H region");
constexpr float S_ACT = 8.f, S_WGU = 256.f, S_HID = 8.f, S_WDN = 1024.f;

constexpr int CW_BAR = 4096;
constexpr int CW_CNT = 64;
constexpr int NWAVES = 8;
constexpr int RING_BYTES = 131072;
constexpr int MISC_OFF = RING_BYTES + 320;
constexpr int LDS_BYTES = 147456;

__device__ __forceinline__ unsigned f2bf(float f) { unsigned u = __builtin_bit_cast(unsigned, f); return (u + 0x7fffu + ((u >> 16) & 1u)) >> 16; }
__device__ __forceinline__ unsigned pk2(float lo, float hi) { return f2bf(lo) | (f2bf(hi) << 16); }
__device__ __forceinline__ unsigned cvt_pk_bf16(float lo, float hi) { unsigned r; asm volatile("v_cvt_pk_bf16_f32 %0, %1, %2" : "=v"(r) : "v"(lo), "v"(hi)); return r; }
__device__ __forceinline__ float bf_lo(unsigned w) { return __builtin_bit_cast(float, w << 16); }
__device__ __forceinline__ float bf_hi(unsigned w) { return __builtin_bit_cast(float, w & 0xffff0000u); }
__device__ __forceinline__ float wave_sum(float v) {
#pragma unroll
    for (int o = 1; o < 64; o <<= 1) v += __shfl_xor(v, o);
    return v;
}
__device__ __forceinline__ float silu_f(float g) { return g / (1.f + __expf(-g)); }
__device__ __forceinline__ float clamp8(float v) { return fminf(fmaxf(v, -448.f), 448.f); }
__device__ __forceinline__ unsigned pk4_fp8(float a, float b, float c, float d) {
    int p = __builtin_amdgcn_cvt_pk_fp8_f32(clamp8(a), clamp8(b), 0, false);
    p = __builtin_amdgcn_cvt_pk_fp8_f32(clamp8(c), clamp8(d), p, true);
    return (unsigned)p;
}

#define XB_TMO      128
#define XB_XCNT(j)  (256  + 64 * (j))
#define XB_XSUB(j)  (1280 + 64 * (j))
#define XB_XGEN(j)  (2304 + 64 * (j))
#define XB_TOP      3328
#define XB_TOPGEN   3392
#define XCD_BAR_WORDS 3456
#define XB_SPIN_CAP (1u << 18)
__device__ __forceinline__ unsigned xb_ld(unsigned* p)              { return __hip_atomic_load(p, __ATOMIC_RELAXED, __HIP_MEMORY_SCOPE_AGENT); }
__device__ __forceinline__ unsigned xb_add(unsigned* p, unsigned v) { return __hip_atomic_fetch_add(p, v, __ATOMIC_RELAXED, __HIP_MEMORY_SCOPE_AGENT); }
__device__ __forceinline__ unsigned xb_xcc_id() { return (unsigned)__builtin_amdgcn_s_getreg((3 << 11) | 20) & 0xFu; }
#define XB_SPIN(cond, bar) do { unsigned _sp = 0; while (cond) { __builtin_amdgcn_s_sleep(1); \
    if ((++_sp & 255u) == 0u) { if (xb_ld(&(bar)[XB_TMO])) break; if (_sp > XB_SPIN_CAP) { atomicAdd(&(bar)[XB_TMO], 1u); break; } } } } while (0)
struct XcdBarrier { unsigned* bar; unsigned x; volatile LAS unsigned* st; };
__device__ __forceinline__ XcdBarrier xcd_barrier_post(unsigned* bar, volatile LAS unsigned* st) {
    XcdBarrier b; b.bar = bar; b.x = xb_xcc_id(); b.st = st;
    if (threadIdx.x == 0) (void)xb_add(&bar[XB_XCNT(b.x)], 1u);
    return b;
}
__device__ __forceinline__ void xcd_barrier_complete(unsigned* bar, unsigned x, unsigned& nloc, unsigned& nx) {
    const unsigned G = gridDim.x * gridDim.y * gridDim.z;
    unsigned sum, cnt, mine, sp = 0u;
    for (;;) {
        sum = 0u; cnt = 0u; mine = 0u;
#pragma unroll
        for (unsigned j = 0; j < 16; ++j) { const unsigned c = xb_ld(&bar[XB_XCNT(j)]); sum += c; cnt += (c > 0u) ? 1u : 0u; mine = (j == x) ? c : mine; }
        if (sum == G) break;
        __builtin_amdgcn_s_sleep(1);
        if ((++sp & 255u) == 0u) { if (xb_ld(&bar[XB_TMO])) break; if (sp > XB_SPIN_CAP) { atomicAdd(&bar[XB_TMO], 1u); break; } }
    }
    nloc = mine > 0u ? mine : 1u; nx = cnt > 0u ? cnt : 1u;
}
__device__ __forceinline__ void xcd_barrier(const XcdBarrier& b) {
    asm volatile("s_waitcnt vmcnt(0)" ::: "memory");
    __syncthreads();
    if (threadIdx.x == 0) {
        unsigned* bar = b.bar;
        __builtin_amdgcn_s_waitcnt(0);
        unsigned nloc = b.st[0], nx = b.st[1];
        if (nloc == 0u) { xcd_barrier_complete(bar, b.x, nloc, nx); b.st[0] = nloc; b.st[1] = nx; }
        const unsigned old = xb_add(&bar[XB_XSUB(b.x)], 1u);
        const unsigned gen = old / nloc;
        if (old + 1u == (gen + 1u) * nloc) {
            __builtin_amdgcn_fence(__ATOMIC_RELEASE, "agent");
            asm volatile("s_waitcnt vmcnt(0)" ::: "memory");
            const unsigned og = xb_add(&bar[XB_TOP], 1u);
            const unsigned tg = og / nx;
            if (og + 1u == (tg + 1u) * nx) xb_add(&bar[XB_TOPGEN], 1u);
            else XB_SPIN(xb_ld(&bar[XB_TOPGEN]) == tg, bar);
            __builtin_amdgcn_fence(__ATOMIC_ACQUIRE, "agent");
            xb_add(&bar[XB_XGEN(b.x)], 1u);
            asm volatile("s_waitcnt vmcnt(0)" ::: "memory");
        } else {
            XB_SPIN(xb_ld(&bar[XB_XGEN(b.x)]) == gen, bar);
            __builtin_amdgcn_fence(__ATOMIC_ACQUIRE, "agent");
            asm volatile("s_waitcnt vmcnt(0)" ::: "memory");
        }
    }
    __syncthreads();
}

namespace pg8 {
constexpr int BM = 256, BK = 64, HALF = 128, HTB = HALF * BK * 2, STAGE_BYTES = 8 * HTB, NXCD = 8, WGM = 8;
__host__ __device__ __forceinline__ int lds_byte(int r, int c) { const int st = (r >> 4) * 2 + (c >> 5), rr = r & 15, cc = c & 31, ob = rr * 64 + cc * 2; return st * 1024 + (ob ^ (((ob >> 9) & 1) << 5)); }
__host__ __device__ __forceinline__ void stage_rc(int b, int& R, int& C) { const int st = b / 1024, sb = b % 1024, swz = sb ^ (((sb >> 9) & 1) << 5); R = (st >> 1) * 16 + swz / 64; C = (st & 1) * 32 + (swz % 64) / 2; }
__host__ __device__ __forceinline__ int perm32(int rho) { const int n = rho >> 4, i = rho & 15; return 8 * (i >> 2) + 4 * n + (i & 3); }

struct Unit { int pm, pn; int orow0, ocol0; unsigned long long bofs; int aux; };
struct Gemm { const void* A; const void* Bt; int lda, ldb, K; };

typedef int i32x8 __attribute__((ext_vector_type(8)));
typedef int i32x4 __attribute__((ext_vector_type(4)));
__device__ __forceinline__ i32x8 cat8(bf16x8 a, bf16x8 b) { const u32x4 x = __builtin_bit_cast(u32x4, a), y = __builtin_bit_cast(u32x4, b); return (i32x8){(int)x.x, (int)x.y, (int)x.z, (int)x.w, (int)y.x, (int)y.y, (int)y.z, (int)y.w}; }
template <bool FP8, class Epi, class Sched>
__device__ __forceinline__ void gemm_phase(LAS unsigned char* lds, const Gemm g, const Sched& S, const Epi& E) {
    const int tid = threadIdx.x, wid = __builtin_amdgcn_readfirstlane(tid >> 6), lane = tid & 63, wr = wid >> 2, wc = wid & 3, fr = lane & 15, fq = lane >> 4;
    const int nt = g.K / (BK * 2);
    int Rr[2]; unsigned Cb[2], voffB[2];
#pragma unroll
    for (int i = 0; i < 2; ++i) { int R, C; stage_rc(tid * 16 + i * 8192, R, C); const int Rb = (R & ~31) + perm32(R & 31);
        Rr[i] = R; Cb[i] = (unsigned)C * 2u; voffB[i] = (unsigned)(Rb * g.ldb + C * 2); }
    const size_t kstep = (size_t)(BK * 2);
    const size_t hstepB = (size_t)HALF * g.ldb;
    const unsigned lda2 = (unsigned)g.lda;
    const unsigned ldsw = (unsigned)wid * 1024u;
    const int aoff = lds_byte(wr * 64 + fr, fq * 8), boff = lds_byte(wc * 32 + fr, fq * 8);
#define PG8_SA(b, h) (((b) * 2 + (h)) * HTB)
#define PG8_SB(b, h) ((4 + (b) * 2 + (h)) * HTB)
#define PG8_STAGE(bufoff, gbase, voff) do { _Pragma("unroll") for (int _i = 0; _i < 2; ++_i) \
        __builtin_amdgcn_global_load_lds((const unsigned*)((const char*)(gbase) + (voff)[_i]), (LAS unsigned*)(lds + (bufoff) + ldsw + _i * 8192), 16, 0, 0); } while (0)
#define PG8_LD16(p) (*(const LAS i32x4*)(p))
#define PG8_LDA(dst, b, h) do { _Pragma("unroll") for (int m = 0; m < 4; ++m) { const i32x4 x_ = PG8_LD16(lds + PG8_SA(b, h) + aoff + m * 2048), y_ = PG8_LD16(lds + PG8_SA(b, h) + aoff + m * 2048 + 1024); \
        dst[m] = (i32x8){x_.x, x_.y, x_.z, x_.w, y_.x, y_.y, y_.z, y_.w}; } } while (0)
#define PG8_LDB(dst, b, h) do { _Pragma("unroll") for (int n = 0; n < 2; ++n) { const i32x4 x_ = PG8_LD16(lds + PG8_SB(b, h) + boff + n * 2048), y_ = PG8_LD16(lds + PG8_SB(b, h) + boff + n * 2048 + 1024); \
        dst[n] = (i32x8){x_.x, x_.y, x_.z, x_.w, y_.x, y_.y, y_.z, y_.w}; } } while (0)
#define PG8_HALF(v, k) __builtin_bit_cast(bf16x8, (k) == 0 ? (i32x4){v.s0, v.s1, v.s2, v.s3} : (i32x4){v.s4, v.s5, v.s6, v.s7})
#define PG8_MMA(ai, bj, At, Bt) do { __builtin_amdgcn_s_setprio(1); _Pragma("unroll") for (int m = 0; m < 4; ++m) _Pragma("unroll") for (int n = 0; n < 2; ++n) { \
        if constexpr (FP8) { asm volatile("v_mfma_scale_f32_16x16x128_f8f6f4 %0, %1, %2, %0, %3, %3 op_sel_hi:[0,0,0]" : "+v"(acc[ai][bj][m][n]) : "v"(Bt[n]), "v"(At[m]), "v"(sc1)); } \
        else { _Pragma("unroll") for (int k = 0; k < 2; ++k) acc[ai][bj][m][n] = __builtin_amdgcn_mfma_f32_16x16x32_bf16(PG8_HALF(Bt[n], k), PG8_HALF(At[m], k), acc[ai][bj][m][n], 0, 0, 0); } } __builtin_amdgcn_s_setprio(0); } while (0)
#define PG8_WAIT_V(n) asm volatile("s_waitcnt vmcnt(" #n ")" ::: "memory")
#define PG8_WAIT_L(n) asm volatile("s_waitcnt lgkmcnt(" #n ")" ::: "memory")
#define PG8_BAR __builtin_amdgcn_s_barrier()
#define PG8_SCHED __builtin_amdgcn_sched_barrier(0)
#define PG8_AOFF(dst, u) do { _Pragma("unroll") for (int _h = 0; _h < 2; ++_h) _Pragma("unroll") for (int _i = 0; _i < 2; ++_i) \
        dst[_h][_i] = (unsigned)S.arow(u, _h * HALF + Rr[_i]) * lda2 + Cb[_i]; } while (0)
    Unit cur, nxt; int ui = 0;
    if (!S.next(0, cur)) return;
    f32x4 acc[2][2][4][2];
#pragma unroll
    for (int a = 0; a < 2; ++a)
#pragma unroll
        for (int b = 0; b < 2; ++b)
#pragma unroll
            for (int m = 0; m < 4; ++m)
#pragma unroll
                for (int n = 0; n < 2; ++n) acc[a][b][m][n] = (f32x4){0.f, 0.f, 0.f, 0.f};
    i32x8 At[4], B0[2], B1[2];
    const int sc1 = 0x7f7f7f7f;
    unsigned aoc[2][2], aon[2][2];
    PG8_AOFF(aoc, cur);
    const char* const Ab = (const char*)g.A;
    const char* cB = (const char*)g.Bt + cur.bofs;
    PG8_STAGE(PG8_SB(0, 0), cB, voffB); PG8_STAGE(PG8_SB(0, 1), cB + hstepB, voffB); PG8_STAGE(PG8_SA(0, 0), Ab, aoc[0]); PG8_STAGE(PG8_SA(0, 1), Ab, aoc[1]);
    if (wr == 1) PG8_BAR;
    PG8_WAIT_V(2); PG8_BAR;
    PG8_STAGE(PG8_SB(1, 0), cB + kstep, voffB); PG8_STAGE(PG8_SA(1, 0), Ab + kstep, aoc[0]); PG8_STAGE(PG8_SB(1, 1), cB + hstepB + kstep, voffB);
    PG8_WAIT_V(6); PG8_BAR;
    for (;;) {
        const bool has_next = S.next(ui + 1, nxt);
        const char* nB = has_next ? (const char*)g.Bt + nxt.bofs : cB;
        if (has_next) { PG8_AOFF(aon, nxt); } else {
#pragma unroll
            for (int h = 0; h < 2; ++h)
#pragma unroll
                for (int i = 0; i < 2; ++i) aon[h][i] = aoc[h][i]; }
#pragma unroll 1
        for (int t = 0; t < nt; t += 2) {
            const bool last = (t == nt - 2);
            const char* a1 = Ab + (size_t)(t + 1) * kstep;
            const char* a2 = last ? Ab : Ab + (size_t)(t + 2) * kstep; const char* b2 = last ? nB : cB + (size_t)(t + 2) * kstep;
            const char* a3 = a2 + kstep; const char* b3 = b2 + kstep;
            unsigned ao2[2][2];
#pragma unroll
            for (int h = 0; h < 2; ++h)
#pragma unroll
                for (int i = 0; i < 2; ++i) ao2[h][i] = last ? aon[h][i] : aoc[h][i];
            PG8_LDB(B0, 0, 0); PG8_LDB(B1, 0, 1); PG8_SCHED; PG8_LDA(At, 0, 0); PG8_STAGE(PG8_SA(1, 1), a1, aoc[1]);
            PG8_WAIT_V(8); PG8_WAIT_L(0); PG8_BAR; PG8_MMA(0, 0, At, B0); PG8_MMA(0, 1, At, B1); PG8_BAR; PG8_SCHED;
            PG8_LDA(At, 0, 1); PG8_STAGE(PG8_SB(0, 0), b2, voffB); PG8_STAGE(PG8_SB(0, 1), b2 + hstepB, voffB); PG8_STAGE(PG8_SA(0, 0), a2, ao2[0]);
            PG8_WAIT_V(8); PG8_WAIT_L(0); PG8_BAR; PG8_MMA(1, 0, At, B0); PG8_MMA(1, 1, At, B1); PG8_BAR; PG8_SCHED;
            PG8_LDB(B0, 1, 0); PG8_LDB(B1, 1, 1); PG8_SCHED; PG8_LDA(At, 1, 0); PG8_STAGE(PG8_SA(0, 1), a2, ao2[1]);
            PG8_WAIT_V(8); PG8_WAIT_L(0); PG8_BAR; PG8_MMA(0, 0, At, B0); PG8_MMA(0, 1, At, B1); PG8_BAR; PG8_SCHED;
            PG8_LDA(At, 1, 1); PG8_STAGE(PG8_SB(1, 0), b3, voffB); PG8_STAGE(PG8_SB(1, 1), b3 + hstepB, voffB); PG8_STAGE(PG8_SA(1, 0), a3, ao2[0]);
            PG8_WAIT_V(8); PG8_WAIT_L(0); PG8_BAR; PG8_MMA(1, 0, At, B0); PG8_MMA(1, 1, At, B1); PG8_BAR; PG8_SCHED;
        }
        if (wr == 0) PG8_BAR;
        if constexpr (FP8) asm volatile("s_nop 15\n\ts_nop 15" ::: "memory");
        E(acc, cur, wr, wc, fr, fq);
        if (!has_next) break;
#pragma unroll
        for (int a = 0; a < 2; ++a)
#pragma unroll
            for (int b = 0; b < 2; ++b)
#pragma unroll
                for (int m = 0; m < 4; ++m)
#pragma unroll
                    for (int n = 0; n < 2; ++n) acc[a][b][m][n] = (f32x4){0.f, 0.f, 0.f, 0.f};
        cur = nxt; cB = nB; ++ui;
#pragma unroll
        for (int h = 0; h < 2; ++h)
#pragma unroll
            for (int i = 0; i < 2; ++i) aoc[h][i] = aon[h][i];
        if (wr == 1) PG8_BAR;
    }
    PG8_WAIT_V(0);
    PG8_BAR;
#undef PG8_SA
#undef PG8_SB
#undef PG8_STAGE
#undef PG8_LDA
#undef PG8_LD16
#undef PG8_HALF
#undef PG8_LDB
#undef PG8_MMA
#undef PG8_WAIT_V
#undef PG8_WAIT_L
#undef PG8_BAR
#undef PG8_SCHED
#undef PG8_AOFF
}

struct DenseOrder {
    int nM, nN, nwg, G, c; int ocw; unsigned long long bstep;
    __device__ __forceinline__ void init(int nM_, int nN_, int G_, int c_, int ocw_, int ldb) { nM = nM_; nN = nN_; nwg = nM * nN; G = G_; c = c_; ocw = ocw_; bstep = (unsigned long long)BM * ldb; }
    __device__ __forceinline__ bool next(int i, Unit& u) const {
        const long L = (long)i * G + c; if (L >= nwg) return false;
        int wgid = (int)L; { const int q = nwg / NXCD, r = nwg % NXCD, xcd = wgid % NXCD, off = wgid / NXCD; wgid = (xcd < r ? xcd * (q + 1) : r * (q + 1) + (xcd - r) * q) + off; }
        const int nig = WGM * nN, gid = wgid / nig, fm = gid * WGM, gsz = (nM - fm) < WGM ? (nM - fm) : WGM;
        u.pm = fm + ((wgid % nig) % gsz); u.pn = (wgid % nig) / gsz;
        u.orow0 = u.pm * BM; u.ocol0 = u.pn * ocw; u.bofs = (unsigned long long)u.pn * bstep; u.aux = 0; return true;
    }
    __device__ __forceinline__ int arow(const Unit& u, int r) const { return u.pm * BM + r; }
};
}

struct EpiPlain {
    bf16* O; int ldc; float scale;
    __device__ __forceinline__ void operator()(const f32x4 (&acc)[2][2][4][2], const pg8::Unit& u, int wr, int wc, int fr, int fq) const {
        const int row0 = u.orow0 + wr * 64 + fr, col0 = u.ocol0 + wc * 32 + 8 * fq;
#pragma unroll
        for (int ai = 0; ai < 2; ++ai)
#pragma unroll
            for (int m = 0; m < 4; ++m) { bf16* rowp = O + (size_t)(row0 + ai * 128 + m * 16) * ldc + col0;
#pragma unroll
                for (int bj = 0; bj < 2; ++bj) { const f32x4 v0 = acc[ai][bj][m][0] * scale, v1 = acc[ai][bj][m][1] * scale;
                    u32x4 w; w.x = cvt_pk_bf16(v0[0], v0[1]); w.y = cvt_pk_bf16(v0[2], v0[3]); w.z = cvt_pk_bf16(v1[0], v1[1]); w.w = cvt_pk_bf16(v1[2], v1[3]);
                    *(u32x4*)(rowp + bj * 128) = w; } }
    }
};
struct EpiSwiglu {
    bf16* O; int ldc;
    __device__ __forceinline__ void operator()(const f32x4 (&acc)[2][2][4][2], const pg8::Unit& u, int wr, int wc, int fr, int fq) const {
        const int row0 = u.orow0 + wr * 64 + fr, col0 = u.ocol0 + wc * 32 + 8 * fq;
#pragma unroll
        for (int ai = 0; ai < 2; ++ai)
#pragma unroll
            for (int m = 0; m < 4; ++m) { bf16* rowp = O + (size_t)(row0 + ai * 128 + m * 16) * ldc + col0;
                float r[8];
#pragma unroll
                for (int n = 0; n < 2; ++n)
#pragma unroll
                    for (int j = 0; j < 4; ++j) { const float gt = acc[ai][0][m][n][j], up = acc[ai][1][m][n][j]; r[n * 4 + j] = silu_f(gt) * up; }
                u32x4 w; w.x = cvt_pk_bf16(r[0], r[1]); w.y = cvt_pk_bf16(r[2], r[3]); w.z = cvt_pk_bf16(r[4], r[5]); w.w = cvt_pk_bf16(r[6], r[7]);
                *(u32x4*)rowp = w; }
    }
};
struct EpiSwiglu8 {
    unsigned char* O; int ldc;
    __device__ __forceinline__ void operator()(const f32x4 (&acc)[2][2][4][2], const pg8::Unit& u, int wr, int wc, int fr, int fq) const {
        const int row0 = u.orow0 + wr * 64 + fr, col0 = u.ocol0 + wc * 32 + 8 * fq;
        constexpr float inv = 1.f / (S_ACT * S_WGU);
#pragma unroll
        for (int ai = 0; ai < 2; ++ai)
#pragma unroll
            for (int m = 0; m < 4; ++m) { unsigned char* rowp = O + (size_t)(row0 + ai * 128 + m * 16) * ldc + col0;
                float r[8];
#pragma unroll
                for (int n = 0; n < 2; ++n)
#pragma unroll
                    for (int j = 0; j < 4; ++j) { const float gt = acc[ai][0][m][n][j] * inv, up = acc[ai][1][m][n][j] * (inv * S_HID); r[n * 4 + j] = silu_f(gt) * up; }
                u32x2 w; w.x = pk4_fp8(r[0], r[1], r[2], r[3]); w.y = pk4_fp8(r[4], r[5], r[6], r[7]);
                *(u32x2*)rowp = w; }
    }
};
struct EpiDftC {
    bf16* PQt; const float* gn;
    __device__ __forceinline__ void operator()(const f32x4 (&acc)[2][2][4][2], const pg8::Unit& u, int wr, int wc, int fr, int fq) const {
        const int gi = u.pm, jrow = wr * 64 + fr;
        const int tok0 = u.pn * 256 + wc * 32 + 8 * fq;
#pragma unroll
        for (int bj = 0; bj < 2; ++bj) {
            const int tk = tok0 + bj * 128; const int b = tk >> 11, l = tk & 2047;
            bf16* base = PQt + ((size_t)(b * 512 + gi * 128 + jrow)) * 4096 + l;
            float mu[8], rs[8];
            { const f32x4* p = (const f32x4*)(gn + ((size_t)gi * ML + tk) * 2);
#pragma unroll
              for (int j = 0; j < 4; ++j) { const f32x4 t = p[j]; mu[2 * j] = t[0]; rs[2 * j] = t[1]; mu[2 * j + 1] = t[2]; rs[2 * j + 1] = t[3]; } }
#pragma unroll
            for (int ai = 0; ai < 2; ++ai) {
#pragma unroll
                for (int m = 0; m < 4; ++m) {
                    const float dc = (ai == 0 && m == 0 && jrow == 0) ? 128.f : 0.f;
                    float r[8];
#pragma unroll
                    for (int n = 0; n < 2; ++n)
#pragma unroll
                        for (int j = 0; j < 4; ++j) r[n * 4 + j] = rs[n * 4 + j] * (acc[ai][bj][m][n][j] - mu[n * 4 + j] * dc);
                    u32x4 w; w.x = cvt_pk_bf16(r[0], r[1]); w.y = cvt_pk_bf16(r[2], r[3]); w.z = cvt_pk_bf16(r[4], r[5]); w.w = cvt_pk_bf16(r[6], r[7]);
                    *(u32x4*)(base + (size_t)m * 16 * 4096 + ai * 2048) = w; }
                asm volatile("" ::: "memory"); }
        }
    }
};

struct Frame {
    LAS unsigned char* lds;
    int tid, lane, wave, G, vcu, gw, NGW;
    const float* in[26];
    float* out; unsigned char* ws;
};
#define IN_X 0
#define IN_C 1
#define IN_CTX 2
#define IN_CCTX 3
#define IN_WMOD 4
#define IN_BMOD 5
#define IN_LNG 6
#define IN_LNB 7
#define IN_EWIN 8
#define IN_ECONV 9
#define IN_LQ1 10
#define IN_LK1 11
#define IN_LQ2 12
#define IN_LK2 13
#define IN_SUBG 14
#define IN_EWO 15
#define IN_EGATE 16
#define IN_EUP 17
#define IN_EDOWN 18
#define IN_OWIN 19
#define IN_RPB 20
#define IN_OWO 21
#define IN_ROUTER 22
#define IN_XGATE 23
#define IN_XUP 24
#define IN_XDOWN 25

__device__ __forceinline__ const float* mods_ptr(const Frame& F, int layer, int cond, int which) { return (const float*)(F.ws + WS_MODS) + ((size_t)(layer * NCOND + cond) * 6 + which) * DM; }
__device__ __forceinline__ int cond_of_row(int row) { return row < ML ? (row >> 11) : NCOND - 1; }

__device__ __forceinline__ void conv_item(const float* W, int K, int N, bf16* WT, int mode, LAS float* scr, int item, int lane) {
    const int nblk = N / 32, kb = item / nblk, nb = item % nblk, k0 = 64 * kb, n0 = 32 * nb;
#pragma unroll 8
    for (int i = 0; i < 32; ++i) { const int kk = 2 * i + (lane >> 5); scr[kk * 33 + (lane & 31)] = W[(size_t)(k0 + kk) * N + n0 + (lane & 31)]; }
    asm volatile("s_waitcnt lgkmcnt(0)" ::: "memory");
    const int d0 = (mode == 0) ? n0 : ((n0 >> 7) * 256 + (n0 & 127) + (mode == 2 ? 128 : 0));
    const int c = lane & 7;
#pragma unroll
    for (int j = 0; j < 4; ++j) { const int n = (lane >> 3) + 8 * j; const LAS float* s = scr + (8 * c) * 33 + n;
        u32x4 o; o.x = pk2(s[0 * 33], s[1 * 33]); o.y = pk2(s[2 * 33], s[3 * 33]); o.z = pk2(s[4 * 33], s[5 * 33]); o.w = pk2(s[6 * 33], s[7 * 33]);
        *(u32x4*)(WT + (size_t)(d0 + n) * K + k0 + 8 * c) = o; }
    asm volatile("s_waitcnt lgkmcnt(0)" ::: "memory");
}

__device__ __forceinline__ void conv_item8(const float* W, int K, int N, unsigned char* WT, int mode, float scale, LAS float* scr, int item, int lane) {
    const int nblk = N / 32, kb = item / nblk, nb = item % nblk, k0 = 64 * kb, n0 = 32 * nb;
#pragma unroll 8
    for (int i = 0; i < 32; ++i) { const int kk = 2 * i + (lane >> 5); scr[kk * 33 + (lane & 31)] = W[(size_t)(k0 + kk) * N + n0 + (lane & 31)]; }
    asm volatile("s_waitcnt lgkmcnt(0)" ::: "memory");
    const int d0 = (mode == 0) ? n0 : ((n0 >> 7) * 256 + (n0 & 127) + (mode == 2 ? 128 : 0));
    const int c = lane & 7;
#pragma unroll
    for (int j = 0; j < 4; ++j) { const int n = (lane >> 3) + 8 * j; const LAS float* s = scr + (8 * c) * 33 + n;
        u32x2 o; o.x = pk4_fp8(s[0 * 33] * scale, s[1 * 33] * scale, s[2 * 33] * scale, s[3 * 33] * scale); o.y = pk4_fp8(s[4 * 33] * scale, s[5 * 33] * scale, s[6 * 33] * scale, s[7 * 33] * scale);
        *(u32x2*)(WT + (size_t)(d0 + n) * K + k0 + 8 * c) = o; }
    asm volatile("s_waitcnt lgkmcnt(0)" ::: "memory");
}

__device__ __forceinline__ void p0_prologue(Frame& F) {
    const int tid = F.tid, lane = F.lane, wave = F.wave;
    if ((int)blockIdx.x < 192) {
        LAS float* S = (LAS float*)F.lds;
        LAS float* red = (LAS float*)(F.lds + 17 * 1024 * 4);
        for (int i = tid; i < NCOND * DM; i += 512) { const int j = i >> 10, k = i & 1023; const float v = (j < 16) ? F.in[IN_C][j * DM + k] : F.in[IN_CCTX][k]; S[i] = silu_f(v); }
        __syncthreads();
        const int item = blockIdx.x, layer = item / 96, n = (item % 96) * 64 + lane;
        const float* W = F.in[IN_WMOD] + (size_t)layer * DM * 6144;
        float acc[NCOND];
#pragma unroll
        for (int j = 0; j < NCOND; ++j) acc[j] = 0.f;
        for (int k = wave * 128; k < wave * 128 + 128; ++k) { const float w = W[(size_t)k * 6144 + n];
#pragma unroll
            for (int j = 0; j < NCOND; ++j) acc[j] += S[j * DM + k] * w; }
#pragma unroll
        for (int j = 0; j < NCOND; ++j) red[(wave * NCOND + j) * 64 + lane] = acc[j];
        __syncthreads();
        for (int i = tid; i < NCOND * 64; i += 512) { const int j = i >> 6, l = i & 63; float s = 0.f;
#pragma unroll
            for (int w = 0; w < 8; ++w) s += red[(w * NCOND + j) * 64 + l];
            const int nn = (item % 96) * 64 + l;
            ((float*)(F.ws + WS_MODS))[(size_t)(layer * NCOND + j) * 6144 + nn] = s + F.in[IN_BMOD][layer * 6144 + nn]; }
        __syncthreads();
    }
    {
        LAS float* scr = (LAS float*)(F.lds + wave * 16384);
        constexpr int I_EIN = 16 * 96, I_EO = 16 * 32, I_G = 16 * 88, I_DN = 44 * 32, I_OIN = 16 * 64, I_OO = 16 * 32;
        constexpr int NIT = I_EIN + I_EO + 2 * I_G + I_DN + I_OIN + I_OO;
        for (int it = F.gw; it < NIT; it += F.NGW) {
            int r = it;
            if (r < I_EIN) { conv_item(F.in[IN_EWIN], DM, E_IN, (bf16*)(F.ws + WS_WEIN), 0, scr, r, lane); continue; } r -= I_EIN;
            if (r < I_EO) { conv_item(F.in[IN_EWO], DM, DM, (bf16*)(F.ws + WS_WEO), 0, scr, r, lane); continue; } r -= I_EO;
            if (r < I_G) { conv_item(F.in[IN_EGATE], DM, FF, (bf16*)(F.ws + WS_WGU), 1, scr, r, lane); continue; } r -= I_G;
            if (r < I_G) { conv_item(F.in[IN_EUP], DM, FF, (bf16*)(F.ws + WS_WGU), 2, scr, r, lane); continue; } r -= I_G;
            if (r < I_DN) { conv_item(F.in[IN_EDOWN], FF, DM, (bf16*)(F.ws + WS_WDN), 0, scr, r, lane); continue; } r -= I_DN;
            if (r < I_OIN) { conv_item(F.in[IN_OWIN], DM, O_IN, (bf16*)(F.ws + WS_WOIN), 0, scr, r, lane); continue; } r -= I_OIN;
            conv_item(F.in[IN_OWO], DM, DM, (bf16*)(F.ws + WS_WOO), 0, scr, r, lane);
        }
    }
    {
        const size_t gt = (size_t)blockIdx.x * 512 + tid, NT = (size_t)F.G * 512;
        bf16* DL = (bf16*)(F.ws + WS_DFTL);
        for (size_t i = gt; i < (size_t)2048 * 4096 / 8; i += NT) {
            const int k = (int)(i >> 9), l0 = (int)(i & 511) * 8; unsigned w[4];
#pragma unroll
            for (int j = 0; j < 8; j += 2) { float v[2];
#pragma unroll
                for (int q = 0; q < 2; ++q) { const int lp = l0 + j + q, l = lp & 2047; const int ph = (k * l) & 2047; float s, c; sincospif((float)ph * (1.f / 1024.f), &s, &c); v[q] = (lp < 2048) ? c : -s; }
                w[j >> 1] = pk2(v[0], v[1]); }
            *(u32x4*)(DL + (size_t)k * 4096 + l0) = (u32x4){w[0], w[1], w[2], w[3]};
        }
        bf16* DC = (bf16*)(F.ws + WS_DFTC);
        for (size_t i = gt; i < (size_t)4 * 256 * 256; i += NT) {
            const int gi = (int)(i >> 16), mp = (int)(i >> 8) & 255, c2 = (int)i & 255; const int pq = mp >> 7, j = mp & 127, cg = c2 >> 7, c = c2 & 127;
            float v = 0.f;
            if (cg == (gi & 1)) { const int ph = (c * j) & 127; float s, cs; sincospif((float)ph * (1.f / 64.f), &s, &cs); v = pq ? s : cs; }
            DC[i] = (bf16)f2bf(v);
        }
        float* RP = (float*)(F.ws + WS_ROPE);
        for (size_t i = gt; i < (size_t)2048 * 32; i += NT) {
            const int t = (int)(i >> 5), j = (int)i & 31; const float pos = (j < 16) ? (float)(t >> 6) : (float)(t & 63);
            const float invf = powf(10000.f, -(float)(j & 15) / 16.f); const float ang = pos * invf;
            RP[i * 2] = cosf(ang); RP[i * 2 + 1] = sinf(ang);
        }
        if (gt == 0) {
            float s1 = 0.f, s2 = 0.f;
            for (int d = 0; d < 64; ++d) { s1 += F.in[IN_LQ1][d] * F.in[IN_LK1][d]; s2 += F.in[IN_LQ2][d] * F.in[IN_LK2][d]; }
            const float lam_init = 0.2f;
            ((float*)(F.ws + WS_MISC))[0] = expf(s1) - expf(s2) + lam_init;
        }
    }
}

__device__ __forceinline__ void conv_experts(Frame& F) {
    LAS float* scr = (LAS float*)(F.lds + F.wave * 16384);
    constexpr int I_G = 16 * 112, I_D = 56 * 32;
    constexpr int NIT = NEXP * (2 * I_G + I_D);
    for (int it = F.gw; it < NIT; it += F.NGW) {
        const int e = it / (2 * I_G + I_D); int r = it % (2 * I_G + I_D);
        unsigned char* gu = F.ws + WS_EWGU + (size_t)e * 7168 * DM;
        if (r < I_G) { conv_item8(F.in[IN_XGATE] + (size_t)e * DM * FFE, DM, FFE, gu, 1, S_WGU, scr, r, F.lane); continue; } r -= I_G;
        if (r < I_G) { conv_item8(F.in[IN_XUP] + (size_t)e * DM * FFE, DM, FFE, gu, 2, S_WGU, scr, r, F.lane); continue; } r -= I_G;
        conv_item8(F.in[IN_XDOWN] + (size_t)e * FFE * DM, FFE, DM, F.ws + WS_EWDN + (size_t)e * DM * FFE, 0, S_WDN, scr, r, F.lane);
    }
}

__device__ __forceinline__ void ld_row_f32(const float* p, int lane, f32x4 (&v)[4]) {
#pragma unroll
    for (int j = 0; j < 4; ++j) v[j] = *(const f32x4*)(p + 4 * lane + 256 * j);
}
__device__ __forceinline__ void ld_row_bf16(const bf16* p, int lane, f32x4 (&v)[4]) {
#pragma unroll
    for (int j = 0; j < 4; ++j) { const u32x2 w = *(const u32x2*)(p + 4 * lane + 256 * j); v[j] = (f32x4){bf_lo(w.x), bf_hi(w.x), bf_lo(w.y), bf_hi(w.y)}; }
}
__device__ __forceinline__ void st_row_f32(float* p, int lane, const f32x4 (&v)[4]) {
#pragma unroll
    for (int j = 0; j < 4; ++j) *(f32x4*)(p + 4 * lane + 256 * j) = v[j];
}
__device__ __forceinline__ void st_row_bf16(bf16* p, int lane, const f32x4 (&v)[4]) {
#pragma unroll
    for (int j = 0; j < 4; ++j) { u32x2 w; w.x = pk2(v[j][0], v[j][1]); w.y = pk2(v[j][2], v[j][3]); *(u32x2*)(p + 4 * lane + 256 * j) = w; }
}
__device__ __forceinline__ void ln_row(f32x4 (&v)[4], const float* g, const float* b, int lane) {
    float s = 0.f;
#pragma unroll
    for (int j = 0; j < 4; ++j) s += (v[j][0] + v[j][1]) + (v[j][2] + v[j][3]);
    const float mean = wave_sum(s) * (1.f / DM); float s2 = 0.f;
#pragma unroll
    for (int j = 0; j < 4; ++j) { v[j] = v[j] - mean; s2 += (v[j][0] * v[j][0] + v[j][1] * v[j][1]) + (v[j][2] * v[j][2] + v[j][3] * v[j][3]); }
    const float rstd = rsqrtf(wave_sum(s2) * (1.f / DM) + LN_EPS);
    f32x4 gg[4], bb[4]; ld_row_f32(g, lane, gg); ld_row_f32(b, lane, bb);
#pragma unroll
    for (int j = 0; j < 4; ++j) v[j] = v[j] * rstd * gg[j] + bb[j];
}
__device__ __forceinline__ void modulate_row(f32x4 (&h)[4], const f32x4 (&x)[4], const float* sh, const float* sc, int lane) {
    f32x4 a[4], c[4]; ld_row_f32(sh, lane, a); ld_row_f32(sc, lane, c);
#pragma unroll
    for (int j = 0; j < 4; ++j) h[j] = x[j] * (1.f + c[j]) + a[j];
}

__device__ __forceinline__ void p1_modulate(Frame& F) {
    bf16* H = (bf16*)(F.ws + WS_H);
    for (int row = F.gw; row < MT; row += F.NGW) {
        const int cond = cond_of_row(row);
        const float* xr = row < ML ? F.in[IN_X] + (size_t)row * DM : F.in[IN_CTX] + (size_t)(row - ML) * DM;
        f32x4 x[4], h[4]; ld_row_f32(xr, F.lane, x);
        modulate_row(h, x, mods_ptr(F, 0, cond, 0), mods_ptr(F, 0, cond, 1), F.lane);
        st_row_bf16(H + (size_t)row * DM, F.lane, h);
    }
}

__device__ __forceinline__ void p3_rope_conv(Frame& F) {
    bf16* P = (bf16*)(F.ws + WS_BIG); bf16* CAT = (bf16*)(F.ws + WS_CAT);
    const float* RP = (const float*)(F.ws + WS_ROPE);
    const float* wc = F.in[IN_ECONV];
    const int lane = F.lane;
    for (int row = F.gw; row < MT; row += F.NGW) {
        bf16* pr = P + (size_t)row * E_IN;
        if (row < ML) {
            const int t = row & 2047;
            const int d4 = 4 * (lane & 7);
            f32x4 cs[2];
            { const float* rp = RP + ((size_t)t * 32 + d4) * 2; cs[0] = *(const f32x4*)rp; cs[1] = *(const f32x4*)(rp + 4); }
            const float c0 = cs[0][0], s0 = cs[0][1], c1 = cs[0][2], s1 = cs[0][3], c2 = cs[1][0], s2 = cs[1][1], c3 = cs[1][2], s3 = cs[1][3];
#pragma unroll
            for (int pass = 0; pass < 2; ++pass) {
                bf16* gp = pr + 1536 + (pass * 8 + (lane >> 3)) * 64 + d4;
                const u32x2 a = *(const u32x2*)gp, b = *(const u32x2*)(gp + 32);
                const float x10 = bf_lo(a.x), x11 = bf_hi(a.x), x12 = bf_lo(a.y), x13 = bf_hi(a.y);
                const float x20 = bf_lo(b.x), x21 = bf_hi(b.x), x22 = bf_lo(b.y), x23 = bf_hi(b.y);
                u32x2 oa, ob;
                oa.x = pk2(x10 * c0 - x20 * s0, x11 * c1 - x21 * s1); oa.y = pk2(x12 * c2 - x22 * s2, x13 * c3 - x23 * s3);
                ob.x = pk2(x10 * s0 + x20 * c0, x11 * s1 + x21 * c1); ob.y = pk2(x12 * s2 + x22 * c2, x13 * s3 + x23 * c3);
                *(u32x2*)gp = oa; *(u32x2*)(gp + 32) = ob;
            }
        }
        const int t = row < ML ? (row & 2047) : ((row - ML) & 255); const int Ls = row < ML ? SEQ : LC;
        const int ch = 8 * lane;
        float cv[3][8];
#pragma unroll
        for (int dt = 0; dt < 3; ++dt) {
            const int tt = t + dt - 1;
            if (tt >= 0 && tt < Ls) { const bf16* q = P + (size_t)(row + dt - 1) * E_IN; const u32x4 cg = *(const u32x4*)(q + 512 + ch), vl = *(const u32x4*)(q + 1024 + ch);
#pragma unroll
                for (int j = 0; j < 4; ++j) { cv[dt][2 * j] = bf_lo(cg[j]) * bf_lo(vl[j]); cv[dt][2 * j + 1] = bf_hi(cg[j]) * bf_hi(vl[j]); } }
            else {
#pragma unroll
                for (int j = 0; j < 8; ++j) cv[dt][j] = 0.f; }
        }
        const u32x4 bg = *(const u32x4*)(pr + ch);
        float w0[8], w1[8], w2[8];
#pragma unroll
        for (int j = 0; j < 8; ++j) { w0[j] = wc[ch + j]; w1[j] = wc[512 + ch + j]; w2[j] = wc[1024 + ch + j]; }
        float o[8];
#pragma unroll
        for (int j = 0; j < 8; ++j) { const float bgv = (j & 1) ? bf_hi(bg[j >> 1]) : bf_lo(bg[j >> 1]); o[j] = bgv * (cv[0][j] * w0[j] + cv[1][j] * w1[j] + cv[2][j] * w2[j]); }
        u32x4 w; w.x = pk2(o[0], o[1]); w.y = pk2(o[2], o[3]); w.z = pk2(o[4], o[5]); w.w = pk2(o[6], o[7]);
        *(u32x4*)(CAT + (size_t)row * DM + ch) = w;
    }
}

__device__ __forceinline__ int crow(int r, int hi) { return (r & 3) + 8 * (r >> 2) + 4 * hi; }
__device__ __forceinline__ s16x4 vtr(const LAS unsigned char* p) { return __builtin_bit_cast(s16x4, __builtin_amdgcn_ds_read_tr16_b64_v4i16((LAS s16x4*)p)); }
__device__ __forceinline__ float xhalf_max(float v) { return fmaxf(v, __shfl_xor(v, 32)); }
__device__ __forceinline__ bf16x8 pack8(const f32x16& p, int s) {
    u32x4 w; w.x = cvt_pk_bf16(p[8 * s + 0], p[8 * s + 1]); w.y = cvt_pk_bf16(p[8 * s + 2], p[8 * s + 3]); w.z = cvt_pk_bf16(p[8 * s + 4], p[8 * s + 5]); w.w = cvt_pk_bf16(p[8 * s + 6], p[8 * s + 7]);
    return __builtin_bit_cast(bf16x8, w);
}
__device__ __forceinline__ int koff(int row, int ch) { return row * 128 + ((ch ^ ((row >> 1) & 7)) << 4); }
__device__ __forceinline__ int voff128(int row, int ch) { return 256 * row + 16 * (ch ^ (((row & 3) << 2) | ((row >> 2) & 3))); }
__device__ __forceinline__ int voff64(int row, int ch) { return 128 * row + 16 * (ch ^ (((row >> 1) & 1) << 2)); }

__device__ __forceinline__ void p4_diff_attn(Frame& F) {
    const bf16* P = (const bf16*)(F.ws + WS_BIG); bf16* CAT = (bf16*)(F.ws + WS_CAT);
    const float lam = ((const float*)(F.ws + WS_MISC))[0];
    const float* subg = F.in[IN_SUBG];
    const int tid = F.tid, lane = F.lane, wave = F.wave, r32 = lane & 31, hi = lane >> 5;
    const int comp = wave >> 2, qb = wave & 3;
    LAS unsigned char* lds = F.lds;
    constexpr int STG = 32768;
    constexpr float C2 = 0.125f * 1.4426950408889634f;
    constexpr int NU_LAT = NB * 4 * 16, NU = NU_LAT + NB * 4 * 2;
    for (int un = F.vcu; un < NU; un += F.G) {
        int b, h, qrow0, j0, j1;
        if (un < NU_LAT) { b = un >> 6; h = (un >> 4) & 3; qrow0 = b * SEQ + (un & 15) * 128; j0 = 0; j1 = 36; }
        else { const int v = un - NU_LAT; b = v >> 3; h = (v >> 1) & 3; qrow0 = ML + b * LC + (v & 1) * 128; j0 = 0; j1 = 4; }
        bf16x8 qf[4];
        { const bf16* qp = P + (size_t)(qrow0 + qb * 32 + r32) * E_IN + 1536 + h * 128 + comp * 64 + hi * 8;
#pragma unroll
          for (int ds = 0; ds < 4; ++ds) qf[ds] = *(const bf16x8*)(qp + ds * 16); }
        f32x16 o[4];
#pragma unroll
        for (int e = 0; e < 4; ++e) o[e] = (f32x16){};
        float mrun = -INFINITY, lrun = 0.f;
        u32x4 sk1, sk2, sv[2];
        const int krow = tid >> 3, kch = tid & 7;
#define DA_LOAD(j) do { const int rowb = ((j) < 4) ? (ML + b * LC + (j) * 64) : (b * SEQ + ((j) - 4) * 64); \
            const bf16* kp = P + (size_t)(rowb + krow) * E_IN + 2048 + h * 128 + kch * 8; sk1 = *(const u32x4*)kp; sk2 = *(const u32x4*)(kp + 64); \
            _Pragma("unroll") for (int i = 0; i < 2; ++i) { const int idx = tid + 512 * i; sv[i] = *(const u32x4*)(P + (size_t)(rowb + (idx >> 4)) * E_IN + 2560 + h * 128 + (idx & 15) * 8); } } while (0)
#define DA_STORE(st) do { LAS unsigned char* sb = lds + (st) * STG; *(LAS u32x4*)(sb + koff(krow, kch)) = sk1; *(LAS u32x4*)(sb + 8192 + koff(krow, kch)) = sk2; \
            _Pragma("unroll") for (int i = 0; i < 2; ++i) { const int idx = tid + 512 * i; *(LAS u32x4*)(sb + 16384 + voff128(idx >> 4, idx & 15)) = sv[i]; } } while (0)
        __syncthreads();
        DA_LOAD(j0); DA_STORE(0);
        __syncthreads();
        for (int j = j0; j < j1; ++j) {
            const int st = (j - j0) & 1;
            if (j + 1 < j1) DA_LOAD(j + 1);
            const LAS unsigned char* kb_ = lds + st * STG + comp * 8192;
            const LAS unsigned char* vb_ = lds + st * STG + 16384;
            f32x16 p[2];
#pragma unroll
            for (int kb = 0; kb < 2; ++kb) { p[kb] = (f32x16){};
#pragma unroll
                for (int ds = 0; ds < 4; ++ds) { const bf16x8 kf = *(const LAS bf16x8*)(kb_ + koff(kb * 32 + r32, ds * 2 + hi)); p[kb] = __builtin_amdgcn_mfma_f32_32x32x16_bf16(kf, qf[ds], p[kb], 0, 0, 0); } }
            float mx = p[0][0];
#pragma unroll
            for (int r = 0; r < 16; ++r) { mx = fmaxf(mx, p[0][r]); mx = fmaxf(mx, p[1][r]); }
            mx = xhalf_max(mx) * C2;
            const float mnew = fmaxf(mrun, mx); const float al = __builtin_amdgcn_exp2f(mrun - mnew); mrun = mnew;
            float ps = 0.f;
#pragma unroll
            for (int kb = 0; kb < 2; ++kb)
#pragma unroll
                for (int r = 0; r < 16; ++r) { const float e = __builtin_amdgcn_exp2f(p[kb][r] * C2 - mnew); p[kb][r] = e; ps += e; }
            lrun = lrun * al + ps;
#pragma unroll
            for (int e = 0; e < 4; ++e) o[e] = o[e] * al;
#pragma unroll
            for (int kb = 0; kb < 2; ++kb)
#pragma unroll
                for (int s = 0; s < 2; ++s) { const bf16x8 pf = pack8(p[kb], s);
                    const int rb = kb * 32 + 16 * s + 4 * hi + ((lane & 15) >> 2);
#pragma unroll
                    for (int e = 0; e < 4; ++e) { const int c0 = 4 * e + 2 * ((lane >> 4) & 1) + ((lane & 3) >> 1);
                        const s16x4 lo = vtr(vb_ + voff128(rb, c0) + 8 * (lane & 1)), hh = vtr(vb_ + voff128(rb + 8, c0) + 8 * (lane & 1));
                        const bf16x8 vf = (bf16x8){lo[0], lo[1], lo[2], lo[3], hh[0], hh[1], hh[2], hh[3]};
                        o[e] = __builtin_amdgcn_mfma_f32_32x32x16_bf16(vf, pf, o[e], 0, 0, 0); } }
            if (j + 1 < j1) DA_STORE(st ^ 1);
            __syncthreads();
        }
        const float linv = 1.f / (lrun + __shfl_xor(lrun, 32));
        LAS float* X = (LAS float*)(lds + qb * 16384);
        if (comp == 1) {
#pragma unroll
            for (int e = 0; e < 4; ++e)
#pragma unroll
                for (int r = 0; r < 16; ++r) X[(e * 16 + r) * 64 + lane] = o[e][r] * linv; }
        __syncthreads();
        if (comp == 0) {
            float ss = 0.f;
#pragma unroll
            for (int e = 0; e < 4; ++e)
#pragma unroll
                for (int r = 0; r < 16; ++r) { const float v = o[e][r] * linv - lam * X[(e * 16 + r) * 64 + lane]; o[e][r] = v; ss += v * v; }
            ss += __shfl_xor(ss, 32);
            const float rn = rsqrtf(ss * (1.f / 128.f) + RMS_EPS) * 0.8f;
            bf16* op = CAT + (size_t)(qrow0 + qb * 32 + r32) * DM + 512 + h * 128;
#pragma unroll
            for (int e = 0; e < 4; ++e)
#pragma unroll
                for (int r4 = 0; r4 < 4; ++r4) { const int ec = 32 * e + 8 * r4 + 4 * hi; const f32x4 g = *(const f32x4*)(subg + ec);
                    u32x2 w; w.x = pk2(o[e][4 * r4] * rn * g[0], o[e][4 * r4 + 1] * rn * g[1]); w.y = pk2(o[e][4 * r4 + 2] * rn * g[2], o[e][4 * r4 + 3] * rn * g[3]);
                    *(u32x2*)(op + ec) = w; }
        }
#undef DA_LOAD
#undef DA_STORE
    }
    __syncthreads();
}

__device__ __forceinline__ void p11_na_attn(Frame& F) {
    const bf16* P2 = (const bf16*)(F.ws + WS_BIG); bf16* CAT = (bf16*)(F.ws + WS_CAT);
    const int lane = F.lane, wave = F.wave, r32 = lane & 31, hi = lane >> 5;
    {
        float* GN = (float*)(F.ws + WS_GN);
        for (int row = F.gw; row < ML; row += F.NGW) {
            const u32x4 w = *(const u32x4*)(P2 + (size_t)row * O_IN + 8 * lane);
            float v[8];
#pragma unroll
            for (int j = 0; j < 4; ++j) { v[2 * j] = bf_lo(w[j]); v[2 * j + 1] = bf_hi(w[j]); }
            float s = 0.f;
#pragma unroll
            for (int j = 0; j < 8; ++j) s += v[j];
#pragma unroll
            for (int o = 1; o < 16; o <<= 1) s += __shfl_xor(s, o);
            const float mean = s * (1.f / 128.f); float q = 0.f;
#pragma unroll
            for (int j = 0; j < 8; ++j) { const float d = v[j] - mean; q += d * d; }
#pragma unroll
            for (int o = 1; o < 16; o <<= 1) q += __shfl_xor(q, o);
            if ((lane & 15) == 0) { float* g = GN + ((size_t)(lane >> 4) * ML + row) * 2; g[0] = mean; g[1] = rsqrtf(q * (1.f / 128.f) + LN_EPS); }
        }
    }
    LAS float* TAB = (LAS float*)(F.lds + 1024);
    __syncthreads();
    for (int i = F.tid; i < 8 * 15 * 32; i += 512) { const int dc = i & 31; TAB[i] = (dc < 31) ? F.in[IN_RPB][(i >> 5) * 31 + dc] : 0.f; }
    __syncthreads();
    LAS unsigned char* vt = F.lds + 32768 + wave * 8192;
    constexpr float C2 = 0.125f * 1.4426950408889634f, LOG2E = 1.4426950408889634f;
    constexpr int NWU = NB * 32 * 8 * 2;
    for (int wu = F.vcu * NWAVES + wave; wu < NWU; wu += F.G * NWAVES) {
        const int qh = wu & 1, h = (wu >> 1) & 7, r = (wu >> 4) & 31, b = wu >> 9;
        const int rs = min(max(r - 4, 0), 24);
        const int qc = qh * 32 + r32, cs = min(max(qc - 8, 0), 48);
        const int qrow = b * SEQ + r * 64 + qc;
        bf16x8 qf[4];
        { const bf16* qp = P2 + (size_t)qrow * O_IN + 512 + h * 64 + hi * 8;
#pragma unroll
          for (int ds = 0; ds < 4; ++ds) qf[ds] = *(const bf16x8*)(qp + ds * 16); }
        f32x16 o[2]; o[0] = (f32x16){}; o[1] = (f32x16){};
        float mrun = -INFINITY, lrun = 0.f;
        bf16x8 kf[2][4], kn[2][4]; u32x4 vn[8];
#define NA_ROWB(j) (((j) < 8) ? (b * SEQ + (rs + (j)) * 64) : (ML + b * LC + ((j) - 8) * 64))
#define NA_LOADK(dst, j) do { const bf16* kp = P2 + (size_t)(NA_ROWB(j) + r32) * O_IN + 1024 + h * 64 + hi * 8; \
            _Pragma("unroll") for (int kb = 0; kb < 2; ++kb) _Pragma("unroll") for (int ds = 0; ds < 4; ++ds) dst[kb][ds] = *(const bf16x8*)(kp + (size_t)kb * 32 * O_IN + ds * 16); } while (0)
#define NA_LOADV(j) do { const bf16* vp = P2 + (size_t)NA_ROWB(j) * O_IN + 1536 + h * 64; \
            _Pragma("unroll") for (int i = 0; i < 8; ++i) { const int idx = lane + 64 * i; vn[i] = *(const u32x4*)(vp + (size_t)(idx >> 3) * O_IN + (idx & 7) * 8); } } while (0)
#define NA_STOREV() do { _Pragma("unroll") for (int i = 0; i < 8; ++i) { const int idx = lane + 64 * i; *(LAS u32x4*)(vt + voff64(idx >> 3, idx & 7)) = vn[i]; } } while (0)
        NA_LOADK(kf, 0); NA_LOADV(0); NA_STOREV();
        for (int j = 0; j < 12; ++j) {
            if (j + 1 < 12) { NA_LOADK(kn, j + 1); NA_LOADV(j + 1); }
            f32x16 p[2];
#pragma unroll
            for (int kb = 0; kb < 2; ++kb) { p[kb] = (f32x16){};
#pragma unroll
                for (int ds = 0; ds < 4; ++ds) p[kb] = __builtin_amdgcn_mfma_f32_32x32x16_bf16(kf[kb][ds], qf[ds], p[kb], 0, 0, 0); }
            if (j < 8) {
                const int dr = rs + j - r + 7;
                const LAS float* tb = TAB + (h * 15 + dr) * 32 + (15 - qc + 4 * hi);
                const int kd = 4 * hi - cs;
#pragma unroll
                for (int kb = 0; kb < 2; ++kb)
#pragma unroll
                    for (int rr = 0; rr < 16; ++rr) { const int kc0 = kb * 32 + (rr & 3) + 8 * (rr >> 2);
                        const float bias = tb[kc0]; const bool ok = (unsigned)(kc0 + kd) < 16u;
                        p[kb][rr] = ok ? (p[kb][rr] * C2 + bias * LOG2E) : -INFINITY; }
            } else {
#pragma unroll
                for (int kb = 0; kb < 2; ++kb)
#pragma unroll
                    for (int rr = 0; rr < 16; ++rr) p[kb][rr] *= C2;
            }
            float mx = p[0][0];
#pragma unroll
            for (int rr = 0; rr < 16; ++rr) { mx = fmaxf(mx, p[0][rr]); mx = fmaxf(mx, p[1][rr]); }
            mx = xhalf_max(mx);
            const float mnew = fmaxf(mrun, mx); const float al = __builtin_amdgcn_exp2f(mrun - mnew); mrun = mnew;
            float ps = 0.f;
#pragma unroll
            for (int kb = 0; kb < 2; ++kb)
#pragma unroll
                for (int rr = 0; rr < 16; ++rr) { const float e = __builtin_amdgcn_exp2f(p[kb][rr] - mnew); p[kb][rr] = e; ps += e; }
            lrun = lrun * al + ps;
            o[0] = o[0] * al; o[1] = o[1] * al;
#pragma unroll
            for (int kb = 0; kb < 2; ++kb)
#pragma unroll
                for (int s = 0; s < 2; ++s) { const bf16x8 pf = pack8(p[kb], s);
                    const int rb = kb * 32 + 16 * s + 4 * hi + ((lane & 15) >> 2);
#pragma unroll
                    for (int e = 0; e < 2; ++e) { const int c0 = 4 * e + 2 * ((lane >> 4) & 1) + ((lane & 3) >> 1);
                        const s16x4 lo = vtr(vt + voff64(rb, c0) + 8 * (lane & 1)), hh = vtr(vt + voff64(rb + 8, c0) + 8 * (lane & 1));
                        const bf16x8 vf = (bf16x8){lo[0], lo[1], lo[2], lo[3], hh[0], hh[1], hh[2], hh[3]};
                        o[e] = __builtin_amdgcn_mfma_f32_32x32x16_bf16(vf, pf, o[e], 0, 0, 0); } }
            if (j + 1 < 12) {
                NA_STOREV();
#pragma unroll
                for (int kb = 0; kb < 2; ++kb)
#pragma unroll
                    for (int ds = 0; ds < 4; ++ds) kf[kb][ds] = kn[kb][ds];
            }
        }
        const float linv = 1.f / (lrun + __shfl_xor(lrun, 32));
        bf16* op = CAT + (size_t)qrow * DM + 512 + h * 64;
#pragma unroll
        for (int e = 0; e < 2; ++e)
#pragma unroll
            for (int r4 = 0; r4 < 4; ++r4) { const int ec = 32 * e + 8 * r4 + 4 * hi;
                u32x2 w; w.x = pk2(o[e][4 * r4] * linv, o[e][4 * r4 + 1] * linv); w.y = pk2(o[e][4 * r4 + 2] * linv, o[e][4 * r4 + 3] * linv);
                *(u32x2*)(op + ec) = w; }
#undef NA_ROWB
#undef NA_LOADK
#undef NA_LOADV
#undef NA_STOREV
    }
    __syncthreads();
}

__device__ __forceinline__ void p6_ln1_even(Frame& F) {
    const bf16* Y = (const bf16*)(F.ws + WS_Y); bf16* H = (bf16*)(F.ws + WS_H); float* XC = (float*)(F.ws + WS_XC);
    const float* lg = F.in[IN_LNG] + 0 * DM; const float* lb = F.in[IN_LNB] + 0 * DM;
    for (int row = F.gw; row < MT; row += F.NGW) {
        const int cond = cond_of_row(row);
        const float* xr = row < ML ? F.in[IN_X] + (size_t)row * DM : F.in[IN_CTX] + (size_t)(row - ML) * DM;
        f32x4 x[4], y[4], g[4], h[4]; ld_row_f32(xr, F.lane, x); ld_row_bf16(Y + (size_t)row * DM, F.lane, y); ld_row_f32(mods_ptr(F, 0, cond, 2), F.lane, g);
#pragma unroll
        for (int j = 0; j < 4; ++j) x[j] = ALPHA * x[j] + g[j] * y[j];
        ln_row(x, lg, lb, F.lane);
        st_row_f32(row < ML ? F.out + (size_t)row * DM : XC + (size_t)(row - ML) * DM, F.lane, x);
        modulate_row(h, x, mods_ptr(F, 0, cond, 3), mods_ptr(F, 0, cond, 4), F.lane);
        st_row_bf16(H + (size_t)row * DM, F.lane, h);
    }
}
__device__ __forceinline__ void p9_ln2_even(Frame& F) {
    const bf16* Fd = (const bf16*)(F.ws + WS_Y); bf16* H = (bf16*)(F.ws + WS_H); const float* XC = (const float*)(F.ws + WS_XC);
    const float* lg = F.in[IN_LNG] + 1 * DM; const float* lb = F.in[IN_LNB] + 1 * DM;
    for (int row = F.gw; row < MT; row += F.NGW) {
        const int cond = cond_of_row(row);
        const float* xr = row < ML ? F.out + (size_t)row * DM : XC + (size_t)(row - ML) * DM;
        f32x4 x[4], y[4], g[4], h[4]; ld_row_f32(xr, F.lane, x); ld_row_bf16(Fd + (size_t)row * DM, F.lane, y); ld_row_f32(mods_ptr(F, 0, cond, 5), F.lane, g);
#pragma unroll
        for (int j = 0; j < 4; ++j) x[j] = ALPHA * x[j] + g[j] * y[j];
        ln_row(x, lg, lb, F.lane);
        if (row < ML) st_row_f32(F.out + (size_t)row * DM, F.lane, x);
        modulate_row(h, x, mods_ptr(F, 1, cond, 0), mods_ptr(F, 1, cond, 1), F.lane);
        st_row_bf16(H + (size_t)row * DM, F.lane, h);
    }
}
__device__ __forceinline__ void p15_ln1_odd(Frame& F) {
    const bf16* Y = (const bf16*)(F.ws + WS_Y); unsigned char* H8 = F.ws + WS_H8;
    const float* lg = F.in[IN_LNG] + 2 * DM; const float* lb = F.in[IN_LNB] + 2 * DM;
    const float* wr = F.in[IN_ROUTER];
    unsigned* cnt = (unsigned*)(F.ws + WS_CTL) + CW_CNT; int* TOK = (int*)(F.ws + WS_TOK); int* LIST = (int*)(F.ws + WS_LIST);
    for (int row = F.gw; row < ML; row += F.NGW) {
        const int cond = row >> 11;
        f32x4 x[4], y[4], g[4], h[4]; ld_row_f32(F.out + (size_t)row * DM, F.lane, x); ld_row_bf16(Y + (size_t)row * DM, F.lane, y); ld_row_f32(mods_ptr(F, 1, cond, 2), F.lane, g);
#pragma unroll
        for (int j = 0; j < 4; ++j) x[j] = ALPHA * x[j] + g[j] * y[j];
        ln_row(x, lg, lb, F.lane);
        st_row_f32(F.out + (size_t)row * DM, F.lane, x);
        modulate_row(h, x, mods_ptr(F, 1, cond, 3), mods_ptr(F, 1, cond, 4), F.lane);
#pragma unroll
        for (int j = 0; j < 4; ++j) *(unsigned*)(H8 + (size_t)row * DM + 4 * F.lane + 256 * j) = pk4_fp8(h[j][0] * S_ACT, h[j][1] * S_ACT, h[j][2] * S_ACT, h[j][3] * S_ACT);
        float lg8[8];
#pragma unroll
        for (int e = 0; e < 8; ++e) lg8[e] = 0.f;
#pragma unroll
        for (int j = 0; j < 4; ++j)
#pragma unroll
            for (int q = 0; q < 4; ++q) { const int d = 4 * F.lane + 256 * j + q; const f32x4 w0 = *(const f32x4*)(wr + (size_t)d * 8), w1 = *(const f32x4*)(wr + (size_t)d * 8 + 4); const float hv = h[j][q];
#pragma unroll
                for (int e = 0; e < 4; ++e) { lg8[e] += hv * w0[e]; lg8[4 + e] += hv * w1[e]; } }
#pragma unroll
        for (int e = 0; e < 8; ++e) lg8[e] = wave_sum(lg8[e]);
        if (F.lane == 0) {
            int e0 = 0; float v0 = lg8[0];
#pragma unroll
            for (int e = 1; e < 8; ++e) if (lg8[e] > v0) { v0 = lg8[e]; e0 = e; }
            int e1 = -1; float v1 = -INFINITY;
#pragma unroll
            for (int e = 0; e < 8; ++e) if (e != e0 && lg8[e] > v1) { v1 = lg8[e]; e1 = e; }
            const float p1 = 1.f / (1.f + __expf(v0 - v1)), p0 = 1.f - p1;
            const int pos0 = (int)atomicAdd(cnt + e0, 1u), pos1 = (int)atomicAdd(cnt + e1, 1u);
            LIST[e0 * ML + pos0] = row; LIST[e1 * ML + pos1] = row;
            int* tk = TOK + (size_t)row * 8; tk[0] = e0; tk[1] = pos0; tk[2] = e1; tk[3] = pos1; tk[4] = __builtin_bit_cast(int, p0); tk[5] = __builtin_bit_cast(int, p1);
        }
    }
}
__device__ __forceinline__ void p24_final(Frame& F) {
    const bf16* YS = (const bf16*)(F.ws + WS_YS);
    const float* lg = F.in[IN_LNG] + 3 * DM; const float* lb = F.in[IN_LNB] + 3 * DM;
    const unsigned* cnt = (const unsigned*)(F.ws + WS_CTL) + CW_CNT; const int* TOK = (const int*)(F.ws + WS_TOK);
    int pbase[8]; { int a = 0;
#pragma unroll
        for (int e = 0; e < 8; ++e) { pbase[e] = a; a += ((int)cnt[e] + 255) >> 8; } }
    for (int row = F.gw; row < ML; row += F.NGW) {
        const int cond = row >> 11;
        const int* tk = TOK + (size_t)row * 8; const int e0 = tk[0], pos0 = tk[1], e1 = tk[2], pos1 = tk[3]; const float p0 = __builtin_bit_cast(float, tk[4]), p1 = __builtin_bit_cast(float, tk[5]);
        int pb0 = 0, pb1 = 0;
#pragma unroll
        for (int e = 0; e < 8; ++e) { pb0 = (e == e0) ? pbase[e] : pb0; pb1 = (e == e1) ? pbase[e] : pb1; }
        const size_t s0 = (size_t)pb0 * 256 + pos0, s1 = (size_t)pb1 * 256 + pos1;
        f32x4 x[4], ya[4], yb[4], g[4]; ld_row_f32(F.out + (size_t)row * DM, F.lane, x); ld_row_bf16(YS + s0 * DM, F.lane, ya); ld_row_bf16(YS + s1 * DM, F.lane, yb); ld_row_f32(mods_ptr(F, 1, cond, 5), F.lane, g);
#pragma unroll
        for (int j = 0; j < 4; ++j) x[j] = ALPHA * x[j] + g[j] * (p0 * ya[j] + p1 * yb[j]);
        ln_row(x, lg, lb, F.lane);
        st_row_f32(F.out + (size_t)row * DM, F.lane, x);
    }
}

struct MoeOrder {
    int cum[9]; int cnt[8]; int nM, nN, nwg, G, c; int gather; const int* list; unsigned long long bstep; int ocw;
    __device__ __forceinline__ void init(const unsigned* counts, int nN_, int G_, int c_, int gather_, const int* list_, int ldb, int ocw_) {
        int a = 0;
#pragma unroll
        for (int e = 0; e < 8; ++e) { cnt[e] = __builtin_amdgcn_readfirstlane((int)counts[e]); cum[e] = a; a += (cnt[e] + 255) >> 8; }
        cum[8] = a; nM = a;
        nN = nN_; nwg = nM * nN; G = G_; c = c_; gather = gather_; list = list_; bstep = (unsigned long long)256 * ldb; ocw = ocw_;
    }
    __device__ __forceinline__ bool next(int i, pg8::Unit& u) const {
        const long L = (long)i * G + c; if (L >= nwg) return false;
        int wgid = (int)L; { const int q = nwg / 8, r = nwg % 8, xcd = wgid % 8, off = wgid / 8; wgid = (xcd < r ? xcd * (q + 1) : r * (q + 1) + (xcd - r) * q) + off; }
        const int nig = 8 * nN, gid = wgid / nig, fm = gid * 8, gsz = (nM - fm) < 8 ? (nM - fm) : 8;
        const int pm = fm + ((wgid % nig) % gsz), pn = (wgid % nig) / gsz;
        int e = 0;
#pragma unroll
        for (int k = 1; k < 8; ++k) e += (pm >= cum[k]) ? 1 : 0;
        int ce = 0, cme = 0;
#pragma unroll
        for (int k = 0; k < 8; ++k) { ce = (k == e) ? cnt[k] : ce; cme = (k == e) ? cum[k] : cme; }
        u.pm = pm; u.pn = pn; u.aux = e | ((pm - cme) << 4) | (ce << 12);
        u.bofs = (unsigned long long)(e * nN + pn) * bstep;
        u.orow0 = pm * 256; u.ocol0 = pn * ocw;
        return true;
    }
    __device__ __forceinline__ int arow(const pg8::Unit& u, int r) const {
        if (gather) { const int e = u.aux & 15, lp = (u.aux >> 4) & 255, ce = u.aux >> 12; const int idx = lp * 256 + r; return idx < ce ? list[e * ML + idx] : 0; }
        return u.pm * 256 + r;
    }
};
struct DftCOrder {
    int G, c;
    __device__ __forceinline__ bool next(int i, pg8::Unit& u) const {
        const int L = i * G + c; if (L >= 512) return false;
        u.pm = L & 3; u.pn = L >> 2; u.orow0 = 0; u.ocol0 = 0; u.aux = 0;
        u.bofs = ((unsigned long long)u.pn * 256 * O_IN + (u.pm >> 1) * 256) * 2; return true;
    }
    __device__ __forceinline__ int arow(const pg8::Unit& u, int r) const { return u.pm * 256 + r; }
};
struct DftLOrder {
    int G, vcu;
    __device__ __forceinline__ bool next(int i, pg8::Unit& u) const {
        const int L = i * G + vcu; if (L >= 256) return false;
        const int b = L >> 4; u.pm = (L >> 1) & 7; u.pn = L & 1; u.orow0 = b * SEQ + u.pm * 256; u.ocol0 = u.pn * 256; u.aux = 0;
        u.bofs = ((unsigned long long)(b * 512 + u.pn * 256) * 4096) * 2; return true;
    }
    __device__ __forceinline__ int arow(const pg8::Unit& u, int r) const { return u.pm * 256 + r; }
};

constexpr int NPH = 19;
struct Args { const float* in[26]; float* out; unsigned char* ws; int ph_lo, ph_hi; int use_bar, bar_region; };

__global__ void __launch_bounds__(NWAVES * 64, 2) fwd(Args args) {
    extern __shared__ __attribute__((aligned(16))) unsigned char lds_raw[];
    Frame F;
    F.lds = (LAS unsigned char*)lds_raw;
    F.tid = threadIdx.x; F.lane = F.tid & 63; F.wave = __builtin_amdgcn_readfirstlane(F.tid >> 6);
    F.G = gridDim.x; { const int bx = blockIdx.x; F.vcu = (F.G % 8 == 0) ? (bx % 8) * (F.G / 8) + bx / 8 : bx; }
    F.gw = F.vcu * NWAVES + F.wave; F.NGW = F.G * NWAVES;
#pragma unroll
    for (int i = 0; i < 26; ++i) F.in[i] = args.in[i];
    F.out = args.out; F.ws = args.ws;
    volatile LAS unsigned* MISC = (volatile LAS unsigned*)(F.lds + MISC_OFF);
    for (int u = F.tid; u < (LDS_BYTES - RING_BYTES) / 4; u += NWAVES * 64) ((LAS unsigned*)(F.lds + RING_BYTES))[u] = 0u;
    __syncthreads();
    unsigned* ctl = (unsigned*)(args.ws + WS_CTL);
    XcdBarrier bar; bar.bar = ctl + CW_BAR + args.bar_region * XCD_BAR_WORDS; bar.x = 0; bar.st = nullptr;
    if (args.use_bar) bar = xcd_barrier_post(ctl + CW_BAR + args.bar_region * XCD_BAR_WORDS, MISC + 8);
    const int lo = args.ph_lo, hi = args.ph_hi;
#ifndef PH_MASK
#define PH_MASK 0xffffffffu
#endif
#define IN(k) (((PH_MASK >> (k)) & 1u) && lo <= (k) && (k) < hi)
#define SEAM(k) do { if (IN(k) && IN((k) + 1)) xcd_barrier(bar); } while (0)
    bf16* const H = (bf16*)(F.ws + WS_H); bf16* const CAT = (bf16*)(F.ws + WS_CAT); bf16* const Y = (bf16*)(F.ws + WS_Y); bf16* const BIG = (bf16*)(F.ws + WS_BIG);

    if (IN(0)) { p0_prologue(F); SEAM(0); }
    if (IN(1)) { p1_modulate(F); SEAM(1); }
    if (IN(2)) {
        pg8::Gemm g{H, F.ws + WS_WEIN, DM * 2, DM * 2, DM * 2}; pg8::DenseOrder S; S.init(MT / 256, E_IN / 256, F.G, blockIdx.x, 256, DM * 2);
        EpiPlain E{BIG, E_IN, 1.f}; pg8::gemm_phase<false>(F.lds, g, S, E); SEAM(2); }
    if (IN(3)) { p3_rope_conv(F); SEAM(3); }
    if (IN(4)) { p4_diff_attn(F); SEAM(4); }
    if (IN(5)) {
        pg8::Gemm g{CAT, F.ws + WS_WEO, DM * 2, DM * 2, DM * 2}; pg8::DenseOrder S; S.init(MT / 256, DM / 256, F.G, blockIdx.x, 256, DM * 2);
        EpiPlain E{Y, DM, 1.f}; pg8::gemm_phase<false>(F.lds, g, S, E); SEAM(5); }
    if (IN(6)) { p6_ln1_even(F); SEAM(6); }
    if (IN(7)) {
        pg8::Gemm g{H, F.ws + WS_WGU, DM * 2, DM * 2, DM * 2}; pg8::DenseOrder S; S.init(MT / 256, 2 * FF / 256, F.G, blockIdx.x, 128, DM * 2);
        EpiSwiglu E{BIG, FF}; pg8::gemm_phase<false>(F.lds, g, S, E); SEAM(7); }
    if (IN(8)) {
        pg8::Gemm g{BIG, F.ws + WS_WDN, FF * 2, FF * 2, FF * 2}; pg8::DenseOrder S; S.init(MT / 256, DM / 256, F.G, blockIdx.x, 256, FF * 2);
        EpiPlain E{Y, DM, 1.f}; pg8::gemm_phase<false>(F.lds, g, S, E); SEAM(8); }
    if (IN(9)) { p9_ln2_even(F); SEAM(9); }
    if (IN(10)) {
        pg8::Gemm g{H, F.ws + WS_WOIN, DM * 2, DM * 2, DM * 2}; pg8::DenseOrder S; S.init(MT / 256, O_IN / 256, F.G, blockIdx.x, 256, DM * 2);
        EpiPlain E{BIG, O_IN, 1.f}; pg8::gemm_phase<false>(F.lds, g, S, E); SEAM(10); }
    if (IN(11)) { p11_na_attn(F); SEAM(11); }
    if (IN(12)) {
        pg8::Gemm g{F.ws + WS_DFTC, BIG, 256 * 2, O_IN * 2, 256 * 2}; DftCOrder S{F.G, (int)blockIdx.x};
        EpiDftC E{Y, (const float*)(F.ws + WS_GN)}; pg8::gemm_phase<false>(F.lds, g, S, E); SEAM(12); }
    if (IN(13)) {
        pg8::Gemm g{F.ws + WS_DFTL, Y, 4096 * 2, 4096 * 2, 4096 * 2}; DftLOrder S{F.G, F.vcu};
        EpiPlain E{CAT, DM, 1.f / 512.f}; pg8::gemm_phase<false>(F.lds, g, S, E); SEAM(13); }
    if (IN(14)) {
        pg8::Gemm g{CAT, F.ws + WS_WOO, DM * 2, DM * 2, DM * 2}; pg8::DenseOrder S; S.init(ML / 256, DM / 256, F.G, blockIdx.x, 256, DM * 2);
        EpiPlain E{Y, DM, 1.f}; pg8::gemm_phase<false>(F.lds, g, S, E);
        __syncthreads(); conv_experts(F); SEAM(14); }
    if (IN(15)) { p15_ln1_odd(F); SEAM(15); }
    if (IN(16)) {
        pg8::Gemm g{F.ws + WS_H8, F.ws + WS_EWGU, DM, DM, DM}; MoeOrder S; S.init((const unsigned*)ctl + CW_CNT, 2 * FFE / 256, F.G, blockIdx.x, 1, (const int*)(F.ws + WS_LIST), DM, 128);
        EpiSwiglu8 E{F.ws + WS_BIG, FFE}; pg8::gemm_phase<true>(F.lds, g, S, E); SEAM(16); }
    if (IN(17)) {
        pg8::Gemm g{F.ws + WS_BIG, F.ws + WS_EWDN, FFE, FFE, FFE}; MoeOrder S; S.init((const unsigned*)ctl + CW_CNT, DM / 256, F.G, blockIdx.x, 0, nullptr, FFE, 256);
        EpiPlain E{(bf16*)(F.ws + WS_YS), DM, 1.f / (S_HID * S_WDN)}; pg8::gemm_phase<true>(F.lds, g, S, E); SEAM(17); }
    if (IN(NPH - 1)) { p24_final(F); }
#undef IN
#undef SEAM
}

extern "C" void kernel_launch(void* const* d_in, const int* in_sizes, int n_in, void* d_out, int out_size, void* d_ws, size_t ws_size, hipStream_t stream) {
    static int grid = 0;
    if (grid == 0) {
        if (n_in != 26 || out_size != ML * DM || ws_size < WS_END) { fprintf(stderr, "kernel_launch: unexpected problem (n_in %d out %d ws %zu)\n", n_in, out_size, ws_size); grid = -1; return; }
        int dev = 0, cus = 0;
        if (hipGetDevice(&dev) != hipSuccess || hipDeviceGetAttribute(&cus, hipDeviceAttributeMultiprocessorCount, dev) != hipSuccess) { grid = -1; return; }
        if (hipFuncSetAttribute((const void*)fwd, hipFuncAttributeMaxDynamicSharedMemorySize, LDS_BYTES) != hipSuccess) { grid = -1; return; }
        grid = cus;
    }
    if (grid < 0) return;
    (void)hipMemsetAsync((char*)d_ws + WS_CTL, 0, CTL_ZERO_BYTES, stream);
    Args a{};
    for (int i = 0; i < 26; ++i) a.in[i] = (const float*)d_in[i];
    a.out = (float*)d_out; a.ws = (unsigned char*)d_ws;
#if MK_LAUNCH_PER_PHASE
    a.use_bar = 0;
    for (int ph = 0; ph < NPH; ++ph) { a.ph_lo = ph; a.ph_hi = ph + 1; hipLaunchKernelGGL(fwd, dim3(grid), dim3(NWAVES * 64), LDS_BYTES, stream, a); }
#elif defined(PROBE_REPEAT)
    a.use_bar = 1; a.ph_lo = 0; a.ph_hi = PROBE_REPEAT + 1; a.bar_region = 0;
    hipLaunchKernelGGL(fwd, dim3(grid), dim3(NWAVES * 64), LDS_BYTES, stream, a);
    a.ph_lo = PROBE_REPEAT; a.ph_hi = NPH; a.bar_region = 1;
    hipLaunchKernelGGL(fwd, dim3(grid), dim3(NWAVES * 64), LDS_BYTES, stream, a);
#else
    a.use_bar = 1; a.ph_lo = 0; a.ph_hi = NPH;
    hipLaunchKernelGGL(fwd, dim3(grid), dim3(NWAVES * 64), LDS_BYTES, stream, a);
#endif
}
```

```cpp
#include <hip/hip_runtime.h>
#include <cstdio>
#include <cstdint>

#ifndef FFN_FP8
#define FFN_FP8 3
#endif
#ifndef OIN_I8
#define OIN_I8 1
#endif
#ifndef DFTL_I8
#define DFTL_I8 1
#endif
#ifndef EIN_I8
#define EIN_I8 1
#endif
#ifndef MK_LAUNCH_PER_PHASE
#define MK_LAUNCH_PER_PHASE 0
#endif

#define GAS __attribute__((address_space(1)))
#define LAS __attribute__((address_space(3)))
typedef unsigned short bf16;
typedef short bf16x8 __attribute__((ext_vector_type(8)));
typedef short s16x4 __attribute__((ext_vector_type(4)));
typedef float f32x4 __attribute__((ext_vector_type(4)));
typedef float f32x16 __attribute__((ext_vector_type(16)));
typedef unsigned u32x4 __attribute__((ext_vector_type(4)));
typedef unsigned u32x2 __attribute__((ext_vector_type(2)));

constexpr int NB = 16, SEQ = 2048, DM = 1024, LC = 256, GW = 64;
constexpr int ML = NB * SEQ;
constexpr int MC = NB * LC;
constexpr int MT = ML + MC;
constexpr int E_IN = 3072, FF = 2816, O_IN = 2048, NEXP = 8, FFE = 3584;
constexpr int NCOND = 17;
constexpr float LN_EPS = 1e-5f, RMS_EPS = 1e-5f;
constexpr float ALPHA = 1.41421356237309515f;

constexpr size_t MiB = 1u << 20;
constexpr size_t WS_CTL = 0, CTL_ZERO_BYTES = 2 * MiB;
constexpr size_t WS_MODS = 2 * MiB;
constexpr size_t WS_ROPE = 3 * MiB;
constexpr size_t WS_TOK  = 4 * MiB;
constexpr size_t WS_LIST = 5 * MiB;
constexpr size_t WS_GN   = 6 * MiB;
constexpr size_t WS_MISC = 7 * MiB;
constexpr size_t WS_WEIN = 8 * MiB;
constexpr size_t WS_WEO  = 14 * MiB;
constexpr size_t WS_WGU  = 16 * MiB;
constexpr size_t WS_WDN  = 27 * MiB;
constexpr size_t WS_WOIN = 33 * MiB;
constexpr size_t WS_WOO  = 37 * MiB;
constexpr size_t WS_DFTC = 39 * MiB;
constexpr size_t WS_DFTL = 40 * MiB;
constexpr size_t WS_XC   = 56 * MiB;
constexpr size_t WS_H    = 72 * MiB;
constexpr size_t WS_CAT  = 144 * MiB;
constexpr size_t WS_Y    = 216 * MiB;
constexpr size_t WS_YS   = 144 * MiB;
constexpr size_t WS_BIG  = 288 * MiB;
constexpr size_t WS_H8   = WS_H;
constexpr size_t WS_EWDN = WS_H + 32 * MiB;
constexpr size_t WS_EWGU = WS_BIG + 231 * MiB;
constexpr size_t WS_END  = WS_EWGU + 56 * MiB;
constexpr size_t WS_BT   = WS_END;
static_assert(WS_BT + 2 * MiB <= 589 * MiB, "workspace");
static_assert((size_t)264 * 256 * FFE <= 231 * MiB, "HID2");
static_assert(WS_EWDN + 28 * MiB <= WS_CAT, "EWDN inside the H region");
static_assert(WS_WEIN + 64 * MiB <= WS_H, "layer-1 X1 (bf16) overlays the small weights, the DFT tables and XC");
constexpr float S_ACT = 8.f, S_WGU = 256.f, S_HID = 8.f, S_WDN = 1024.f;
constexpr float S_WI8 = 1024.f;
constexpr float S_PQ = 127.f / 40.f;
constexpr size_t WS_SRS = WS_GN;

constexpr int CW_BAR = 4096;
constexpr int CW_CNT = 64;
constexpr int NWAVES = 8;
constexpr int RING_BYTES = 131072;
constexpr int MISC_OFF = RING_BYTES + 320;
constexpr int RSC_OFF = RING_BYTES + 1024;
constexpr int LDS_BYTES = 147456;

__device__ __forceinline__ unsigned f2bf(float f) { unsigned u = __builtin_bit_cast(unsigned, f); return (u + 0x7fffu + ((u >> 16) & 1u)) >> 16; }
__device__ __forceinline__ unsigned pk2(float lo, float hi) { return f2bf(lo) | (f2bf(hi) << 16); }
__device__ __forceinline__ unsigned cvt_pk_bf16(float lo, float hi) { unsigned r; asm volatile("v_cvt_pk_bf16_f32 %0, %1, %2" : "=v"(r) : "v"(lo), "v"(hi)); return r; }
__device__ __forceinline__ float bf_lo(unsigned w) { return __builtin_bit_cast(float, w << 16); }
__device__ __forceinline__ float bf_hi(unsigned w) { return __builtin_bit_cast(float, w & 0xffff0000u); }
__device__ __forceinline__ float wave_sum(float v) {
#pragma unroll
    for (int o = 1; o < 64; o <<= 1) v += __shfl_xor(v, o);
    return v;
}
__device__ __forceinline__ float silu_f(float g) { return g * __builtin_amdgcn_rcpf(1.f + __builtin_amdgcn_exp2f(g * -1.4426950408889634f)); }
__device__ __forceinline__ float clamp8(float v) { return __builtin_amdgcn_fmed3f(v, -448.f, 448.f); }
__device__ __forceinline__ unsigned pk4_fp8(float a, float b, float c, float d) {
    int p = __builtin_amdgcn_cvt_pk_fp8_f32(clamp8(a), clamp8(b), 0, false);
    p = __builtin_amdgcn_cvt_pk_fp8_f32(clamp8(c), clamp8(d), p, true);
    return (unsigned)p;
}

#define XB_TMO      128
#define XB_XCNT(j)  (256  + 64 * (j))
#define XB_XSUB(j)  (1280 + 64 * (j))
#define XB_XGEN(j)  (2304 + 64 * (j))
#define XB_TOP      3328
#define XB_TOPGEN   3392
#define XCD_BAR_WORDS 3456
#define XB_SPIN_CAP (1u << 18)
__device__ __forceinline__ unsigned xb_ld(unsigned* p)              { return __hip_atomic_load(p, __ATOMIC_RELAXED, __HIP_MEMORY_SCOPE_AGENT); }
__device__ __forceinline__ unsigned xb_add(unsigned* p, unsigned v) { return __hip_atomic_fetch_add(p, v, __ATOMIC_RELAXED, __HIP_MEMORY_SCOPE_AGENT); }
__device__ __forceinline__ unsigned xb_xcc_id() { return (unsigned)__builtin_amdgcn_s_getreg((3 << 11) | 20) & 0xFu; }
#define XB_SPIN(cond, bar) do { unsigned _sp = 0; while (cond) { __builtin_amdgcn_s_sleep(1); \
    if ((++_sp & 255u) == 0u) { if (xb_ld(&(bar)[XB_TMO])) break; if (_sp > XB_SPIN_CAP) { atomicAdd(&(bar)[XB_TMO], 1u); break; } } } } while (0)
struct XcdBarrier { unsigned* bar; unsigned x; volatile LAS unsigned* st; };
__device__ __forceinline__ XcdBarrier xcd_barrier_post(unsigned* bar, volatile LAS unsigned* st) {
    XcdBarrier b; b.bar = bar; b.x = xb_xcc_id(); b.st = st;
    if (threadIdx.x == 0) (void)xb_add(&bar[XB_XCNT(b.x)], 1u);
    return b;
}
__device__ __forceinline__ void xcd_barrier_complete(unsigned* bar, unsigned x, unsigned& nloc, unsigned& nx) {
    const unsigned G = gridDim.x * gridDim.y * gridDim.z;
    unsigned sum, cnt, mine, sp = 0u;
    for (;;) {
        sum = 0u; cnt = 0u; mine = 0u;
#pragma unroll
        for (unsigned j = 0; j < 16; ++j) { const unsigned c = xb_ld(&bar[XB_XCNT(j)]); sum += c; cnt += (c > 0u) ? 1u : 0u; mine = (j == x) ? c : mine; }
        if (sum == G) break;
        __builtin_amdgcn_s_sleep(1);
        if ((++sp & 255u) == 0u) { if (xb_ld(&bar[XB_TMO])) break; if (sp > XB_SPIN_CAP) { atomicAdd(&bar[XB_TMO], 1u); break; } }
    }
    nloc = mine > 0u ? mine : 1u; nx = cnt > 0u ? cnt : 1u;
}
__device__ __forceinline__ void xcd_barrier(const XcdBarrier& b) {
    asm volatile("s_waitcnt vmcnt(0)" ::: "memory");
    __syncthreads();
    if (threadIdx.x == 0) {
        unsigned* bar = b.bar;
        __builtin_amdgcn_s_waitcnt(0);
        unsigned nloc = b.st[0], nx = b.st[1];
        if (nloc == 0u) { xcd_barrier_complete(bar, b.x, nloc, nx); b.st[0] = nloc; b.st[1] = nx; }
        const unsigned old = xb_add(&bar[XB_XSUB(b.x)], 1u);
        const unsigned gen = old / nloc;
        if (old + 1u == (gen + 1u) * nloc) {
            __builtin_amdgcn_fence(__ATOMIC_RELEASE, "agent");
            asm volatile("s_waitcnt vmcnt(0)" ::: "memory");
            const unsigned og = xb_add(&bar[XB_TOP], 1u);
            const unsigned tg = og / nx;
            if (og + 1u == (tg + 1u) * nx) xb_add(&bar[XB_TOPGEN], 1u);
            else XB_SPIN(xb_ld(&bar[XB_TOPGEN]) == tg, bar);
            __builtin_amdgcn_fence(__ATOMIC_ACQUIRE, "agent");
            xb_add(&bar[XB_XGEN(b.x)], 1u);
            asm volatile("s_waitcnt vmcnt(0)" ::: "memory");
        } else {
            XB_SPIN(xb_ld(&bar[XB_XGEN(b.x)]) == gen, bar);
            __builtin_amdgcn_fence(__ATOMIC_ACQUIRE, "agent");
            asm volatile("s_waitcnt vmcnt(0)" ::: "memory");
        }
    }
    __syncthreads();
}

namespace pg8 {
constexpr int BM = 256, BK = 64, HALF = 128, HTB = HALF * BK * 2, STAGE_BYTES = 8 * HTB, NXCD = 8, WGM = 8;
__host__ __device__ __forceinline__ int lds_byte(int r, int c) { const int st = (r >> 4) * 2 + (c >> 5), rr = r & 15, cc = c & 31, ob = rr * 64 + cc * 2; return st * 1024 + (ob ^ (((ob >> 9) & 1) << 5)); }
__host__ __device__ __forceinline__ void stage_rc(int b, int& R, int& C) { const int st = b / 1024, sb = b % 1024, swz = sb ^ (((sb >> 9) & 1) << 5); R = (st >> 1) * 16 + swz / 64; C = (st & 1) * 32 + (swz % 64) / 2; }
__host__ __device__ __forceinline__ int perm32(int rho) { const int n = rho >> 4, i = rho & 15; return 8 * (i >> 2) + 4 * n + (i & 3); }

struct Unit { int pm, pn; int orow0, ocol0; unsigned long long bofs; int aux; int part = 0; };
struct Gemm { const void* A; const void* Bt; int lda, ldb, K; const float* rs = nullptr; float cs = 1.f; };

typedef int i32x8 __attribute__((ext_vector_type(8)));
typedef int i32x4 __attribute__((ext_vector_type(4)));
__device__ __forceinline__ i32x8 cat8(bf16x8 a, bf16x8 b) { const u32x4 x = __builtin_bit_cast(u32x4, a), y = __builtin_bit_cast(u32x4, b); return (i32x8){(int)x.x, (int)x.y, (int)x.z, (int)x.w, (int)y.x, (int)y.y, (int)y.z, (int)y.w}; }
template <int DT, bool SPLIT, class Epi, class Sched>
__device__ __forceinline__ void gemm_phase_(LAS unsigned char* lds, const Gemm g, const Sched& S, const Epi& E) {
    const int tid = threadIdx.x, wid = __builtin_amdgcn_readfirstlane(tid >> 6), lane = tid & 63, wr = wid >> 2, wc = wid & 3, fr = lane & 15, fq = lane >> 4;
    const int nt = g.K / (BK * 2);
    int Rr[2]; unsigned Cb[2], voffB[2];
#pragma unroll
    for (int i = 0; i < 2; ++i) { int R, C; stage_rc(tid * 16 + i * 8192, R, C); const int Rb = (R & ~31) + perm32(R & 31);
        Rr[i] = R; Cb[i] = (unsigned)C * 2u; voffB[i] = (unsigned)(Rb * g.ldb + C * 2); }
    const size_t kstep = (size_t)(BK * 2);
    const size_t hstepB = (size_t)HALF * g.ldb;
    const unsigned lda2 = (unsigned)g.lda;
    const unsigned ldsw = (unsigned)wid * 1024u;
    const int aoff = lds_byte(wr * 64 + fr, fq * 8), boff = lds_byte(wc * 32 + fr, fq * 8);
#define PG8_SA(b, h) (((b) * 2 + (h)) * HTB)
#define PG8_SB(b, h) ((4 + (b) * 2 + (h)) * HTB)
#define PG8_STAGE(bufoff, gbase, voff) do { _Pragma("unroll") for (int _i = 0; _i < 2; ++_i) \
        __builtin_amdgcn_global_load_lds((const unsigned*)((const char*)(gbase) + (voff)[_i]), (LAS unsigned*)(lds + (bufoff) + ldsw + _i * 8192), 16, 0, 0); } while (0)
#define PG8_LD16(p) (*(const LAS i32x4*)(p))
#define PG8_LDA(dst, b, h) do { _Pragma("unroll") for (int m = 0; m < 4; ++m) { const i32x4 x_ = PG8_LD16(lds + PG8_SA(b, h) + aoff + m * 2048), y_ = PG8_LD16(lds + PG8_SA(b, h) + aoff + m * 2048 + 1024); \
        dst[m] = (i32x8){x_.x, x_.y, x_.z, x_.w, y_.x, y_.y, y_.z, y_.w}; } } while (0)
#define PG8_LDB(dst, b, h) do { _Pragma("unroll") for (int n = 0; n < 2; ++n) { const i32x4 x_ = PG8_LD16(lds + PG8_SB(b, h) + boff + n * 2048), y_ = PG8_LD16(lds + PG8_SB(b, h) + boff + n * 2048 + 1024); \
        dst[n] = (i32x8){x_.x, x_.y, x_.z, x_.w, y_.x, y_.y, y_.z, y_.w}; } } while (0)
#define PG8_HALFI(v, k) ((k) == 0 ? (i32x4){v.s0, v.s1, v.s2, v.s3} : (i32x4){v.s4, v.s5, v.s6, v.s7})
#define PG8_HALF(v, k) __builtin_bit_cast(bf16x8, PG8_HALFI(v, k))
#define PG8_MMA(ai, bj, At, Bt) do { __builtin_amdgcn_s_setprio(1); _Pragma("unroll") for (int m = 0; m < 4; ++m) _Pragma("unroll") for (int n = 0; n < 2; ++n) { \
        if constexpr (DT == 1) { asm volatile("v_mfma_scale_f32_16x16x128_f8f6f4 %0, %1, %2, %0, %3, %3 op_sel_hi:[0,0,0]" : "+v"(acc[ai][bj][m][n]) : "v"(Bt[n]), "v"(At[m]), "v"(sc1)); } \
        else if constexpr (DT >= 2) { _Pragma("unroll") for (int k = 0; k < 2; ++k) acc[ai][bj][m][n] = __builtin_bit_cast(f32x4, __builtin_amdgcn_mfma_i32_16x16x64_i8(PG8_HALFI(Bt[n], k), PG8_HALFI(At[m], k), __builtin_bit_cast(i32x4, acc[ai][bj][m][n]), 0, 0, 0)); } \
        else { _Pragma("unroll") for (int k = 0; k < 2; ++k) acc[ai][bj][m][n] = __builtin_amdgcn_mfma_f32_16x16x32_bf16(PG8_HALF(Bt[n], k), PG8_HALF(At[m], k), acc[ai][bj][m][n], 0, 0, 0); } } __builtin_amdgcn_s_setprio(0); } while (0)
#define PG8_WAIT_V(n) asm volatile("s_waitcnt vmcnt(" #n ")" ::: "memory")
#define PG8_WAIT_V8F(first) do { if ((first) && !SPLIT) asm volatile("s_waitcnt vmcnt(%0)" :: "n"(8 + Epi::NVM) : "memory"); else asm volatile("s_waitcnt vmcnt(8)" ::: "memory"); } while (0)
#define PG8_WAIT_L(n) asm volatile("s_waitcnt lgkmcnt(" #n ")" ::: "memory")
#define PG8_BAR __builtin_amdgcn_s_barrier()
#define PG8_SCHED __builtin_amdgcn_sched_barrier(0)
#define PG8_AOFF(dst, u) do { _Pragma("unroll") for (int _h = 0; _h < 2; ++_h) _Pragma("unroll") for (int _i = 0; _i < 2; ++_i) \
        dst[_h][_i] = (unsigned)S.arow(u, _h * HALF + Rr[_i]) * lda2 + Cb[_i]; } while (0)
    Unit cur, nxt; int ui = 0;
    if (!S.next(0, cur)) return;
    f32x4 acc[2][2][4][2];
#pragma unroll
    for (int a = 0; a < 2; ++a)
#pragma unroll
        for (int b = 0; b < 2; ++b)
#pragma unroll
            for (int m = 0; m < 4; ++m)
#pragma unroll
                for (int n = 0; n < 2; ++n) acc[a][b][m][n] = (f32x4){0.f, 0.f, 0.f, 0.f};
    i32x8 At[4], B0[2], B1[2];
    const int sc1 = 0x7f7f7f7f;
    unsigned aoc[2][2], aon[2][2];
    PG8_AOFF(aoc, cur);
    const char* const Ab = (const char*)g.A;
    const char* cB = (const char*)g.Bt + cur.bofs;
    PG8_STAGE(PG8_SB(0, 0), cB, voffB); PG8_STAGE(PG8_SB(0, 1), cB + hstepB, voffB); PG8_STAGE(PG8_SA(0, 0), Ab, aoc[0]); PG8_STAGE(PG8_SA(0, 1), Ab, aoc[1]);
    if (wr == 1) PG8_BAR;
    PG8_WAIT_V(2); PG8_BAR;
    PG8_STAGE(PG8_SB(1, 0), cB + kstep, voffB); PG8_STAGE(PG8_SA(1, 0), Ab + kstep, aoc[0]); PG8_STAGE(PG8_SB(1, 1), cB + hstepB + kstep, voffB);
    PG8_WAIT_V(6); PG8_BAR;
    for (;;) {
        const bool has_next = S.next(ui + 1, nxt);
        int pt_ = 0; if constexpr (SPLIT) pt_ = __builtin_amdgcn_readfirstlane(cur.part);
        const bool uB0 = ((pt_ >> 2) & 3) != 2, uB1 = ((pt_ >> 2) & 3) != 1, uA1 = (pt_ & 3) == 0;
        const char* nB = has_next ? (const char*)g.Bt + nxt.bofs : cB;
        if (has_next) { PG8_AOFF(aon, nxt); } else {
#pragma unroll
            for (int h = 0; h < 2; ++h)
#pragma unroll
                for (int i = 0; i < 2; ++i) aon[h][i] = aoc[h][i]; }
#pragma unroll 1
        for (int t = 0; t < nt; t += 2) {
            const bool last = (t == nt - 2);
            if constexpr (DT == 2 || DT == 3) if (last && wc == 0) {
                const float* sp_;
                if constexpr (DT == 3) sp_ = g.rs + cur.orow0 + wr * 64 + fr; else sp_ = E.scale_ptr(cur, wr, fr);
#define PG8_RSC(i) __builtin_amdgcn_global_load_lds((const unsigned*)sp_, (LAS unsigned*)(lds + RSC_OFF + wr * 2048 + (i) * 256 - (((i) >> 2) * 512 + ((i) & 3) * 64)), 4, ((i) >> 2) * 512 + ((i) & 3) * 64, 0)
                PG8_RSC(0); PG8_RSC(1); PG8_RSC(2); PG8_RSC(3); PG8_RSC(4); PG8_RSC(5); PG8_RSC(6); PG8_RSC(7);
#undef PG8_RSC
            }
            const char* a1 = Ab + (size_t)(t + 1) * kstep;
            const char* a2 = last ? Ab : Ab + (size_t)(t + 2) * kstep; const char* b2 = last ? nB : cB + (size_t)(t + 2) * kstep;
            const char* a3 = a2 + kstep; const char* b3 = b2 + kstep;
            unsigned ao2[2][2]; const unsigned lm_ = last ? 0xffffffffu : 0u;
#pragma unroll
            for (int h = 0; h < 2; ++h)
#pragma unroll
                for (int i = 0; i < 2; ++i) ao2[h][i] = (aon[h][i] & lm_) | (aoc[h][i] & ~lm_);
            const bool fst = (t == 0) && (ui > 0);
#define PG8_IF(c, x) do { if constexpr (SPLIT) { if (c) { x; } } else { x; } } while (0)
            PG8_IF(uB0, PG8_LDB(B0, 0, 0)); PG8_IF(uB1, PG8_LDB(B1, 0, 1)); PG8_SCHED; PG8_LDA(At, 0, 0); PG8_STAGE(PG8_SA(1, 1), a1, aoc[1]);
            PG8_WAIT_V8F(fst); PG8_WAIT_L(0); PG8_BAR; PG8_IF(uB0, PG8_MMA(0, 0, At, B0)); PG8_IF(uB1, PG8_MMA(0, 1, At, B1)); PG8_BAR; PG8_SCHED;
            PG8_IF(uA1, PG8_LDA(At, 0, 1)); PG8_STAGE(PG8_SB(0, 0), b2, voffB); PG8_STAGE(PG8_SB(0, 1), b2 + hstepB, voffB); PG8_STAGE(PG8_SA(0, 0), a2, ao2[0]);
            PG8_WAIT_V8F(fst); PG8_WAIT_L(0); PG8_BAR; PG8_IF(uA1 && uB0, PG8_MMA(1, 0, At, B0)); PG8_IF(uA1 && uB1, PG8_MMA(1, 1, At, B1)); PG8_BAR; PG8_SCHED;
            PG8_IF(uB0, PG8_LDB(B0, 1, 0)); PG8_IF(uB1, PG8_LDB(B1, 1, 1)); PG8_SCHED; PG8_LDA(At, 1, 0); PG8_STAGE(PG8_SA(0, 1), a2, ao2[1]);
            PG8_WAIT_V(8); PG8_WAIT_L(0); PG8_BAR; PG8_IF(uB0, PG8_MMA(0, 0, At, B0)); PG8_IF(uB1, PG8_MMA(0, 1, At, B1)); PG8_BAR; PG8_SCHED;
            PG8_IF(uA1, PG8_LDA(At, 1, 1)); PG8_STAGE(PG8_SB(1, 0), b3, voffB); PG8_STAGE(PG8_SB(1, 1), b3 + hstepB, voffB); PG8_STAGE(PG8_SA(1, 0), a3, ao2[0]);
            PG8_WAIT_V(8); PG8_WAIT_L(0); PG8_BAR; PG8_IF(uA1 && uB0, PG8_MMA(1, 0, At, B0)); PG8_IF(uA1 && uB1, PG8_MMA(1, 1, At, B1)); PG8_BAR; PG8_SCHED;
#undef PG8_IF
        }
        if (wr == 0) PG8_BAR;
        float rsc[8];
        if constexpr (DT == 2 || DT == 3) {
#pragma unroll
            for (int i = 0; i < 8; ++i) rsc[i] = *(const LAS float*)(lds + RSC_OFF + wr * 2048 + i * 256 + lane * 4);
        }
        if constexpr (DT == 1) asm volatile("s_nop 15\n\ts_nop 15" ::: "memory");
        if constexpr (DT == 4) {
#pragma unroll
            for (int a = 0; a < 2; ++a)
#pragma unroll
                for (int b = 0; b < 2; ++b)
#pragma unroll
                    for (int m = 0; m < 4; ++m)
#pragma unroll
                        for (int n = 0; n < 2; ++n)
#pragma unroll
                            for (int j = 0; j < 4; ++j) { const float f_ = acc[a][b][m][n][j]; acc[a][b][m][n][j] = (float)__builtin_bit_cast(int, f_) * g.cs; }
        }
        if constexpr (DT == 3) {
#pragma unroll
            for (int a = 0; a < 2; ++a)
#pragma unroll
                for (int m = 0; m < 4; ++m) { const float sc = rsc[a * 4 + m] * (1.f / S_WI8);
#pragma unroll
                    for (int b = 0; b < 2; ++b)
#pragma unroll
                        for (int n = 0; n < 2; ++n)
#pragma unroll
                            for (int j = 0; j < 4; ++j) { const float f_ = acc[a][b][m][n][j]; acc[a][b][m][n][j] = (float)__builtin_bit_cast(int, f_) * sc; } }
        }
        if constexpr (DT == 2) E(acc, cur, wr, wc, fr, fq, rsc); else E(acc, cur, wr, wc, fr, fq);
        if (!has_next) break;
#pragma unroll
        for (int a = 0; a < 2; ++a)
#pragma unroll
            for (int b = 0; b < 2; ++b)
#pragma unroll
                for (int m = 0; m < 4; ++m)
#pragma unroll
                    for (int n = 0; n < 2; ++n) acc[a][b][m][n] = (f32x4){0.f, 0.f, 0.f, 0.f};
        cur = nxt; cB = nB; ++ui;
#pragma unroll
        for (int h = 0; h < 2; ++h)
#pragma unroll
            for (int i = 0; i < 2; ++i) aoc[h][i] = aon[h][i];
        if (wr == 1) PG8_BAR;
    }
    PG8_WAIT_V(0);
    PG8_BAR;
#undef PG8_SA
#undef PG8_SB
#undef PG8_STAGE
#undef PG8_LDA
#undef PG8_LD16
#undef PG8_HALF
#undef PG8_HALFI
#undef PG8_LDB
#undef PG8_MMA
#undef PG8_WAIT_V
#undef PG8_WAIT_V8F
#undef PG8_WAIT_L
#undef PG8_BAR
#undef PG8_SCHED
#undef PG8_AOFF
}
template <int DT, class Epi, class Sched>
__device__ __forceinline__ void gemm_phase(LAS unsigned char* lds, const Gemm g, const Sched& S, const Epi& E) { gemm_phase_<DT, false>(lds, g, S, E); }

struct DenseOrder {
    int flat = 0; int nM, nN, nwg, G, c; int ocw; unsigned long long bstep;
    __device__ __forceinline__ void init(int nM_, int nN_, int G_, int c_, int ocw_, int ldb) { nM = nM_; nN = nN_; nwg = nM * nN; G = G_; c = c_; ocw = ocw_; bstep = (unsigned long long)BM * ldb; }
    __device__ __forceinline__ bool next(int i, Unit& u) const {
        const long L = (long)i * G + c; if (L >= nwg) return false;
        int wgid = (int)L; { const int q = nwg / NXCD, r = nwg % NXCD, xcd = wgid % NXCD, off = wgid / NXCD; wgid = (xcd < r ? xcd * (q + 1) : r * (q + 1) + (xcd - r) * q) + off; }
        const int nig = WGM * nN, gid = wgid / nig, fm = gid * WGM, gsz = (nM - fm) < WGM ? (nM - fm) : WGM;
        u.pm = fm + ((wgid % nig) % gsz); u.pn = (wgid % nig) / gsz;
        if (flat) { u.pm = 0; u.pn = 0; }
        u.orow0 = u.pm * BM; u.ocol0 = u.pn * ocw; u.bofs = (unsigned long long)u.pn * bstep; u.aux = 0; return true;
    }
    __device__ __forceinline__ int arow(const Unit& u, int r) const { return u.pm * BM + r; }
};
}

__device__ __forceinline__ unsigned pk4_i8(float a, float b, float c, float d) {
    const int ia = (int)__builtin_amdgcn_fmed3f(__builtin_rintf(a), -127.f, 127.f), ib = (int)__builtin_amdgcn_fmed3f(__builtin_rintf(b), -127.f, 127.f);
    const int ic = (int)__builtin_amdgcn_fmed3f(__builtin_rintf(c), -127.f, 127.f), id = (int)__builtin_amdgcn_fmed3f(__builtin_rintf(d), -127.f, 127.f);
    return (unsigned)(ia & 255) | ((unsigned)(ib & 255) << 8) | ((unsigned)(ic & 255) << 16) | ((unsigned)id << 24);
}
constexpr float QK_C2 = 0.125f * 1.4426950408889634f;
struct EpiPlain {
    static constexpr int NVM = 16;
    bf16* O; int ldc; float scale; int skip = 0; int qlo = 0, qhi = 0;
    __device__ __forceinline__ void operator()(const f32x4 (&acc)[2][2][4][2], const pg8::Unit& u, int wr, int wc, int fr, int fq) const {
        const float sc = (u.pn >= qlo && u.pn < qhi) ? scale * QK_C2 : scale;
        const int row0 = u.orow0 + wr * 64 + fr, col0 = u.ocol0 + wc * 32 + 8 * fq;
#pragma unroll
        for (int ai = 0; ai < 2; ++ai)
#pragma unroll
            for (int m = 0; m < 4; ++m) { bf16* rowp = O + (size_t)(row0 + ai * 128 + m * 16) * ldc + col0;
                if (ai == 1 && (u.part & 3)) continue;
#pragma unroll
                for (int bj = 0; bj < 2; ++bj) { const f32x4 v0 = acc[ai][bj][m][0] * sc, v1 = acc[ai][bj][m][1] * sc;
                    if (((u.part >> 2) & 3) == 2 - bj) continue;
                    u32x4 w; w.x = cvt_pk_bf16(v0[0], v0[1]); w.y = cvt_pk_bf16(v0[2], v0[3]); w.z = cvt_pk_bf16(v1[0], v1[1]); w.w = cvt_pk_bf16(v1[2], v1[3]);
                    *(u32x4*)(rowp + bj * 128) = w; } }
    }
};
struct EpiRope {
    static constexpr int NVM = 16;
    bf16* O; int ldc; const float* rope;
    __device__ __forceinline__ void operator()(const f32x4 (&acc)[2][2][4][2], const pg8::Unit& u, int wr, int wc, int fr, int fq) const {
        const int row0 = u.orow0 + wr * 64 + fr, col0 = u.ocol0 + wc * 32 + 8 * fq;
        const bool isq = (u.pn == 6 || u.pn == 7), isqk = (u.pn >= 6 && u.pn <= 9), lat = u.orow0 < ML;
        const float sc = isq ? QK_C2 : 1.f;
        const int i0 = 16 * (wc & 1) + 4 * fq;
        if (isqk) {
            f32x4 csv[8][2];
#pragma unroll
            for (int i = 0; i < 8; ++i) { const int row = row0 + (i >> 2) * 128 + (i & 3) * 16; const float* rp = rope + ((size_t)(lat ? (row & 2047) : 0) * 32 + i0) * 2; csv[i][0] = *(const f32x4*)rp; csv[i][1] = *(const f32x4*)(rp + 4); }
            if (!lat) {
#pragma unroll
                for (int i = 0; i < 8; ++i) { csv[i][0] = (f32x4){1.f, 0.f, 1.f, 0.f}; csv[i][1] = csv[i][0]; } }
#pragma unroll
            for (int ai = 0; ai < 2; ++ai)
#pragma unroll
                for (int m = 0; m < 4; ++m) { const int row = row0 + ai * 128 + m * 16; bf16* rowp = O + (size_t)row * ldc + col0;
                    const f32x4 cs0 = csv[ai * 4 + m][0], cs1 = csv[ai * 4 + m][1];
#pragma unroll
                    for (int bj = 0; bj < 2; ++bj) { const f32x4 v0 = acc[ai][bj][m][0] * sc, v1 = acc[ai][bj][m][1] * sc;
                        u32x4 w;
                        w.x = cvt_pk_bf16(v0[0] * cs0[0] - v0[1] * cs0[1], v0[0] * cs0[1] + v0[1] * cs0[0]); w.y = cvt_pk_bf16(v0[2] * cs0[2] - v0[3] * cs0[3], v0[2] * cs0[3] + v0[3] * cs0[2]);
                        w.z = cvt_pk_bf16(v1[0] * cs1[0] - v1[1] * cs1[1], v1[0] * cs1[1] + v1[1] * cs1[0]); w.w = cvt_pk_bf16(v1[2] * cs1[2] - v1[3] * cs1[3], v1[2] * cs1[3] + v1[3] * cs1[2]);
                        *(u32x4*)(rowp + bj * 128) = w; } }
        } else {
#pragma unroll
            for (int ai = 0; ai < 2; ++ai)
#pragma unroll
                for (int m = 0; m < 4; ++m) { bf16* rowp = O + (size_t)(row0 + ai * 128 + m * 16) * ldc + col0;
#pragma unroll
                    for (int bj = 0; bj < 2; ++bj) { const f32x4 v0 = acc[ai][bj][m][0], v1 = acc[ai][bj][m][1];
                        u32x4 w; w.x = cvt_pk_bf16(v0[0], v0[1]); w.y = cvt_pk_bf16(v0[2], v0[3]); w.z = cvt_pk_bf16(v1[0], v1[1]); w.w = cvt_pk_bf16(v1[2], v1[3]);
                        *(u32x4*)(rowp + bj * 128) = w; } }
        }
    }
};
struct EpiSwiglu {
    static constexpr int NVM = 8;
    bf16* O; int ldc;
    __device__ __forceinline__ void operator()(const f32x4 (&acc)[2][2][4][2], const pg8::Unit& u, int wr, int wc, int fr, int fq) const {
        const int row0 = u.orow0 + wr * 64 + fr, col0 = u.ocol0 + wc * 32 + 8 * fq;
#pragma unroll
        for (int ai = 0; ai < 2; ++ai)
#pragma unroll
            for (int m = 0; m < 4; ++m) { bf16* rowp = O + (size_t)(row0 + ai * 128 + m * 16) * ldc + col0;
                float r[8];
#pragma unroll
                for (int n = 0; n < 2; ++n)
#pragma unroll
                    for (int j = 0; j < 4; ++j) { const float gt = acc[ai][0][m][n][j], up = acc[ai][1][m][n][j]; r[n * 4 + j] = silu_f(gt) * up; }
                u32x4 w; w.x = cvt_pk_bf16(r[0], r[1]); w.y = cvt_pk_bf16(r[2], r[3]); w.z = cvt_pk_bf16(r[4], r[5]); w.w = cvt_pk_bf16(r[6], r[7]);
                *(u32x4*)rowp = w; }
    }
};
struct EpiSwiglu8 {
    static constexpr int NVM = 8;
    unsigned char* O; int ldc; float inv;
    __device__ __forceinline__ void operator()(const f32x4 (&acc)[2][2][4][2], const pg8::Unit& u, int wr, int wc, int fr, int fq) const {
        const int row0 = u.orow0 + wr * 64 + fr, col0 = u.ocol0 + wc * 32 + 8 * fq;
        const float c1 = -inv * 1.4426950408889634f, c2 = inv * inv * S_HID;
#pragma unroll
        for (int ai = 0; ai < 2; ++ai)
#pragma unroll
            for (int m = 0; m < 4; ++m) { unsigned char* rowp = O + (size_t)(row0 + ai * 128 + m * 16) * ldc + col0;
                float r[8];
#pragma unroll
                for (int n = 0; n < 2; ++n)
#pragma unroll
                    for (int j = 0; j < 4; ++j) { const float ag = acc[ai][0][m][n][j], au = acc[ai][1][m][n][j];
                        r[n * 4 + j] = (ag * au) * __builtin_amdgcn_rcpf(1.f + __builtin_amdgcn_exp2f(ag * c1)) * c2; }
                u32x2 w; w.x = pk4_fp8(r[0], r[1], r[2], r[3]); w.y = pk4_fp8(r[4], r[5], r[6], r[7]);
                *(u32x2*)rowp = w; }
    }
};
template <bool MOE>
struct EpiSwigluI8 {
    static constexpr int NVM = 8;
    unsigned char* O; int ldc; const float* srs;
    __device__ __forceinline__ const float* scale_ptr(const pg8::Unit& u, int wr, int fr) const {
        return srs + (MOE ? (size_t)(u.aux & 15) * ML + ((u.aux >> 4) & 255) * 256 : (size_t)u.orow0) + wr * 64 + fr; }
    __device__ __forceinline__ void operator()(const f32x4 (&acc)[2][2][4][2], const pg8::Unit& u, int wr, int wc, int fr, int fq, const float (&rsc)[8]) const {
        const int row0 = u.orow0 + wr * 64 + fr, col0 = u.ocol0 + wc * 32 + 8 * fq;
#pragma unroll
        for (int ai = 0; ai < 2; ++ai)
#pragma unroll
            for (int m = 0; m < 4; ++m) { unsigned char* rowp = O + (size_t)(row0 + ai * 128 + m * 16) * ldc + col0;
                const float inv = rsc[ai * 4 + m] * (1.f / S_WI8);
                const float c1 = -inv * 1.4426950408889634f, c2 = inv * inv * S_HID;
                float r[8];
                typedef float f32x2_ __attribute__((ext_vector_type(2)));
#pragma unroll
                for (int n = 0; n < 2; ++n)
#pragma unroll
                    for (int j = 0; j < 4; j += 2) { const float fg0 = acc[ai][0][m][n][j], fu0 = acc[ai][1][m][n][j], fg1 = acc[ai][0][m][n][j + 1], fu1 = acc[ai][1][m][n][j + 1];
                        const f32x2_ ag = (f32x2_){(float)__builtin_bit_cast(int, fg0), (float)__builtin_bit_cast(int, fg1)}, au = (f32x2_){(float)__builtin_bit_cast(int, fu0), (float)__builtin_bit_cast(int, fu1)};
                        const f32x2_ t = ag * c1; const f32x2_ d = (f32x2_){__builtin_amdgcn_exp2f(t.x), __builtin_amdgcn_exp2f(t.y)} + 1.f;
                        const f32x2_ q = (f32x2_){__builtin_amdgcn_rcpf(d.x), __builtin_amdgcn_rcpf(d.y)};
                        const f32x2_ v = (ag * q) * (au * c2);
                        r[n * 4 + j] = v.x; r[n * 4 + j + 1] = v.y; }
                u32x2 w; w.x = pk4_fp8(r[0], r[1], r[2], r[3]); w.y = pk4_fp8(r[4], r[5], r[6], r[7]);
                *(u32x2*)rowp = w; }
    }
};
struct EpiDftC {
    static constexpr int NVM = 16;
    bf16* PQt; const float* gn;
    __device__ __forceinline__ void operator()(const f32x4 (&acc)[2][2][4][2], const pg8::Unit& u, int wr, int wc, int fr, int fq) const {
        const int gi = u.pm, jrow = wr * 64 + fr;
        const int tok0 = u.pn * 256 + wc * 32 + 8 * fq;
#pragma unroll
        for (int bj = 0; bj < 2; ++bj) {
            const int tk = tok0 + bj * 128; const int b = tk >> 11, l = tk & 2047;
            bf16* base = PQt + ((size_t)(b * 512 + gi * 128 + jrow)) * 4096 + l;
            float mu[8], rs[8];
            { const f32x4* p = (const f32x4*)(gn + ((size_t)gi * ML + tk) * 2);
#pragma unroll
              for (int j = 0; j < 4; ++j) { const f32x4 t = p[j]; mu[2 * j] = t[0]; rs[2 * j] = t[1]; mu[2 * j + 1] = t[2]; rs[2 * j + 1] = t[3]; } }
#pragma unroll
            for (int ai = 0; ai < 2; ++ai) {
#pragma unroll
                for (int m = 0; m < 4; ++m) {
                    const float dc = (ai == 0 && m == 0 && jrow == 0) ? 128.f : 0.f;
                    float r[8];
#pragma unroll
                    for (int n = 0; n < 2; ++n)
#pragma unroll
                        for (int j = 0; j < 4; ++j) r[n * 4 + j] = rs[n * 4 + j] * (acc[ai][bj][m][n][j] - mu[n * 4 + j] * dc);
#if DFTL_I8
                    u32x2 w; w.x = pk4_i8(r[0] * S_PQ, r[1] * S_PQ, r[2] * S_PQ, r[3] * S_PQ); w.y = pk4_i8(r[4] * S_PQ, r[5] * S_PQ, r[6] * S_PQ, r[7] * S_PQ);
                    *(u32x2*)((unsigned char*)PQt + ((size_t)(b * 512 + gi * 128 + jrow + m * 16)) * 4096 + l + ai * 2048) = w; }
#else
                    u32x4 w; w.x = cvt_pk_bf16(r[0], r[1]); w.y = cvt_pk_bf16(r[2], r[3]); w.z = cvt_pk_bf16(r[4], r[5]); w.w = cvt_pk_bf16(r[6], r[7]);
                    *(u32x4*)(base + (size_t)m * 16 * 4096 + ai * 2048) = w; }
#endif
                asm volatile("" ::: "memory"); }
        }
    }
};

struct Frame {
    LAS unsigned char* lds;
    int tid, lane, wave, G, vcu, gw, NGW;
    const float* in[26];
    float* out; unsigned char* ws;
};
#define IN_X 0
#define IN_C 1
#define IN_CTX 2
#define IN_CCTX 3
#define IN_WMOD 4
#define IN_BMOD 5
#define IN_LNG 6
#define IN_LNB 7
#define IN_EWIN 8
#define IN_ECONV 9
#define IN_LQ1 10
#define IN_LK1 11
#define IN_LQ2 12
#define IN_LK2 13
#define IN_SUBG 14
#define IN_EWO 15
#define IN_EGATE 16
#define IN_EUP 17
#define IN_EDOWN 18
#define IN_OWIN 19
#define IN_RPB 20
#define IN_OWO 21
#define IN_ROUTER 22
#define IN_XGATE 23
#define IN_XUP 24
#define IN_XDOWN 25

__device__ __forceinline__ const float* mods_ptr(const Frame& F, int layer, int cond, int which) { return (const float*)(F.ws + WS_MODS) + ((size_t)(layer * NCOND + cond) * 6 + which) * DM; }
__device__ __forceinline__ int cond_of_row(int row) { return row < ML ? (row >> 11) : NCOND - 1; }

__device__ __forceinline__ void conv_item(const float* W, int K, int N, bf16* WT, int mode, LAS float* scr, int item, int lane) {
    const int nblk = N / 32, kb = item / nblk, nb = item % nblk, k0 = 64 * kb, n0 = 32 * nb;
    { float v_[32];
#pragma unroll
      for (int i = 0; i < 32; ++i) v_[i] = W[(size_t)(k0 + 2 * i + (lane >> 5)) * N + n0 + (lane & 31)];
#pragma unroll
      for (int i = 0; i < 32; ++i) scr[(2 * i + (lane >> 5)) * 33 + (lane & 31)] = v_[i]; }
    asm volatile("s_waitcnt lgkmcnt(0)" ::: "memory");
    int d0 = n0, ds = 1;
    if (mode == 1 || mode == 2) d0 = (n0 >> 7) * 256 + (n0 & 127) + (mode == 2 ? 128 : 0);
    if (mode == 3 && n0 >= 1536 && n0 < 2560) { d0 = (n0 & ~63) + ((n0 >> 5) & 1); ds = 2; }
    const int c = lane & 7;
#pragma unroll
    for (int j = 0; j < 4; ++j) { const int n = (lane >> 3) + 8 * j; const LAS float* s = scr + (8 * c) * 33 + n;
        u32x4 o; o.x = pk2(s[0 * 33], s[1 * 33]); o.y = pk2(s[2 * 33], s[3 * 33]); o.z = pk2(s[4 * 33], s[5 * 33]); o.w = pk2(s[6 * 33], s[7 * 33]);
        *(u32x4*)(WT + (size_t)(d0 + n * ds) * K + k0 + 8 * c) = o; }
    asm volatile("s_waitcnt lgkmcnt(0)" ::: "memory");
}
template <bool I8 = false>
__device__ __forceinline__ void conv_item8(const float* W, int K, int N, unsigned char* WT, int mode, float scale, LAS float* scr, int item, int lane) {
    const int nblk = N / 32, kb = item / nblk, nb = item % nblk, k0 = 64 * kb, n0 = 32 * nb;
    { float v_[32];
#pragma unroll
      for (int i = 0; i < 32; ++i) v_[i] = W[(size_t)(k0 + 2 * i + (lane >> 5)) * N + n0 + (lane & 31)];
#pragma unroll
      for (int i = 0; i < 32; ++i) scr[(2 * i + (lane >> 5)) * 33 + (lane & 31)] = v_[i]; }
    asm volatile("s_waitcnt lgkmcnt(0)" ::: "memory");
    int d0 = n0, ds = 1;
    if (mode == 1 || mode == 2) d0 = (n0 >> 7) * 256 + (n0 & 127) + (mode == 2 ? 128 : 0);
    if (mode == 3 && n0 >= 1536 && n0 < 2560) { d0 = (n0 & ~63) + ((n0 >> 5) & 1); ds = 2; }
    const int c = lane & 7;
#pragma unroll
    for (int j = 0; j < 4; ++j) { const int n = (lane >> 3) + 8 * j; const LAS float* s = scr + (8 * c) * 33 + n;
        u32x2 o;
        if (I8) { o.x = pk4_i8(s[0 * 33] * scale, s[1 * 33] * scale, s[2 * 33] * scale, s[3 * 33] * scale); o.y = pk4_i8(s[4 * 33] * scale, s[5 * 33] * scale, s[6 * 33] * scale, s[7 * 33] * scale); }
        else { o.x = pk4_fp8(s[0 * 33] * scale, s[1 * 33] * scale, s[2 * 33] * scale, s[3 * 33] * scale); o.y = pk4_fp8(s[4 * 33] * scale, s[5 * 33] * scale, s[6 * 33] * scale, s[7 * 33] * scale); }
        *(u32x2*)(WT + (size_t)(d0 + n * ds) * K + k0 + 8 * c) = o; }
    asm volatile("s_waitcnt lgkmcnt(0)" ::: "memory");
}

__device__ __forceinline__ void p0_prologue(Frame& F) {
    const int tid = F.tid, lane = F.lane, wave = F.wave;
    if ((int)blockIdx.x < 192) {
        LAS float* S = (LAS float*)F.lds;
        LAS float* red = (LAS float*)(F.lds + 17 * 1024 * 4);
        for (int i = tid; i < NCOND * DM; i += 512) { const int j = i >> 10, k = i & 1023; const float v = (j < 16) ? F.in[IN_C][j * DM + k] : F.in[IN_CCTX][k]; S[i] = silu_f(v); }
        __syncthreads();
        const int item = blockIdx.x, layer = item / 96, n = (item % 96) * 64 + lane;
        const float* W = F.in[IN_WMOD] + (size_t)layer * DM * 6144;
        float acc[NCOND];
#pragma unroll
        for (int j = 0; j < NCOND; ++j) acc[j] = 0.f;
#pragma unroll 1
        for (int k0 = wave * 128; k0 < wave * 128 + 128; k0 += 32) {
            float wv[32];
#pragma unroll
            for (int i = 0; i < 32; ++i) wv[i] = W[(size_t)(k0 + i) * 6144 + n];
#pragma unroll
            for (int i = 0; i < 32; ++i)
#pragma unroll
                for (int j = 0; j < NCOND; ++j) acc[j] += S[j * DM + k0 + i] * wv[i]; }
#pragma unroll
        for (int j = 0; j < NCOND; ++j) red[(wave * NCOND + j) * 64 + lane] = acc[j];
        __syncthreads();
        for (int i = tid; i < NCOND * 64; i += 512) { const int j = i >> 6, l = i & 63; float s = 0.f;
#pragma unroll
            for (int w = 0; w < 8; ++w) s += red[(w * NCOND + j) * 64 + l];
            const int nn = (item % 96) * 64 + l;
            ((float*)(F.ws + WS_MODS))[(size_t)(layer * NCOND + j) * 6144 + nn] = s + F.in[IN_BMOD][layer * 6144 + nn]; }
        __syncthreads();
    }
    {
        LAS float* scr = (LAS float*)(F.lds + wave * 16384);
        constexpr int I_EIN = 16 * 96, I_EO = 16 * 32, I_G = 16 * 88, I_DN = 44 * 32, I_OIN = 16 * 64, I_OO = 16 * 32;
        constexpr int NIT = I_EIN + I_EO + 2 * I_G + I_DN + I_OIN + I_OO;
        for (int it = F.gw; it < NIT; it += F.NGW) {
            int r = it;
#if EIN_I8
            if (r < I_EIN) { conv_item8<true>(F.in[IN_EWIN], DM, E_IN, F.ws + WS_WEIN, 3, S_WI8, scr, r, lane); continue; } r -= I_EIN;
#else
            if (r < I_EIN) { conv_item(F.in[IN_EWIN], DM, E_IN, (bf16*)(F.ws + WS_WEIN), 3, scr, r, lane); continue; } r -= I_EIN;
#endif
            if (r < I_EO) { conv_item(F.in[IN_EWO], DM, DM, (bf16*)(F.ws + WS_WEO), 0, scr, r, lane); continue; } r -= I_EO;
#if FFN_FP8 == 3
            if (r < I_G) { conv_item8<true>(F.in[IN_EGATE], DM, FF, F.ws + WS_WGU, 1, S_WI8, scr, r, lane); continue; } r -= I_G;
            if (r < I_G) { conv_item8<true>(F.in[IN_EUP], DM, FF, F.ws + WS_WGU, 2, S_WI8, scr, r, lane); continue; } r -= I_G;
            if (r < I_DN) { conv_item8(F.in[IN_EDOWN], FF, DM, F.ws + WS_WDN, 0, S_WDN, scr, r, lane); continue; } r -= I_DN;
#elif FFN_FP8 == 1
            if (r < I_G) { conv_item8(F.in[IN_EGATE], DM, FF, F.ws + WS_WGU, 1, S_WGU, scr, r, lane); continue; } r -= I_G;
            if (r < I_G) { conv_item8(F.in[IN_EUP], DM, FF, F.ws + WS_WGU, 2, S_WGU, scr, r, lane); continue; } r -= I_G;
            if (r < I_DN) { conv_item8(F.in[IN_EDOWN], FF, DM, F.ws + WS_WDN, 0, S_WDN, scr, r, lane); continue; } r -= I_DN;
#else
            if (r < I_G) { conv_item(F.in[IN_EGATE], DM, FF, (bf16*)(F.ws + WS_WGU), 1, scr, r, lane); continue; } r -= I_G;
            if (r < I_G) { conv_item(F.in[IN_EUP], DM, FF, (bf16*)(F.ws + WS_WGU), 2, scr, r, lane); continue; } r -= I_G;
#if FFN_FP8 == 2
            if (r < I_DN) { conv_item8(F.in[IN_EDOWN], FF, DM, F.ws + WS_WDN, 0, S_WDN, scr, r, lane); continue; } r -= I_DN;
#else
            if (r < I_DN) { conv_item(F.in[IN_EDOWN], FF, DM, (bf16*)(F.ws + WS_WDN), 0, scr, r, lane); continue; } r -= I_DN;
#endif
#endif
#if OIN_I8
            if (r < I_OIN) { conv_item8<true>(F.in[IN_OWIN], DM, O_IN, F.ws + WS_WOIN, 0, S_WI8, scr, r, lane); continue; } r -= I_OIN;
#else
            if (r < I_OIN) { conv_item(F.in[IN_OWIN], DM, O_IN, (bf16*)(F.ws + WS_WOIN), 0, scr, r, lane); continue; } r -= I_OIN;
#endif
            conv_item(F.in[IN_OWO], DM, DM, (bf16*)(F.ws + WS_WOO), 0, scr, r, lane);
        }
    }
    {
        const size_t gt = (size_t)blockIdx.x * 512 + tid, NT = (size_t)F.G * 512;
        bf16* DL = (bf16*)(F.ws + WS_DFTL);
        for (size_t i = gt; i < (size_t)2048 * 4096 / 8; i += NT) {
            const int k = (int)(i >> 9), l0 = (int)(i & 511) * 8; unsigned w[4]; float vv[8]; (void)w; (void)vv;
#pragma unroll
            for (int j = 0; j < 8; j += 2) { float v[2];
#pragma unroll
                for (int q = 0; q < 2; ++q) { const int lp = l0 + j + q, l = lp & 2047; const int ph = (k * l) & 2047; float s, c; sincospif((float)ph * (1.f / 1024.f), &s, &c); v[q] = (lp < 2048) ? c : -s; }
#if DFTL_I8
                vv[j] = v[0]; vv[j + 1] = v[1]; }
            *(u32x2*)((unsigned char*)DL + (size_t)k * 4096 + l0) = (u32x2){pk4_i8(vv[0] * 127.f, vv[1] * 127.f, vv[2] * 127.f, vv[3] * 127.f), pk4_i8(vv[4] * 127.f, vv[5] * 127.f, vv[6] * 127.f, vv[7] * 127.f)};
#else
                w[j >> 1] = pk2(v[0], v[1]); }
            *(u32x4*)(DL + (size_t)k * 4096 + l0) = (u32x4){w[0], w[1], w[2], w[3]};
#endif
        }
        bf16* DC = (bf16*)(F.ws + WS_DFTC);
        for (size_t i = gt; i < (size_t)4 * 256 * 256; i += NT) {
            const int gi = (int)(i >> 16), mp = (int)(i >> 8) & 255, c2 = (int)i & 255; const int pq = mp >> 7, j = mp & 127, cg = c2 >> 7, c = c2 & 127;
            float v = 0.f;
            if (cg == (gi & 1)) { const int ph = (c * j) & 127; float s, cs; sincospif((float)ph * (1.f / 64.f), &s, &cs); v = pq ? s : cs; }
            DC[i] = (bf16)f2bf(v);
        }
        float* RP = (float*)(F.ws + WS_ROPE);
        for (size_t i = gt; i < (size_t)2048 * 32; i += NT) {
            const int t = (int)(i >> 5), j = (int)i & 31; const float pos = (j < 16) ? (float)(t >> 6) : (float)(t & 63);
            const float invf = powf(10000.f, -(float)(j & 15) / 16.f); const float ang = pos * invf;
            RP[i * 2] = cosf(ang); RP[i * 2 + 1] = sinf(ang);
        }
        bf16* BT = (bf16*)(F.ws + WS_BT);
        for (size_t i = gt; i < (size_t)8 * 15 * 2 * 2 * 64 * 16; i += NT) {
            const int r = (int)i & 15, ln = (int)(i >> 4) & 63, kb = (int)(i >> 10) & 1, qh = (int)(i >> 11) & 1, hd = (int)(i >> 12);
            const int qc = qh * 32 + (ln & 31), kc = kb * 32 + (r & 3) + 8 * (r >> 2) + 4 * (ln >> 5);
            const int cs = min(max(qc - 8, 0), 48);
            BT[i] = (bf16)f2bf((kc >= cs && kc < cs + 16) ? F.in[IN_RPB][hd * 31 + (kc - qc + 15)] * 1.4426950408889634f : -1e30f);
        }
        if (gt == 0) {
            float s1 = 0.f, s2 = 0.f;
            for (int d = 0; d < 64; ++d) { s1 += F.in[IN_LQ1][d] * F.in[IN_LK1][d]; s2 += F.in[IN_LQ2][d] * F.in[IN_LK2][d]; }
            const float lam_init = 0.2f;
            ((float*)(F.ws + WS_MISC))[0] = expf(s1) - expf(s2) + lam_init;
        }
    }
}

__device__ __forceinline__ void conv_experts(Frame& F, LAS float* scr, int k0, int k1) {
    constexpr int I_G = 16 * 112, I_D = 56 * 32;
    constexpr int NIT = NEXP * (2 * I_G + I_D);
    int ln = F.lane; asm volatile("" : "+v"(ln));
    for (int k = k0; k < k1; ++k) {
        const int it = F.gw + k * F.NGW; if (it >= NIT) break;
        const int e = it / (2 * I_G + I_D); int r = it % (2 * I_G + I_D);
        unsigned char* gu = F.ws + WS_EWGU + (size_t)e * 7168 * DM;
        if (r < I_G) { conv_item8<true>(F.in[IN_XGATE] + (size_t)e * DM * FFE, DM, FFE, gu, 1, S_WI8, scr, r, ln); continue; } r -= I_G;
        if (r < I_G) { conv_item8<true>(F.in[IN_XUP] + (size_t)e * DM * FFE, DM, FFE, gu, 2, S_WI8, scr, r, ln); continue; } r -= I_G;
        conv_item8(F.in[IN_XDOWN] + (size_t)e * FFE * DM, FFE, DM, F.ws + WS_EWDN + (size_t)e * DM * FFE, 0, S_WDN, scr, r, ln);
    }
}

__device__ __forceinline__ void ld_row_f32(const float* p, int lane, f32x4 (&v)[4]) {
#pragma unroll
    for (int j = 0; j < 4; ++j) v[j] = *(const f32x4*)(p + 4 * lane + 256 * j);
}
__device__ __forceinline__ void ld_row_bf16(const bf16* p, int lane, f32x4 (&v)[4]) {
#pragma unroll
    for (int j = 0; j < 4; ++j) { const u32x2 w = *(const u32x2*)(p + 4 * lane + 256 * j); v[j] = (f32x4){bf_lo(w.x), bf_hi(w.x), bf_lo(w.y), bf_hi(w.y)}; }
}
__device__ __forceinline__ void st_row_f32(float* p, int lane, const f32x4 (&v)[4]) {
#pragma unroll
    for (int j = 0; j < 4; ++j) *(f32x4*)(p + 4 * lane + 256 * j) = v[j];
}
__device__ __forceinline__ void st_row_bf16(bf16* p, int lane, const f32x4 (&v)[4]) {
#pragma unroll
    for (int j = 0; j < 4; ++j) { u32x2 w; w.x = pk2(v[j][0], v[j][1]); w.y = pk2(v[j][2], v[j][3]); *(u32x2*)(p + 4 * lane + 256 * j) = w; }
}
__device__ __forceinline__ void ln_row(f32x4 (&v)[4], const float* g, const float* b, int lane) {
    float s = 0.f;
#pragma unroll
    for (int j = 0; j < 4; ++j) s += (v[j][0] + v[j][1]) + (v[j][2] + v[j][3]);
    const float mean = wave_sum(s) * (1.f / DM); float s2 = 0.f;
#pragma unroll
    for (int j = 0; j < 4; ++j) { v[j] = v[j] - mean; s2 += (v[j][0] * v[j][0] + v[j][1] * v[j][1]) + (v[j][2] * v[j][2] + v[j][3] * v[j][3]); }
    const float rstd = rsqrtf(wave_sum(s2) * (1.f / DM) + LN_EPS);
    f32x4 gg[4], bb[4]; ld_row_f32(g, lane, gg); ld_row_f32(b, lane, bb);
#pragma unroll
    for (int j = 0; j < 4; ++j) v[j] = v[j] * rstd * gg[j] + bb[j];
}
__device__ __forceinline__ void modulate_row(f32x4 (&h)[4], const f32x4 (&x)[4], const float* sh, const float* sc, int lane) {
    f32x4 a[4], c[4]; ld_row_f32(sh, lane, a); ld_row_f32(sc, lane, c);
#pragma unroll
    for (int j = 0; j < 4; ++j) h[j] = x[j] * (1.f + c[j]) + a[j];
}

__device__ __forceinline__ void p1_modulate(Frame& F) {
    bf16* H = (bf16*)(F.ws + WS_H);
    for (int row = F.gw; row < MT; row += F.NGW) {
        const int cond = cond_of_row(row);
        const float* xr = row < ML ? F.in[IN_X] + (size_t)row * DM : F.in[IN_CTX] + (size_t)(row - ML) * DM;
        f32x4 x[4], h[4]; ld_row_f32(xr, F.lane, x);
        modulate_row(h, x, mods_ptr(F, 0, cond, 0), mods_ptr(F, 0, cond, 1), F.lane);
#if EIN_I8
        float am = 0.f;
#pragma unroll
        for (int j = 0; j < 4; ++j) am = fmaxf(fmaxf(am, fmaxf(fabsf(h[j][0]), fabsf(h[j][1]))), fmaxf(fabsf(h[j][2]), fabsf(h[j][3])));
#pragma unroll
        for (int o = 1; o < 64; o <<= 1) am = fmaxf(am, __shfl_xor(am, o));
        am = fmaxf(am, 1e-20f); const float qs = 127.f / am;
        unsigned char* H8 = F.ws + WS_H8;
#pragma unroll
        for (int j = 0; j < 4; ++j) *(unsigned*)(H8 + (size_t)row * DM + 4 * F.lane + 256 * j) = pk4_i8(h[j][0] * qs, h[j][1] * qs, h[j][2] * qs, h[j][3] * qs);
        if (F.lane == 0) ((float*)(F.ws + WS_SRS))[row] = am * (1.f / 127.f);
#else
        st_row_bf16(H + (size_t)row * DM, F.lane, h);
#endif
    }
}

__device__ __forceinline__ void p3_rope_conv(Frame& F) {
    bf16* P = (bf16*)(F.ws + WS_BIG); bf16* CAT = (bf16*)(F.ws + WS_CAT);
    const float* wc = F.in[IN_ECONV];
    const int lane = F.lane;
    for (int row = F.gw; row < MT; row += F.NGW) {
        bf16* pr = P + (size_t)row * E_IN;
        const int t = row < ML ? (row & 2047) : ((row - ML) & 255); const int Ls = row < ML ? SEQ : LC;
        const int ch = 8 * lane;
        float cv[3][8];
#pragma unroll
        for (int dt = 0; dt < 3; ++dt) {
            const int tt = t + dt - 1;
            if (tt >= 0 && tt < Ls) { const bf16* q = P + (size_t)(row + dt - 1) * E_IN; const u32x4 cg = *(const u32x4*)(q + 512 + ch), vl = *(const u32x4*)(q + 1024 + ch);
#pragma unroll
                for (int j = 0; j < 4; ++j) { cv[dt][2 * j] = bf_lo(cg[j]) * bf_lo(vl[j]); cv[dt][2 * j + 1] = bf_hi(cg[j]) * bf_hi(vl[j]); } }
            else {
#pragma unroll
                for (int j = 0; j < 8; ++j) cv[dt][j] = 0.f; }
        }
        const u32x4 bg = *(const u32x4*)(pr + ch);
        float w0[8], w1[8], w2[8];
#pragma unroll
        for (int j = 0; j < 8; ++j) { w0[j] = wc[ch + j]; w1[j] = wc[512 + ch + j]; w2[j] = wc[1024 + ch + j]; }
        float o[8];
#pragma unroll
        for (int j = 0; j < 8; ++j) { const float bgv = (j & 1) ? bf_hi(bg[j >> 1]) : bf_lo(bg[j >> 1]); o[j] = bgv * (cv[0][j] * w0[j] + cv[1][j] * w1[j] + cv[2][j] * w2[j]); }
        u32x4 w; w.x = pk2(o[0], o[1]); w.y = pk2(o[2], o[3]); w.z = pk2(o[4], o[5]); w.w = pk2(o[6], o[7]);
        *(u32x4*)(CAT + (size_t)row * DM + ch) = w;
    }
}

constexpr float ATT_THR = 8.f;
__device__ __forceinline__ int crow(int r, int hi) { return (r & 3) + 8 * (r >> 2) + 4 * hi; }
__device__ __forceinline__ s16x4 vtr(const LAS unsigned char* p) { return __builtin_bit_cast(s16x4, __builtin_amdgcn_ds_read_tr16_b64_v4i16((LAS s16x4*)p)); }
__device__ __forceinline__ float xhalf_max(float v) { return fmaxf(v, __shfl_xor(v, 32)); }
__device__ __forceinline__ bf16x8 pack8(const f32x16& p, int s) {
    u32x4 w; w.x = cvt_pk_bf16(p[8 * s + 0], p[8 * s + 1]); w.y = cvt_pk_bf16(p[8 * s + 2], p[8 * s + 3]); w.z = cvt_pk_bf16(p[8 * s + 4], p[8 * s + 5]); w.w = cvt_pk_bf16(p[8 * s + 6], p[8 * s + 7]);
    return __builtin_bit_cast(bf16x8, w);
}
__device__ __forceinline__ int koff(int row, int ch) { return row * 128 + ((ch ^ ((row >> 1) & 7)) << 4); }
__device__ __forceinline__ int voff128(int row, int ch) { return 256 * row + 16 * (ch ^ (((row & 3) << 2) | ((row >> 2) & 3))); }
__device__ __forceinline__ int voff64(int row, int ch) { return 128 * row + 16 * (ch ^ (((row >> 1) & 1) << 2)); }

__device__ __forceinline__ void p4_diff_attn(Frame& F) {
    const bf16* P = (const bf16*)(F.ws + WS_BIG); bf16* CAT = (bf16*)(F.ws + WS_CAT);
    const float lam = ((const float*)(F.ws + WS_MISC))[0];
    const float* subg = F.in[IN_SUBG];
    const int tid = F.tid, lane = F.lane, wave = F.wave, r32 = lane & 31, hi = lane >> 5;
    const int comp = wave >> 2, qb = wave & 3;
    LAS unsigned char* lds = F.lds;
    constexpr int STG = 32768;
    constexpr int NU_LAT = NB * 4 * 16, NU = NU_LAT + NB * 4 * 2;
    for (int un = F.vcu; un < NU; un += F.G) {
        int b, h, qrow0, j0, j1;
        if (un < NU_LAT) { b = un >> 6; h = (un >> 4) & 3; qrow0 = b * SEQ + (un & 15) * 128; j0 = 0; j1 = 36; }
        else { const int v = un - NU_LAT; b = v >> 3; h = (v >> 1) & 3; qrow0 = ML + b * LC + (v & 1) * 128; j0 = 0; j1 = 4; }
        bf16x8 qf[4];
        { const bf16* qp = P + (size_t)(qrow0 + qb * 32 + r32) * E_IN + 1536 + h * 128 + comp * 64 + hi * 8;
#pragma unroll
          for (int ds = 0; ds < 4; ++ds) qf[ds] = *(const bf16x8*)(qp + ds * 16); }
        f32x16 o[4];
#pragma unroll
        for (int e = 0; e < 4; ++e) o[e] = (f32x16){};
        float mref = 0.f; f32x16 negm = (f32x16){}; f32x16 lacc = (f32x16){};
        const bf16x8 ones = (bf16x8){0x3F80, 0x3F80, 0x3F80, 0x3F80, 0x3F80, 0x3F80, 0x3F80, 0x3F80};
        u32x4 sk1, sk2, sv[2];
        const int krow = tid >> 3, kch = tid & 7;
#define DA_LOAD(j) do { const int rowb = ((j) < 4) ? (ML + b * LC + (j) * 64) : (b * SEQ + ((j) - 4) * 64); \
            const bf16* kp = P + (size_t)(rowb + krow) * E_IN + 2048 + h * 128 + kch * 8; sk1 = *(const u32x4*)kp; sk2 = *(const u32x4*)(kp + 64); \
            _Pragma("unroll") for (int i = 0; i < 2; ++i) { const int idx = tid + 512 * i; sv[i] = *(const u32x4*)(P + (size_t)(rowb + (idx >> 4)) * E_IN + 2560 + h * 128 + (idx & 15) * 8); } } while (0)
#define DA_STORE(st) do { LAS unsigned char* sb = lds + (st) * STG; *(LAS u32x4*)(sb + koff(krow, kch)) = sk1; *(LAS u32x4*)(sb + 8192 + koff(krow, kch)) = sk2; \
            _Pragma("unroll") for (int i = 0; i < 2; ++i) { const int idx = tid + 512 * i; *(LAS u32x4*)(sb + 16384 + voff128(idx >> 4, idx & 15)) = sv[i]; } } while (0)
        __syncthreads();
        DA_LOAD(j0); DA_STORE(0);
        __syncthreads();
        for (int j = j0; j < j1; ++j) {
            const int st = (j - j0) & 1;
            if (j + 1 < j1) DA_LOAD(j + 1);
            const LAS unsigned char* kb_ = lds + st * STG + comp * 8192;
            const LAS unsigned char* vb_ = lds + st * STG + 16384;
            f32x16 p[2];
#pragma unroll
            for (int kb = 0; kb < 2; ++kb) { p[kb] = negm;
#pragma unroll
                for (int ds = 0; ds < 4; ++ds) { const bf16x8 kf = *(const LAS bf16x8*)(kb_ + koff(kb * 32 + r32, ds * 2 + hi)); p[kb] = __builtin_amdgcn_mfma_f32_32x32x16_bf16(kf, qf[ds], p[kb], 0, 0, 0); } }
            float mx = fmaxf(p[0][0], p[1][0]);
#pragma unroll
            for (int r = 1; r < 16; ++r) mx = fmaxf(fmaxf(mx, p[0][r]), p[1][r]);
            mx = xhalf_max(mx);
            if (__any(mx > ATT_THR)) {
                const float d = fmaxf(mx, 0.f), al = __builtin_amdgcn_exp2f(-d);
                mref += d;
#pragma unroll
                for (int r = 0; r < 16; ++r) { p[0][r] -= d; p[1][r] -= d; negm[r] = -mref; lacc[r] *= al; }
#pragma unroll
                for (int e = 0; e < 4; ++e) o[e] = o[e] * al;
            }
#pragma unroll
            for (int kb = 0; kb < 2; ++kb)
#pragma unroll
                for (int r = 0; r < 16; ++r) p[kb][r] = __builtin_amdgcn_exp2f(p[kb][r]);
#pragma unroll
            for (int kb = 0; kb < 2; ++kb)
#pragma unroll
                for (int s = 0; s < 2; ++s) { const bf16x8 pf = pack8(p[kb], s);
                    lacc = __builtin_amdgcn_mfma_f32_32x32x16_bf16(ones, pf, lacc, 0, 0, 0);
                    const int rb = kb * 32 + 16 * s + 4 * hi + ((lane & 15) >> 2);
#pragma unroll
                    for (int e = 0; e < 4; ++e) { const int c0 = 4 * e + 2 * ((lane >> 4) & 1) + ((lane & 3) >> 1);
                        const s16x4 lo = vtr(vb_ + voff128(rb, c0) + 8 * (lane & 1)), hh = vtr(vb_ + voff128(rb + 8, c0) + 8 * (lane & 1));
                        const bf16x8 vf = (bf16x8){lo[0], lo[1], lo[2], lo[3], hh[0], hh[1], hh[2], hh[3]};
                        o[e] = __builtin_amdgcn_mfma_f32_32x32x16_bf16(vf, pf, o[e], 0, 0, 0); } }
            if (j + 1 < j1) DA_STORE(st ^ 1);
            __syncthreads();
        }
        const float linv = 1.f / lacc[0];
        LAS float* X = (LAS float*)(lds + qb * 16384);
        if (comp == 1) {
#pragma unroll
            for (int e = 0; e < 4; ++e)
#pragma unroll
                for (int r = 0; r < 16; ++r) X[(e * 16 + r) * 64 + lane] = o[e][r] * linv; }
        __syncthreads();
        if (comp == 0) {
            float ss = 0.f;
#pragma unroll
            for (int e = 0; e < 4; ++e)
#pragma unroll
                for (int r = 0; r < 16; ++r) { const float v = o[e][r] * linv - lam * X[(e * 16 + r) * 64 + lane]; o[e][r] = v; ss += v * v; }
            ss += __shfl_xor(ss, 32);
            const float rn = rsqrtf(ss * (1.f / 128.f) + RMS_EPS) * 0.8f;
            bf16* op = CAT + (size_t)(qrow0 + qb * 32 + r32) * DM + 512 + h * 128;
#pragma unroll
            for (int e = 0; e < 4; ++e)
#pragma unroll
                for (int r4 = 0; r4 < 4; ++r4) { const int ec = 32 * e + 8 * r4 + 4 * hi; const f32x4 g = *(const f32x4*)(subg + ec);
                    u32x2 w; w.x = pk2(o[e][4 * r4] * rn * g[0], o[e][4 * r4 + 1] * rn * g[1]); w.y = pk2(o[e][4 * r4 + 2] * rn * g[2], o[e][4 * r4 + 3] * rn * g[3]);
                    *(u32x2*)(op + ec) = w; }
        }
#undef DA_LOAD
#undef DA_STORE
    }
    __syncthreads();
}

__device__ __forceinline__ void p11_na_attn(Frame& F) {
    const bf16* P2 = (const bf16*)(F.ws + WS_BIG); bf16* CAT = (bf16*)(F.ws + WS_CAT);
    const int lane = F.lane, wave = F.wave, r32 = lane & 31, hi = lane >> 5;
    {
        float* GN = (float*)(F.ws + WS_GN);
        for (int row = F.gw; row < ML; row += F.NGW) {
            const u32x4 w = *(const u32x4*)(P2 + (size_t)row * O_IN + 8 * lane);
            float v[8];
#pragma unroll
            for (int j = 0; j < 4; ++j) { v[2 * j] = bf_lo(w[j]); v[2 * j + 1] = bf_hi(w[j]); }
            float s = 0.f;
#pragma unroll
            for (int j = 0; j < 8; ++j) s += v[j];
#pragma unroll
            for (int o = 1; o < 16; o <<= 1) s += __shfl_xor(s, o);
            const float mean = s * (1.f / 128.f); float q = 0.f;
#pragma unroll
            for (int j = 0; j < 8; ++j) { const float d = v[j] - mean; q += d * d; }
#pragma unroll
            for (int o = 1; o < 16; o <<= 1) q += __shfl_xor(q, o);
            if ((lane & 15) == 0) { float* g = GN + ((size_t)(lane >> 4) * ML + row) * 2; g[0] = mean; g[1] = rsqrtf(q * (1.f / 128.f) + LN_EPS); }
        }
    }
    const bf16* BT = (const bf16*)(F.ws + WS_BT);
    __syncthreads();
    LAS unsigned char* vt = F.lds + wave * 8192;
    LAS float* cscr = (LAS float*)(wave < 7 ? F.lds + 65536 + wave * 8448 : F.lds + RSC_OFF + 4096);
    constexpr float NA_THR = 16.f;
    constexpr int NWU = NB * 32 * 8 * 2;
    if (wave >= 4) conv_experts(F, cscr, 0, 1 << 20);
    for (int wu = F.vcu * NWAVES + wave; wu < NWU; wu += F.G * NWAVES) {
        const int qh = wu & 1, h = (wu >> 1) & 7, r = (wu >> 4) & 31, b = wu >> 9;
        const int rs = min(max(r - 4, 0), 24);
        const int qc = qh * 32 + r32;
        const int qrow = b * SEQ + r * 64 + qc;
        bf16x8 qf[4];
        { const bf16* qp = P2 + (size_t)qrow * O_IN + 512 + h * 64 + hi * 8;
#pragma unroll
          for (int ds = 0; ds < 4; ++ds) qf[ds] = *(const bf16x8*)(qp + ds * 16); }
        f32x16 o[2]; o[0] = (f32x16){}; o[1] = (f32x16){};
        float mref = 0.f, lrun = 0.f; bool anyref = false;
        bf16x8 kf[2][4], kn[2][4]; u32x4 vn[8];
#define NA_ROWB(j) (((j) < 8) ? (b * SEQ + (rs + (j)) * 64) : (ML + b * LC + ((j) - 8) * 64))
#define NA_LOADK(dst, j) do { const bf16* kp = P2 + (size_t)(NA_ROWB(j) + r32) * O_IN + 1024 + h * 64 + hi * 8; \
            _Pragma("unroll") for (int kb = 0; kb < 2; ++kb) _Pragma("unroll") for (int ds = 0; ds < 4; ++ds) dst[kb][ds] = *(const bf16x8*)(kp + (size_t)kb * 32 * O_IN + ds * 16); } while (0)
#define NA_LOADV(j) do { const bf16* vp = P2 + (size_t)NA_ROWB(j) * O_IN + 1536 + h * 64; \
            _Pragma("unroll") for (int i = 0; i < 8; ++i) { const int idx = lane + 64 * i; vn[i] = *(const u32x4*)(vp + (size_t)(idx >> 3) * O_IN + (idx & 7) * 8); } } while (0)
#define NA_STOREV() do { _Pragma("unroll") for (int i = 0; i < 8; ++i) { const int idx = lane + 64 * i; *(LAS u32x4*)(vt + voff64(idx >> 3, idx & 7)) = vn[i]; } } while (0)
        u32x4 bt[2][2], btn[2][2];
#define NA_LOADB(dst, j) do { const u32x4* bp_ = (const u32x4*)(BT + ((size_t)(((h * 15 + (rs + (j) - r + 7)) * 2 + qh) * 2) * 64 + lane) * 16); \
            _Pragma("unroll") for (int kb = 0; kb < 2; ++kb) { dst[kb][0] = bp_[kb * 128]; dst[kb][1] = bp_[kb * 128 + 1]; } } while (0)
        NA_LOADK(kf, 0); NA_LOADV(0); NA_LOADB(bt, 0); NA_STOREV();
        for (int j = 0; j < 12; ++j) {
            if (j + 1 < 12) { NA_LOADK(kn, j + 1); NA_LOADV(j + 1); if (j + 1 < 8) NA_LOADB(btn, j + 1); }
            f32x16 p[2];
#pragma unroll
            for (int kb = 0; kb < 2; ++kb) { p[kb] = (f32x16){};
#pragma unroll
                for (int ds = 0; ds < 4; ++ds) p[kb] = __builtin_amdgcn_mfma_f32_32x32x16_bf16(kf[kb][ds], qf[ds], p[kb], 0, 0, 0); }
            if (j < 8) {
#pragma unroll
                for (int kb = 0; kb < 2; ++kb)
#pragma unroll
                    for (int rr = 0; rr < 16; rr += 2) { const unsigned w = bt[kb][rr >> 3][(rr >> 1) & 3]; p[kb][rr] += bf_lo(w); p[kb][rr + 1] += bf_hi(w); } }
            if (anyref) {
#pragma unroll
                for (int rr = 0; rr < 16; ++rr) { p[0][rr] -= mref; p[1][rr] -= mref; } }
            float mx = fmaxf(p[0][0], p[1][0]);
#pragma unroll
            for (int rr = 1; rr < 16; ++rr) mx = fmaxf(fmaxf(mx, p[0][rr]), p[1][rr]);
            mx = xhalf_max(mx);
            if (__any(mx > NA_THR)) {
                const float d = fmaxf(mx, 0.f), al = __builtin_amdgcn_exp2f(-d);
                mref += d; anyref = true; lrun *= al;
#pragma unroll
                for (int rr = 0; rr < 16; ++rr) { p[0][rr] -= d; p[1][rr] -= d; }
                o[0] = o[0] * al; o[1] = o[1] * al;
            }
            float ps = 0.f;
#pragma unroll
            for (int kb = 0; kb < 2; ++kb)
#pragma unroll
                for (int rr = 0; rr < 16; ++rr) { const float e = __builtin_amdgcn_exp2f(p[kb][rr]); p[kb][rr] = e; ps += e; }
            lrun += ps;
#pragma unroll
            for (int kb = 0; kb < 2; ++kb)
#pragma unroll
                for (int s = 0; s < 2; ++s) { const bf16x8 pf = pack8(p[kb], s);
                    const int rb = kb * 32 + 16 * s + 4 * hi + ((lane & 15) >> 2);
#pragma unroll
                    for (int e = 0; e < 2; ++e) { const int c0 = 4 * e + 2 * ((lane >> 4) & 1) + ((lane & 3) >> 1);
                        const s16x4 lo = vtr(vt + voff64(rb, c0) + 8 * (lane & 1)), hh = vtr(vt + voff64(rb + 8, c0) + 8 * (lane & 1));
                        const bf16x8 vf = (bf16x8){lo[0], lo[1], lo[2], lo[3], hh[0], hh[1], hh[2], hh[3]};
                        o[e] = __builtin_amdgcn_mfma_f32_32x32x16_bf16(vf, pf, o[e], 0, 0, 0); } }
            if (j + 1 < 12) {
                NA_STOREV();
#pragma unroll
                for (int kb = 0; kb < 2; ++kb) {
#pragma unroll
                    for (int ds = 0; ds < 4; ++ds) kf[kb][ds] = kn[kb][ds];
                    bt[kb][0] = btn[kb][0]; bt[kb][1] = btn[kb][1]; }
            }
        }
        const float linv = 1.f / (lrun + __shfl_xor(lrun, 32));
        bf16* op = CAT + (size_t)qrow * DM + 512 + h * 64;
#pragma unroll
        for (int e = 0; e < 2; ++e)
#pragma unroll
            for (int r4 = 0; r4 < 4; ++r4) { const int ec = 32 * e + 8 * r4 + 4 * hi;
                u32x2 w; w.x = pk2(o[e][4 * r4] * linv, o[e][4 * r4 + 1] * linv); w.y = pk2(o[e][4 * r4 + 2] * linv, o[e][4 * r4 + 3] * linv);
                *(u32x2*)(op + ec) = w; }
#undef NA_LOADB
#undef NA_ROWB
#undef NA_LOADK
#undef NA_LOADV
#undef NA_STOREV
    }
    if (wave < 4) conv_experts(F, cscr, 0, 1 << 20);
    __syncthreads();
}

template <int MODE>
__device__ __forceinline__ void ln_phase(Frame& F, int rlo, int rhi, int blo) {
    constexpr int LAYER = (MODE >= 15) ? 1 : 0, LNI = (MODE == 6) ? 0 : (MODE == 9) ? 1 : (MODE == 15) ? 2 : 3;
    constexpr int GI = (MODE == 6 || MODE == 15) ? 2 : 5;
    constexpr int HL = (MODE == 9) ? 1 : LAYER, HSH = (MODE == 9) ? 0 : 3, HSC = (MODE == 9) ? 1 : 4;
    const int lane = F.lane;
    const bf16* Y = (const bf16*)(F.ws + WS_Y); const bf16* YS = (const bf16*)(F.ws + WS_YS);
    bf16* H = (bf16*)(F.ws + WS_H); unsigned char* H8 = F.ws + WS_H8; float* XC = (float*)(F.ws + WS_XC);
    const int* TOK = (const int*)(F.ws + WS_TOK);
    LAS float* WR = (LAS float*)F.lds;
    LAS int* REC = (LAS int*)(F.lds + 32768 + F.wave * 2048);
    int rcnt = 0, nrec = 0;
    if (MODE == 15) {
        for (int i = F.tid; i < DM * 8; i += 512) { const int d = i >> 3, e = i & 7; const int l = (d & 255) >> 2, q = d & 3, j = d >> 8; WR[(((j * 4 + q) * 64 + l) << 3) + e] = F.in[IN_ROUTER][i]; }
        __syncthreads();
    }
    int pbase[8];
    if (MODE == 24) { const unsigned* cnt = (const unsigned*)(F.ws + WS_CTL) + CW_CNT; int a = 0;
#pragma unroll
        for (int e = 0; e < 8; ++e) { pbase[e] = a; a += (__builtin_amdgcn_readfirstlane((int)cnt[e]) + 255) >> 8; } }
    const int ngw_ = (F.G - blo) * NWAVES, gw_ = (F.vcu - blo) * NWAVES + F.wave;
    const int rpw = (((rhi - rlo) + ngw_ - 1) / ngw_ + 1) & ~1, run0 = (F.vcu >= blo) ? rlo + gw_ * rpw : rhi, rune = min(rhi, run0 + rpw);
    f32x4 lgv[4], lbv[4], g[4], sh[4], sc[4];
    ld_row_f32(F.in[IN_LNG] + LNI * DM, lane, lgv); ld_row_f32(F.in[IN_LNB] + LNI * DM, lane, lbv);
    bf16* const XB1 = (bf16*)((unsigned char*)F.out + 64 * MiB); bf16* const XB2 = (bf16*)F.out; bf16* const XB3 = (bf16*)(F.ws + WS_WEIN);
#define LN_LOADX(dst, row) do { if (MODE == 6) ld_row_f32((row) < ML ? F.in[IN_X] + (size_t)(row) * DM : F.in[IN_CTX] + (size_t)((row) - ML) * DM, lane, dst); \
        else if (MODE == 9) { if ((row) < ML) ld_row_bf16(XB1 + (size_t)(row) * DM, lane, dst); else ld_row_f32(XC + (size_t)((row) - ML) * DM, lane, dst); } \
        else if (MODE == 15) ld_row_bf16(XB2 + (size_t)(row) * DM, lane, dst); else ld_row_bf16(XB3 + (size_t)(row) * DM, lane, dst); } while (0)
    constexpr int NQ = (MODE == 6 || MODE == 9) ? 3 : 2;
    f32x4 xn[NQ][4]; u32x2 yn[NQ][4], yn2[2][4]; float pn0[2] = {0.f, 0.f}, pn1[2] = {0.f, 0.f};
    int tkn[2][6] = {{0, 0, 0, 0, 0, 0}, {0, 0, 0, 0, 0, 0}};
#define LN_LOADTOK(q, row) do { const int* tk_ = TOK + (size_t)(row) * 8; _Pragma("unroll") for (int q_ = 0; q_ < 6; ++q_) tkn[q][q_] = tk_[q_]; } while (0)
#define LN_LOADROW(q, row) do { LN_LOADX(xn[q], row); \
        if (MODE == 24) { int pb0_ = 0, pb1_ = 0; _Pragma("unroll") for (int e_ = 0; e_ < 8; ++e_) { pb0_ = (e_ == tkn[q][0]) ? pbase[e_] : pb0_; pb1_ = (e_ == tkn[q][2]) ? pbase[e_] : pb1_; } \
            const bf16* ya_ = YS + ((size_t)pb0_ * 256 + tkn[q][1]) * DM; const bf16* yb_ = YS + ((size_t)pb1_ * 256 + tkn[q][3]) * DM; pn0[q] = __builtin_bit_cast(float, tkn[q][4]); pn1[q] = __builtin_bit_cast(float, tkn[q][5]); \
            _Pragma("unroll") for (int j_ = 0; j_ < 4; ++j_) { yn[q][j_] = *(const u32x2*)(ya_ + 4 * lane + 256 * j_); yn2[q][j_] = *(const u32x2*)(yb_ + 4 * lane + 256 * j_); } } \
        else { _Pragma("unroll") for (int j_ = 0; j_ < 4; ++j_) yn[q][j_] = *(const u32x2*)(Y + (size_t)(row) * DM + 4 * lane + 256 * j_); } } while (0)
    for (int row0 = run0; row0 < rune; ) {
    const int cond = (MODE == 6 || MODE == 9) ? cond_of_row(row0) : (row0 >> 11);
    const int rowe = min(rune, row0 < ML ? min(ML, ((row0 >> 11) + 1) << 11) : MT);
    ld_row_f32(mods_ptr(F, LAYER, cond, GI), lane, g);
    if (MODE != 24) { ld_row_f32(mods_ptr(F, HL, cond, HSH), lane, sh); ld_row_f32(mods_ptr(F, HL, cond, HSC), lane, sc); }
#pragma unroll
    for (int q = 0; q < NQ; ++q) if (MODE == 24 && row0 + q < rowe) LN_LOADTOK(q, row0 + q);
#pragma unroll
    for (int q = 0; q < NQ; ++q) if (row0 + q < rowe) { LN_LOADROW(q, row0 + q); if (MODE == 24 && row0 + q + NQ < rowe) LN_LOADTOK(q, row0 + q + NQ); }
    for (int rowp = row0; rowp < rowe; rowp += NQ) {
#pragma unroll
      for (int q = 0; q < NQ; ++q) {
        const int row = rowp + q; if (row >= rowe) break;
        f32x4 x[4];
#pragma unroll
        for (int j = 0; j < 4; ++j) {
            f32x4 yv = (f32x4){bf_lo(yn[q][j].x), bf_hi(yn[q][j].x), bf_lo(yn[q][j].y), bf_hi(yn[q][j].y)};
            if (MODE == 24) { const f32x4 y2 = (f32x4){bf_lo(yn2[q][j].x), bf_hi(yn2[q][j].x), bf_lo(yn2[q][j].y), bf_hi(yn2[q][j].y)}; yv = pn0[q] * yv + pn1[q] * y2; }
            x[j] = ALPHA * xn[q][j] + g[j] * yv; }
        if (row + NQ < rowe) { LN_LOADROW(q, row + NQ); if (MODE == 24 && row + 2 * NQ < rowe) LN_LOADTOK(q, row + 2 * NQ); }
        float s = 0.f;
#pragma unroll
        for (int j = 0; j < 4; ++j) s += (x[j][0] + x[j][1]) + (x[j][2] + x[j][3]);
        const float mean = wave_sum(s) * (1.f / DM); float s2 = 0.f;
#pragma unroll
        for (int j = 0; j < 4; ++j) { x[j] = x[j] - mean; s2 += (x[j][0] * x[j][0] + x[j][1] * x[j][1]) + (x[j][2] * x[j][2] + x[j][3] * x[j][3]); }
        const float rstd = rsqrtf(wave_sum(s2) * (1.f / DM) + LN_EPS);
#pragma unroll
        for (int j = 0; j < 4; ++j) x[j] = x[j] * rstd * lgv[j] + lbv[j];
        if (MODE == 6) { if (row < ML) st_row_bf16(XB1 + (size_t)row * DM, lane, x); else st_row_f32(XC + (size_t)(row - ML) * DM, lane, x); }
        else if (MODE == 9) { if (row < ML) st_row_bf16(XB2 + (size_t)row * DM, lane, x); }
        else if (MODE == 15) st_row_bf16(XB3 + (size_t)row * DM, lane, x);
        else st_row_f32(F.out + (size_t)row * DM, lane, x);
        if (MODE == 24) continue;
        f32x4 h[4];
#pragma unroll
        for (int j = 0; j < 4; ++j) h[j] = x[j] * (1.f + sc[j]) + sh[j];
        float rinv = 1.f;
        if (MODE == 15 || (MODE == 6 && FFN_FP8 == 3) || (MODE == 9 && OIN_I8)) {
            float am = 0.f;
#pragma unroll
            for (int j = 0; j < 4; ++j) am = fmaxf(fmaxf(am, fmaxf(fabsf(h[j][0]), fabsf(h[j][1]))), fmaxf(fabsf(h[j][2]), fabsf(h[j][3])));
#pragma unroll
            for (int o = 1; o < 64; o <<= 1) am = fmaxf(am, __shfl_xor(am, o));
            am = fmaxf(am, 1e-20f); const float qs = 127.f / am; rinv = am * (1.f / 127.f);
#pragma unroll
            for (int j = 0; j < 4; ++j) *(unsigned*)(H8 + (size_t)row * DM + 4 * lane + 256 * j) = pk4_i8(h[j][0] * qs, h[j][1] * qs, h[j][2] * qs, h[j][3] * qs);
            if (MODE != 15 && lane == 0) ((float*)(F.ws + WS_SRS))[row] = rinv;
        } else if (MODE == 6 && FFN_FP8 == 1) {
#pragma unroll
            for (int j = 0; j < 4; ++j) *(unsigned*)(H8 + (size_t)row * DM + 4 * lane + 256 * j) = pk4_fp8(h[j][0] * S_ACT, h[j][1] * S_ACT, h[j][2] * S_ACT, h[j][3] * S_ACT);
        } else st_row_bf16(H + (size_t)row * DM, lane, h);
        if (MODE == 15) {
            asm volatile("" ::: "memory");
            float lg8[8];
#pragma unroll
            for (int e = 0; e < 8; ++e) lg8[e] = 0.f;
#pragma unroll
            for (int j = 0; j < 4; ++j)
#pragma unroll
                for (int q = 0; q < 4; ++q) { const LAS f32x4* wp = (const LAS f32x4*)(WR + (((j * 4 + q) * 64 + lane) << 3)); const f32x4 w0 = wp[0], w1 = wp[1]; const float hv = h[j][q];
#pragma unroll
                    for (int e = 0; e < 4; ++e) { lg8[e] += hv * w0[e]; lg8[4 + e] += hv * w1[e]; } }
#pragma unroll
            for (int e = 0; e < 8; ++e) lg8[e] = wave_sum(lg8[e]);
            int e0 = 0; float v0 = lg8[0];
#pragma unroll
            for (int e = 1; e < 8; ++e) if (lg8[e] > v0) { v0 = lg8[e]; e0 = e; }
            int e1 = -1; float v1 = -INFINITY;
#pragma unroll
            for (int e = 0; e < 8; ++e) if (e != e0 && lg8[e] > v1) { v1 = lg8[e]; e1 = e; }
            const float p1 = 1.f / (1.f + __expf(v0 - v1)), p0 = 1.f - p1;
            const int e0s = __builtin_amdgcn_readfirstlane(e0), e1s = __builtin_amdgcn_readfirstlane(e1);
            const int l0 = __builtin_amdgcn_readlane(rcnt, e0s), l1 = __builtin_amdgcn_readlane(rcnt, e1s);
            rcnt += (lane == e0s ? 1 : 0) + (lane == e1s ? 1 : 0);
            if (lane == 0) { LAS int* rc = REC + nrec * 8; rc[0] = row; rc[1] = e0s | (e1s << 8); rc[2] = l0; rc[3] = l1;
                rc[4] = __builtin_bit_cast(int, p0); rc[5] = __builtin_bit_cast(int, p1); rc[6] = __builtin_bit_cast(int, rinv); }
            ++nrec;
        }
      }
    }
    row0 = rowe; }
#undef LN_LOADX
#undef LN_LOADTOK
#undef LN_LOADROW
    if (MODE == 15) {
        unsigned* cnt = (unsigned*)(F.ws + WS_CTL) + CW_CNT; int* TOKW = (int*)(F.ws + WS_TOK); int* LIST = (int*)(F.ws + WS_LIST); float* SRS = (float*)(F.ws + WS_SRS);
        LAS int* WC = (LAS int*)(F.lds + 32768 + 16384);
        if (lane < 8) WC[F.wave * 8 + lane] = rcnt;
        __syncthreads();
        if (F.wave == 0 && lane < 8) { int tot = 0;
#pragma unroll
            for (int w = 0; w < NWAVES; ++w) tot += WC[w * 8 + lane];
            int b = tot > 0 ? (int)atomicAdd(cnt + lane, (unsigned)tot) : 0;
#pragma unroll
            for (int w = 0; w < NWAVES; ++w) { const int c = WC[w * 8 + lane]; WC[w * 8 + lane] = b; b += c; } }
        __syncthreads();
        const int base = lane < 8 ? WC[F.wave * 8 + lane] : 0;
        const bool act = lane < nrec; const LAS int* rc = REC + lane * 8;
        int row = 0, ee = 0, l0 = 0, l1 = 0, q0 = 0, q1 = 0, ri = 0;
        if (act) { row = rc[0]; ee = rc[1]; l0 = rc[2]; l1 = rc[3]; q0 = rc[4]; q1 = rc[5]; ri = rc[6]; }
        const int e0 = ee & 255, e1 = ee >> 8;
        const int pos0 = __shfl(base, e0) + l0, pos1 = __shfl(base, e1) + l1;
        if (act) { LIST[e0 * ML + pos0] = row; LIST[e1 * ML + pos1] = row;
            SRS[e0 * ML + pos0] = __builtin_bit_cast(float, ri); SRS[e1 * ML + pos1] = __builtin_bit_cast(float, ri);
            int* tk = TOKW + (size_t)row * 8; tk[0] = e0; tk[1] = pos0; tk[2] = e1; tk[3] = pos1; tk[4] = q0; tk[5] = q1; }
    }
    if (MODE == 15) __syncthreads();
}

struct MoeOrder {
    int cum[9]; int cnt[8]; int nM, nN, nwg, G, c; int gather; const int* list; unsigned long long bstep; int ocw; int split = 0;
    __device__ __forceinline__ void init(const unsigned* counts, int nN_, int G_, int c_, int gather_, const int* list_, int ldb, int ocw_) {
        int a = 0;
#pragma unroll
        for (int e = 0; e < 8; ++e) { cnt[e] = __builtin_amdgcn_readfirstlane((int)counts[e]); cum[e] = a; a += (cnt[e] + 255) >> 8; }
        cum[8] = a; nM = a;
        nN = nN_; nwg = nM * nN; G = G_; c = c_; gather = gather_; list = list_; bstep = (unsigned long long)256 * ldb; ocw = ocw_;
    }
    __device__ __forceinline__ bool next(int i, pg8::Unit& u) const {
        const long L = (long)i * G + c; int idx = (int)L, part = 0;
        if (!split) { if (L >= nwg) return false; }
        else { const int nfull = (nwg / G) * G, tail = nwg - nfull, sf = (tail * 4 <= G) ? 4 : (tail * 2 <= G) ? 2 : 1;
            if (L >= nfull) { const int j = (int)L - nfull; if (j >= tail * sf) return false; idx = nfull + j / sf; const int q = j % sf;
                part = (sf == 1) ? 0 : (sf == 2) ? (1 + q) : ((1 + (q & 1)) | ((1 + (q >> 1)) << 2)); } }
        int wgid = idx; { const int q = nwg / 8, r = nwg % 8, xcd = wgid % 8, off = wgid / 8; wgid = (xcd < r ? xcd * (q + 1) : r * (q + 1) + (xcd - r) * q) + off; }
        const int nig = 8 * nN, gid = wgid / nig, fm = gid * 8, gsz = (nM - fm) < 8 ? (nM - fm) : 8;
        const int pm = fm + ((wgid % nig) % gsz), pn = (wgid % nig) / gsz;
        int e = 0;
#pragma unroll
        for (int k = 1; k < 8; ++k) e += (pm >= cum[k]) ? 1 : 0;
        int ce = 0, cme = 0;
#pragma unroll
        for (int k = 0; k < 8; ++k) { ce = (k == e) ? cnt[k] : ce; cme = (k == e) ? cum[k] : cme; }
        u.pm = pm; u.pn = pn; u.aux = e | ((pm - cme) << 4) | (ce << 12);
        u.bofs = (unsigned long long)(e * nN + pn) * bstep;
        u.orow0 = pm * 256 + ((part & 3) == 2 ? 128 : 0); u.ocol0 = pn * ocw; u.part = part;
        return true;
    }
    __device__ __forceinline__ int arow(const pg8::Unit& u, int r) const {
        if (gather) { const int e = u.aux & 15, lp = (u.aux >> 4) & 255, ce = u.aux >> 12; const int idx = lp * 256 + r; return idx < ce ? list[e * ML + idx] : 0; }
        return u.pm * 256 + (((u.part & 3) == 2 ? r + 128 : r) & 255);
    }
};
struct CtxOrder {
    int vcu; unsigned long long bstep;
    __device__ __forceinline__ bool next(int i, pg8::Unit& u) const {
        if (i > 0 || vcu >= 64) return false;
        u.pm = ML / 256 + (vcu >> 2); u.pn = vcu & 3; u.orow0 = u.pm * 256; u.ocol0 = u.pn * 256; u.bofs = (unsigned long long)u.pn * bstep; u.aux = 0; return true;
    }
    __device__ __forceinline__ int arow(const pg8::Unit& u, int r) const { return u.pm * 256 + r; }
};
struct DftCOrder {
    int G, c;
    __device__ __forceinline__ bool next(int i, pg8::Unit& u) const {
        const int L = i * G + c; if (L >= 512) return false;
        u.pm = L & 3; u.pn = L >> 2; u.orow0 = 0; u.ocol0 = 0; u.aux = 0;
        u.bofs = ((unsigned long long)u.pn * 256 * O_IN + (u.pm >> 1) * 256) * 2; return true;
    }
    __device__ __forceinline__ int arow(const pg8::Unit& u, int r) const { return u.pm * 256 + r; }
};
struct DftLOrder {
    int G, vcu;
    __device__ __forceinline__ bool next(int i, pg8::Unit& u) const {
        const int L = i * G + vcu; if (L >= 256) return false;
        const int b = L >> 4; u.pm = (L >> 1) & 7; u.pn = L & 1; u.orow0 = b * SEQ + u.pm * 256; u.ocol0 = u.pn * 256; u.aux = 0;
        u.bofs = ((unsigned long long)(b * 512 + u.pn * 256) * 4096) * (DFTL_I8 ? 1 : 2); return true;
    }
    __device__ __forceinline__ int arow(const pg8::Unit& u, int r) const { return u.pm * 256 + r; }
};

constexpr int NPH = 19;
struct Args { const float* in[26]; float* out; unsigned char* ws; int ph_lo, ph_hi; int use_bar, bar_region; int skip_epi, pad2; };

__global__ void __launch_bounds__(NWAVES * 64, 2) fwd(Args args) {
    extern __shared__ __attribute__((aligned(16))) unsigned char lds_raw[];
    Frame F;
    F.lds = (LAS unsigned char*)lds_raw;
    F.tid = threadIdx.x; F.lane = F.tid & 63; F.wave = __builtin_amdgcn_readfirstlane(F.tid >> 6);
    F.G = gridDim.x; { const int bx = blockIdx.x; F.vcu = (F.G % 8 == 0) ? (bx % 8) * (F.G / 8) + bx / 8 : bx; }
    F.gw = F.vcu * NWAVES + F.wave; F.NGW = F.G * NWAVES;
#pragma unroll
    for (int i = 0; i < 26; ++i) F.in[i] = args.in[i];
    F.out = args.out; F.ws = args.ws;
    volatile LAS unsigned* MISC = (volatile LAS unsigned*)(F.lds + MISC_OFF);
    for (int u = F.tid; u < (LDS_BYTES - RING_BYTES) / 4; u += NWAVES * 64) ((LAS unsigned*)(F.lds + RING_BYTES))[u] = 0u;
    __syncthreads();
    unsigned* ctl = (unsigned*)(args.ws + WS_CTL);
    XcdBarrier bar; bar.bar = ctl + CW_BAR + args.bar_region * XCD_BAR_WORDS; bar.x = 0; bar.st = nullptr;
    if (args.use_bar) bar = xcd_barrier_post(ctl + CW_BAR + args.bar_region * XCD_BAR_WORDS, MISC + 8);
    const int lo = args.ph_lo, hi = args.ph_hi;
#ifdef PROBE_CLOCK
    const long long ck0 = clock64(); const long long wk0 = wall_clock64();
#endif
#ifndef PH_MASK
#define PH_MASK 0xffffffffu
#endif
#define IN(k) (((PH_MASK >> (k)) & 1u) && lo <= (k) && (k) < hi)
#define SEAM(k) do { if (IN(k) && IN((k) + 1)) xcd_barrier(bar); } while (0)
    bf16* const H = (bf16*)(F.ws + WS_H); bf16* const CAT = (bf16*)(F.ws + WS_CAT); bf16* const Y = (bf16*)(F.ws + WS_Y); bf16* const BIG = (bf16*)(F.ws + WS_BIG);

    if (IN(0)) { p0_prologue(F); SEAM(0); }
    if (IN(1)) { p1_modulate(F); SEAM(1); }
    if (IN(2)) {
#if EIN_I8
        pg8::Gemm g{F.ws + WS_H8, F.ws + WS_WEIN, DM, DM, DM, (const float*)(F.ws + WS_SRS)}; pg8::DenseOrder S; S.init(MT / 256, E_IN / 256, F.G, blockIdx.x, 256, DM);
        EpiRope E{BIG, E_IN, (const float*)(F.ws + WS_ROPE)}; pg8::gemm_phase<3>(F.lds, g, S, E); SEAM(2); }
#else
        pg8::Gemm g{H, F.ws + WS_WEIN, DM * 2, DM * 2, DM * 2}; pg8::DenseOrder S; S.init(MT / 256, E_IN / 256, F.G, blockIdx.x, 256, DM * 2);
        EpiRope E{BIG, E_IN, (const float*)(F.ws + WS_ROPE)}; pg8::gemm_phase<false>(F.lds, g, S, E); SEAM(2); }
#endif
    if (IN(3)) { p3_rope_conv(F); SEAM(3); }
    if (IN(4)) { p4_diff_attn(F); SEAM(4); }
    if (IN(5)) {
        pg8::Gemm g{CAT, F.ws + WS_WEO, DM * 2, DM * 2, DM * 2}; pg8::DenseOrder S; S.init(ML / 256, DM / 256, F.G, blockIdx.x, 256, DM * 2);
        EpiPlain E{Y, DM, 1.f}; pg8::gemm_phase<false>(F.lds, g, S, E); SEAM(5); }
    if (IN(6)) {
        if (F.vcu < 64) { pg8::Gemm g{CAT, F.ws + WS_WEO, DM * 2, DM * 2, DM * 2}; CtxOrder S{F.vcu, (unsigned long long)256 * DM * 2};
            EpiPlain E{Y, DM, 1.f}; pg8::gemm_phase<false>(F.lds, g, S, E); }
        ln_phase<6>(F, 0, ML, 64);
        xcd_barrier(bar);
        ln_phase<6>(F, ML, MT, 0); SEAM(6); }
#if FFN_FP8 == 3
    if (IN(7)) {
        pg8::Gemm g{F.ws + WS_H8, F.ws + WS_WGU, DM, DM, DM}; pg8::DenseOrder S; S.init(MT / 256, 2 * FF / 256, F.G, blockIdx.x, 128, DM);
        EpiSwigluI8<false> E{F.ws + WS_BIG, FF, (const float*)(F.ws + WS_SRS)}; pg8::gemm_phase<2>(F.lds, g, S, E); SEAM(7); }
#elif FFN_FP8 == 1
    if (IN(7)) {
        pg8::Gemm g{F.ws + WS_H8, F.ws + WS_WGU, DM, DM, DM}; pg8::DenseOrder S; S.init(MT / 256, 2 * FF / 256, F.G, blockIdx.x, 128, DM);
        EpiSwiglu8 E{F.ws + WS_BIG, FF, 1.f / (S_ACT * S_WGU)}; pg8::gemm_phase<true>(F.lds, g, S, E); SEAM(7); }
#elif FFN_FP8 == 2
    if (IN(7)) {
        pg8::Gemm g{H, F.ws + WS_WGU, DM * 2, DM * 2, DM * 2}; pg8::DenseOrder S; S.init(MT / 256, 2 * FF / 256, F.G, blockIdx.x, 128, DM * 2);
        EpiSwiglu8 E{F.ws + WS_BIG, FF, 1.f}; pg8::gemm_phase<false>(F.lds, g, S, E); SEAM(7); }
#else
    if (IN(7)) {
        pg8::Gemm g{H, F.ws + WS_WGU, DM * 2, DM * 2, DM * 2}; pg8::DenseOrder S; S.init(MT / 256, 2 * FF / 256, F.G, blockIdx.x, 128, DM * 2);
        EpiSwiglu E{BIG, FF}; pg8::gemm_phase<false>(F.lds, g, S, E); SEAM(7); }
#endif
#if FFN_FP8
    if (IN(8)) {
        pg8::Gemm g{F.ws + WS_BIG, F.ws + WS_WDN, FF, FF, FF}; pg8::DenseOrder S; S.init(ML / 256, DM / 256, F.G, blockIdx.x, 256, FF);
        EpiPlain E{Y, DM, 1.f / (S_HID * S_WDN)}; pg8::gemm_phase<true>(F.lds, g, S, E); SEAM(8); }
    if (IN(9)) {
        if (F.vcu < 64) { pg8::Gemm g{F.ws + WS_BIG, F.ws + WS_WDN, FF, FF, FF}; CtxOrder S{F.vcu, (unsigned long long)256 * FF};
            EpiPlain E{Y, DM, 1.f / (S_HID * S_WDN)}; pg8::gemm_phase<true>(F.lds, g, S, E); }
        ln_phase<9>(F, 0, ML, 64);
        xcd_barrier(bar);
        ln_phase<9>(F, ML, MT, 0); SEAM(9); }
#else
    if (IN(8)) {
        pg8::Gemm g{BIG, F.ws + WS_WDN, FF * 2, FF * 2, FF * 2}; pg8::DenseOrder S; S.init(ML / 256, DM / 256, F.G, blockIdx.x, 256, FF * 2);
        EpiPlain E{Y, DM, 1.f}; pg8::gemm_phase<false>(F.lds, g, S, E); SEAM(8); }
    if (IN(9)) {
        if (F.vcu < 64) { pg8::Gemm g{BIG, F.ws + WS_WDN, FF * 2, FF * 2, FF * 2}; CtxOrder S{F.vcu, (unsigned long long)256 * FF * 2};
            EpiPlain E{Y, DM, 1.f}; pg8::gemm_phase<false>(F.lds, g, S, E); }
        ln_phase<9>(F, 0, ML, 64);
        xcd_barrier(bar);
        ln_phase<9>(F, ML, MT, 0); SEAM(9); }
#endif
    if (IN(10)) {
#if OIN_I8
        pg8::Gemm g{F.ws + WS_H8, F.ws + WS_WOIN, DM, DM, DM, (const float*)(F.ws + WS_SRS)}; pg8::DenseOrder S; S.init(MT / 256, O_IN / 256, F.G, blockIdx.x, 256, DM);
        EpiPlain E{BIG, O_IN, 1.f, 0, 2, 4}; pg8::gemm_phase<3>(F.lds, g, S, E); SEAM(10); }
#else
        pg8::Gemm g{H, F.ws + WS_WOIN, DM * 2, DM * 2, DM * 2}; pg8::DenseOrder S; S.init(MT / 256, O_IN / 256, F.G, blockIdx.x, 256, DM * 2);
        EpiPlain E{BIG, O_IN, 1.f, 0, 2, 4}; pg8::gemm_phase<false>(F.lds, g, S, E); SEAM(10); }
#endif
    if (IN(11)) { p11_na_attn(F); SEAM(11); }
    if (IN(12)) {
        pg8::Gemm g{F.ws + WS_DFTC, BIG, 256 * 2, O_IN * 2, 256 * 2}; DftCOrder S{F.G, (int)blockIdx.x};
        EpiDftC E{Y, (const float*)(F.ws + WS_GN)}; pg8::gemm_phase<false>(F.lds, g, S, E); SEAM(12); }
    if (IN(13)) {
#if DFTL_I8
        pg8::Gemm g{F.ws + WS_DFTL, Y, 4096, 4096, 4096, nullptr, 1.f / (127.f * S_PQ)}; DftLOrder S{F.G, F.vcu};
        EpiPlain E{CAT, DM, 1.f / 512.f}; pg8::gemm_phase<4>(F.lds, g, S, E); SEAM(13); }
#else
        pg8::Gemm g{F.ws + WS_DFTL, Y, 4096 * 2, 4096 * 2, 4096 * 2}; DftLOrder S{F.G, F.vcu};
        EpiPlain E{CAT, DM, 1.f / 512.f}; pg8::gemm_phase<false>(F.lds, g, S, E); SEAM(13); }
#endif
    if (IN(14)) {
        pg8::Gemm g{CAT, F.ws + WS_WOO, DM * 2, DM * 2, DM * 2}; pg8::DenseOrder S; S.init(ML / 256, DM / 256, F.G, blockIdx.x, 256, DM * 2);
        EpiPlain E{Y, DM, 1.f}; pg8::gemm_phase<false>(F.lds, g, S, E);
        SEAM(14); }
    if (IN(15)) { ln_phase<15>(F, 0, ML, 0); SEAM(15); }
    if (IN(16)) {
        pg8::Gemm g{F.ws + WS_H8, F.ws + WS_EWGU, DM, DM, DM}; MoeOrder S; S.init((const unsigned*)ctl + CW_CNT, 2 * FFE / 256, F.G, blockIdx.x, 1, (const int*)(F.ws + WS_LIST), DM, 128);
#ifdef PROBE_FLATB
        if (args.skip_epi == 3) S.bstep = 0;
#endif
        EpiSwigluI8<true> E{F.ws + WS_BIG, FFE, (const float*)(F.ws + WS_SRS)}; pg8::gemm_phase<2>(F.lds, g, S, E); SEAM(16); }
    if (IN(17)) {
        pg8::Gemm g{F.ws + WS_BIG, F.ws + WS_EWDN, FFE, FFE, FFE}; MoeOrder S; S.init((const unsigned*)ctl + CW_CNT, DM / 256, F.G, blockIdx.x, 0, nullptr, FFE, 256);
        S.split = 1;
        EpiPlain E{(bf16*)(F.ws + WS_YS), DM, 1.f / (S_HID * S_WDN)}; pg8::gemm_phase_<1, true>(F.lds, g, S, E); SEAM(17); }
    if (IN(NPH - 1)) { ln_phase<24>(F, 0, ML, 0); }
#ifdef PROBE_CLOCK
    {
        xcd_barrier(bar);
        if (blockIdx.x == 0) {
            const long long ck1 = clock64(); const long long wk1 = wall_clock64();
            const float mhz = (float)(ck1 - ck0) / (float)(wk1 - wk0) * 100.f;
            const float cval = sqrtf(10.f * floorf(mhz / 250.f + 0.5f));
            for (size_t i = F.tid; i < (size_t)ML * DM; i += 512) F.out[i] = cval;
        }
    }
#endif
#undef IN
#undef SEAM
}

extern "C" void kernel_launch(void* const* d_in, const int* in_sizes, int n_in, void* d_out, int out_size, void* d_ws, size_t ws_size, hipStream_t stream) {
    static int grid = 0;
    if (grid == 0) {
        if (n_in != 26 || out_size != ML * DM || ws_size < WS_BT + 2 * MiB) { fprintf(stderr, "kernel_launch: unexpected problem (n_in %d out %d ws %zu)\n", n_in, out_size, ws_size); grid = -1; return; }
        int dev = 0, cus = 0;
        if (hipGetDevice(&dev) != hipSuccess || hipDeviceGetAttribute(&cus, hipDeviceAttributeMultiprocessorCount, dev) != hipSuccess) { grid = -1; return; }
        if (hipFuncSetAttribute((const void*)fwd, hipFuncAttributeMaxDynamicSharedMemorySize, LDS_BYTES) != hipSuccess) { grid = -1; return; }
        grid = cus;
    }
    if (grid < 0) return;
    (void)hipMemsetAsync((char*)d_ws + WS_CTL, 0, CTL_ZERO_BYTES, stream);
    Args a{};
    for (int i = 0; i < 26; ++i) a.in[i] = (const float*)d_in[i];
    a.out = (float*)d_out; a.ws = (unsigned char*)d_ws;
#if MK_LAUNCH_PER_PHASE
    a.use_bar = 1;
    for (int ph = 0; ph < NPH; ++ph) { a.ph_lo = ph; a.ph_hi = ph + 1; a.bar_region = ph; hipLaunchKernelGGL(fwd, dim3(grid), dim3(NWAVES * 64), LDS_BYTES, stream, a); }
#elif defined(PROBE_REPEAT)
    a.use_bar = 1; a.ph_lo = 0; a.ph_hi = PROBE_REPEAT; a.bar_region = 0;
    if (PROBE_REPEAT > 0) hipLaunchKernelGGL(fwd, dim3(grid), dim3(NWAVES * 64), LDS_BYTES, stream, a);
    a.ph_lo = PROBE_REPEAT; a.ph_hi = PROBE_REPEAT + 1; a.bar_region = 2;
#ifdef PROBE_SKIP_EPI
    a.skip_epi = 1;
#endif
#ifdef PROBE_FLAT
    a.skip_epi = 2;
#endif
#ifdef PROBE_FLATB
    a.skip_epi = 3;
#endif
    hipLaunchKernelGGL(fwd, dim3(grid), dim3(NWAVES * 64), LDS_BYTES, stream, a);
    a.skip_epi = 0;
    a.ph_lo = PROBE_REPEAT; a.ph_hi = NPH; a.bar_region = 1;
    hipLaunchKernelGGL(fwd, dim3(grid), dim3(NWAVES * 64), LDS_BYTES, stream, a);
#else
    a.use_bar = 1; a.ph_lo = 0; a.ph_hi = NPH;
    hipLaunchKernelGGL(fwd, dim3(grid), dim3(NWAVES * 64), LDS_BYTES, stream, a);
#endif
}
```

```cpp
#include <hip/hip_runtime.h>
#include <cstdio>
#include <cstdint>

#ifndef FFN_FP8
#define FFN_FP8 3
#endif
#ifndef OIN_I8
#define OIN_I8 1
#endif
#ifndef DFTL_I8
#define DFTL_I8 1
#endif
#ifndef EIN_I8
#define EIN_I8 1
#endif
#ifndef MK_LAUNCH_PER_PHASE
#define MK_LAUNCH_PER_PHASE 0
#endif

#define GAS __attribute__((address_space(1)))
#define LAS __attribute__((address_space(3)))
typedef unsigned short bf16;
typedef short bf16x8 __attribute__((ext_vector_type(8)));
typedef short s16x4 __attribute__((ext_vector_type(4)));
typedef float f32x4 __attribute__((ext_vector_type(4)));
typedef float f32x16 __attribute__((ext_vector_type(16)));
typedef unsigned u32x4 __attribute__((ext_vector_type(4)));
typedef unsigned u32x2 __attribute__((ext_vector_type(2)));

constexpr int NB = 16, SEQ = 2048, DM = 1024, LC = 256, GW = 64;
constexpr int ML = NB * SEQ;
constexpr int MC = NB * LC;
constexpr int MT = ML + MC;
constexpr int E_IN = 3072, FF = 2816, O_IN = 2048, NEXP = 8, FFE = 3584;
constexpr int NCOND = 17;
constexpr float LN_EPS = 1e-5f, RMS_EPS = 1e-5f;
constexpr float ALPHA = 1.41421356237309515f;

constexpr size_t MiB = 1u << 20;
constexpr size_t WS_CTL = 0, CTL_ZERO_BYTES = 2 * MiB;
constexpr size_t WS_MODS = 2 * MiB;
constexpr size_t WS_ROPE = 3 * MiB;
constexpr size_t WS_TOK  = 4 * MiB;
constexpr size_t WS_LIST = 5 * MiB;
constexpr size_t WS_GN   = 6 * MiB;
constexpr size_t WS_MISC = 7 * MiB;
constexpr size_t WS_WEIN = 8 * MiB;
constexpr size_t WS_WEO  = 14 * MiB;
constexpr size_t WS_WGU  = 16 * MiB;
constexpr size_t WS_WDN  = 27 * MiB;
constexpr size_t WS_WOIN = 33 * MiB;
constexpr size_t WS_WOO  = 37 * MiB;
constexpr size_t WS_DFTC = 39 * MiB;
constexpr size_t WS_DFTL = 40 * MiB;
constexpr size_t WS_XC   = 56 * MiB;
constexpr size_t WS_H    = 72 * MiB;
constexpr size_t WS_CAT  = 144 * MiB;
constexpr size_t WS_Y    = 216 * MiB;
constexpr size_t WS_YS   = 144 * MiB;
constexpr size_t WS_BIG  = 288 * MiB;
constexpr size_t WS_H8   = WS_H;
constexpr size_t WS_EWDN = WS_H + 32 * MiB;
constexpr size_t WS_EWGU = WS_BIG + 231 * MiB;
constexpr size_t WS_END  = WS_EWGU + 56 * MiB;
constexpr size_t WS_BT   = WS_END;
static_assert(WS_BT + 2 * MiB <= 589 * MiB, "workspace");
static_assert((size_t)264 * 256 * FFE <= 231 * MiB, "HID2");
static_assert(WS_EWDN + 28 * MiB <= WS_CAT, "EWDN inside the H region");
static_assert(WS_WEIN + 64 * MiB <= WS_H, "layer-1 X1 (bf16) overlays the small weights, the DFT tables and XC");
constexpr float S_ACT = 8.f, S_WGU = 256.f, S_HID = 8.f, S_WDN = 1024.f;
constexpr float S_WI8 = 1024.f;
constexpr float S_PQ = 127.f / 40.f;
constexpr size_t WS_SRS = WS_GN;

constexpr int CW_BAR = 4096;
constexpr int CW_CNT = 64;
constexpr int NWAVES = 8;
constexpr int RING_BYTES = 131072;
constexpr int MISC_OFF = RING_BYTES + 320;
constexpr int RSC_OFF = RING_BYTES + 1024;
constexpr int LDS_BYTES = 147456;

__device__ __forceinline__ unsigned f2bf(float f) { unsigned u = __builtin_bit_cast(unsigned, f); return (u + 0x7fffu + ((u >> 16) & 1u)) >> 16; }
__device__ __forceinline__ unsigned pk2(float lo, float hi) { return f2bf(lo) | (f2bf(hi) << 16); }
__device__ __forceinline__ unsigned cvt_pk_bf16(float lo, float hi) { unsigned r; asm volatile("v_cvt_pk_bf16_f32 %0, %1, %2" : "=v"(r) : "v"(lo), "v"(hi)); return r; }
__device__ __forceinline__ float bf_lo(unsigned w) { return __builtin_bit_cast(float, w << 16); }
__device__ __forceinline__ float bf_hi(unsigned w) { return __builtin_bit_cast(float, w & 0xffff0000u); }
__device__ __forceinline__ float wave_sum(float v) {
#pragma unroll
    for (int o = 1; o < 64; o <<= 1) v += __shfl_xor(v, o);
    return v;
}
__device__ __forceinline__ float silu_f(float g) { return g * __builtin_amdgcn_rcpf(1.f + __builtin_amdgcn_exp2f(g * -1.4426950408889634f)); }
__device__ __forceinline__ float clamp8(float v) { return __builtin_amdgcn_fmed3f(v, -448.f, 448.f); }
__device__ __forceinline__ unsigned pk4_fp8(float a, float b, float c, float d) {
    int p = __builtin_amdgcn_cvt_pk_fp8_f32(clamp8(a), clamp8(b), 0, false);
    p = __builtin_amdgcn_cvt_pk_fp8_f32(clamp8(c), clamp8(d), p, true);
    return (unsigned)p;
}

#define XB_TMO      128
#define XB_XCNT(j)  (256  + 64 * (j))
#define XB_XSUB(j)  (1280 + 64 * (j))
#define XB_XGEN(j)  (2304 + 64 * (j))
#define XB_TOP      3328
#define XB_TOPGEN   3392
#define XCD_BAR_WORDS 3456
#define XB_SPIN_CAP (1u << 18)
__device__ __forceinline__ unsigned xb_ld(unsigned* p)              { return __hip_atomic_load(p, __ATOMIC_RELAXED, __HIP_MEMORY_SCOPE_AGENT); }
__device__ __forceinline__ unsigned xb_add(unsigned* p, unsigned v) { return __hip_atomic_fetch_add(p, v, __ATOMIC_RELAXED, __HIP_MEMORY_SCOPE_AGENT); }
__device__ __forceinline__ unsigned xb_xcc_id() { return (unsigned)__builtin_amdgcn_s_getreg((3 << 11) | 20) & 0xFu; }
#define XB_SPIN(cond, bar) do { unsigned _sp = 0; while (cond) { __builtin_amdgcn_s_sleep(1); \
    if ((++_sp & 255u) == 0u) { if (xb_ld(&(bar)[XB_TMO])) break; if (_sp > XB_SPIN_CAP) { atomicAdd(&(bar)[XB_TMO], 1u); break; } } } } while (0)
struct XcdBarrier { unsigned* bar; unsigned x; volatile LAS unsigned* st; };
__device__ __forceinline__ XcdBarrier xcd_barrier_post(unsigned* bar, volatile LAS unsigned* st) {
    XcdBarrier b; b.bar = bar; b.x = xb_xcc_id(); b.st = st;
    if (threadIdx.x == 0) (void)xb_add(&bar[XB_XCNT(b.x)], 1u);
    return b;
}
__device__ __forceinline__ void xcd_barrier_complete(unsigned* bar, unsigned x, unsigned& nloc, unsigned& nx) {
    const unsigned G = gridDim.x * gridDim.y * gridDim.z;
    unsigned sum, cnt, mine, sp = 0u;
    for (;;) {
        sum = 0u; cnt = 0u; mine = 0u;
#pragma unroll
        for (unsigned j = 0; j < 16; ++j) { const unsigned c = xb_ld(&bar[XB_XCNT(j)]); sum += c; cnt += (c > 0u) ? 1u : 0u; mine = (j == x) ? c : mine; }
        if (sum == G) break;
        __builtin_amdgcn_s_sleep(1);
        if ((++sp & 255u) == 0u) { if (xb_ld(&bar[XB_TMO])) break; if (sp > XB_SPIN_CAP) { atomicAdd(&bar[XB_TMO], 1u); break; } }
    }
    nloc = mine > 0u ? mine : 1u; nx = cnt > 0u ? cnt : 1u;
}
__device__ __forceinline__ void xcd_barrier(const XcdBarrier& b) {
    asm volatile("s_waitcnt vmcnt(0)" ::: "memory");
    __syncthreads();
    if (threadIdx.x == 0) {
        unsigned* bar = b.bar;
        __builtin_amdgcn_s_waitcnt(0);
        unsigned nloc = b.st[0], nx = b.st[1];
        if (nloc == 0u) { xcd_barrier_complete(bar, b.x, nloc, nx); b.st[0] = nloc; b.st[1] = nx; }
        const unsigned old = xb_add(&bar[XB_XSUB(b.x)], 1u);
        const unsigned gen = old / nloc;
        if (old + 1u == (gen + 1u) * nloc) {
            __builtin_amdgcn_fence(__ATOMIC_RELEASE, "agent");
            asm volatile("s_waitcnt vmcnt(0)" ::: "memory");
            const unsigned og = xb_add(&bar[XB_TOP], 1u);
            const unsigned tg = og / nx;
            if (og + 1u == (tg + 1u) * nx) xb_add(&bar[XB_TOPGEN], 1u);
            else XB_SPIN(xb_ld(&bar[XB_TOPGEN]) == tg, bar);
            __builtin_amdgcn_fence(__ATOMIC_ACQUIRE, "agent");
            xb_add(&bar[XB_XGEN(b.x)], 1u);
            asm volatile("s_waitcnt vmcnt(0)" ::: "memory");
        } else {
            XB_SPIN(xb_ld(&bar[XB_XGEN(b.x)]) == gen, bar);
            __builtin_amdgcn_fence(__ATOMIC_ACQUIRE, "agent");
            asm volatile("s_waitcnt vmcnt(0)" ::: "memory");
        }
    }
    __syncthreads();
}

namespace pg8 {
constexpr int BM = 256, BK = 64, HALF = 128, HTB = HALF * BK * 2, STAGE_BYTES = 8 * HTB, NXCD = 8, WGM = 8;
__host__ __device__ __forceinline__ int lds_byte(int r, int c) { const int st = (r >> 4) * 2 + (c >> 5), rr = r & 15, cc = c & 31, ob = rr * 64 + cc * 2; return st * 1024 + (ob ^ (((ob >> 9) & 1) << 5)); }
__host__ __device__ __forceinline__ void stage_rc(int b, int& R, int& C) { const int st = b / 1024, sb = b % 1024, swz = sb ^ (((sb >> 9) & 1) << 5); R = (st >> 1) * 16 + swz / 64; C = (st & 1) * 32 + (swz % 64) / 2; }
__host__ __device__ __forceinline__ int perm32(int rho) { const int n = rho >> 4, i = rho & 15; return 8 * (i >> 2) + 4 * n + (i & 3); }

struct Unit { int pm, pn; int orow0, ocol0; unsigned long long bofs; int aux; int part = 0; };
struct Gemm { const void* A; const void* Bt; int lda, ldb, K; const float* rs = nullptr; float cs = 1.f; };

typedef int i32x8 __attribute__((ext_vector_type(8)));
typedef int i32x4 __attribute__((ext_vector_type(4)));
__device__ __forceinline__ i32x8 cat8(bf16x8 a, bf16x8 b) { const u32x4 x = __builtin_bit_cast(u32x4, a), y = __builtin_bit_cast(u32x4, b); return (i32x8){(int)x.x, (int)x.y, (int)x.z, (int)x.w, (int)y.x, (int)y.y, (int)y.z, (int)y.w}; }
template <int DT, bool SPLIT, class Epi, class Sched>
__device__ __forceinline__ void gemm_phase_(LAS unsigned char* lds, const Gemm g, const Sched& S, const Epi& E) {
    const int tid = threadIdx.x, wid = __builtin_amdgcn_readfirstlane(tid >> 6), lane = tid & 63, wr = wid >> 2, wc = wid & 3, fr = lane & 15, fq = lane >> 4;
    const int nt = g.K / (BK * 2);
    int Rr[2]; unsigned Cb[2], voffB[2];
#pragma unroll
    for (int i = 0; i < 2; ++i) { int R, C; stage_rc(tid * 16 + i * 8192, R, C); const int Rb = (R & ~31) + perm32(R & 31);
        Rr[i] = R; Cb[i] = (unsigned)C * 2u; voffB[i] = (unsigned)(Rb * g.ldb + C * 2); }
    const size_t kstep = (size_t)(BK * 2);
    const size_t hstepB = (size_t)HALF * g.ldb;
    const unsigned lda2 = (unsigned)g.lda;
    const unsigned ldsw = (unsigned)wid * 1024u;
    const int aoff = lds_byte(wr * 64 + fr, fq * 8), boff = lds_byte(wc * 32 + fr, fq * 8);
#define PG8_SA(b, h) (((b) * 2 + (h)) * HTB)
#define PG8_SB(b, h) ((4 + (b) * 2 + (h)) * HTB)
#define PG8_STAGE(bufoff, gbase, voff) do { _Pragma("unroll") for (int _i = 0; _i < 2; ++_i) \
        __builtin_amdgcn_global_load_lds((const unsigned*)((const char*)(gbase) + (voff)[_i]), (LAS unsigned*)(lds + (bufoff) + ldsw + _i * 8192), 16, 0, 0); } while (0)
#define PG8_LD16(p) (*(const LAS i32x4*)(p))
#define PG8_LDA(dst, b, h) do { _Pragma("unroll") for (int m = 0; m < 4; ++m) { const i32x4 x_ = PG8_LD16(lds + PG8_SA(b, h) + aoff + m * 2048), y_ = PG8_LD16(lds + PG8_SA(b, h) + aoff + m * 2048 + 1024); \
        dst[m] = (i32x8){x_.x, x_.y, x_.z, x_.w, y_.x, y_.y, y_.z, y_.w}; } } while (0)
#define PG8_LDB(dst, b, h) do { _Pragma("unroll") for (int n = 0; n < 2; ++n) { const i32x4 x_ = PG8_LD16(lds + PG8_SB(b, h) + boff + n * 2048), y_ = PG8_LD16(lds + PG8_SB(b, h) + boff + n * 2048 + 1024); \
        dst[n] = (i32x8){x_.x, x_.y, x_.z, x_.w, y_.x, y_.y, y_.z, y_.w}; } } while (0)
#define PG8_HALFI(v, k) ((k) == 0 ? (i32x4){v.s0, v.s1, v.s2, v.s3} : (i32x4){v.s4, v.s5, v.s6, v.s7})
#define PG8_HALF(v, k) __builtin_bit_cast(bf16x8, PG8_HALFI(v, k))
#define PG8_MMA(ai, bj, At, Bt) do { __builtin_amdgcn_s_setprio(1); _Pragma("unroll") for (int m = 0; m < 4; ++m) _Pragma("unroll") for (int n = 0; n < 2; ++n) { \
        if constexpr (DT == 1) { asm volatile("v_mfma_f32_16x16x128_f8f6f4 %0, %1, %2, %0" : "+v"(acc[ai][bj][m][n]) : "v"(Bt[n]), "v"(At[m])); } \
        else if constexpr (DT >= 2) { _Pragma("unroll") for (int k = 0; k < 2; ++k) acc[ai][bj][m][n] = __builtin_bit_cast(f32x4, __builtin_amdgcn_mfma_i32_16x16x64_i8(PG8_HALFI(Bt[n], k), PG8_HALFI(At[m], k), __builtin_bit_cast(i32x4, acc[ai][bj][m][n]), 0, 0, 0)); } \
        else { _Pragma("unroll") for (int k = 0; k < 2; ++k) acc[ai][bj][m][n] = __builtin_amdgcn_mfma_f32_16x16x32_bf16(PG8_HALF(Bt[n], k), PG8_HALF(At[m], k), acc[ai][bj][m][n], 0, 0, 0); } } __builtin_amdgcn_s_setprio(0); } while (0)
#define PG8_WAIT_V(n) asm volatile("s_waitcnt vmcnt(" #n ")" ::: "memory")
#define PG8_WAIT_V8F(first) do { if ((first) && !SPLIT) asm volatile("s_waitcnt vmcnt(%0)" :: "n"(8 + Epi::NVM) : "memory"); else asm volatile("s_waitcnt vmcnt(8)" ::: "memory"); } while (0)
#define PG8_WAIT_L(n) asm volatile("s_waitcnt lgkmcnt(" #n ")" ::: "memory")
#define PG8_BAR __builtin_amdgcn_s_barrier()
#define PG8_SCHED __builtin_amdgcn_sched_barrier(0)
#define PG8_AOFF(dst, u) do { _Pragma("unroll") for (int _h = 0; _h < 2; ++_h) _Pragma("unroll") for (int _i = 0; _i < 2; ++_i) \
        dst[_h][_i] = (unsigned)S.arow(u, _h * HALF + Rr[_i]) * lda2 + Cb[_i]; } while (0)
    Unit cur, nxt; int ui = 0;
    if (!S.next(0, cur)) return;
    f32x4 acc[2][2][4][2];
#pragma unroll
    for (int a = 0; a < 2; ++a)
#pragma unroll
        for (int b = 0; b < 2; ++b)
#pragma unroll
            for (int m = 0; m < 4; ++m)
#pragma unroll
                for (int n = 0; n < 2; ++n) acc[a][b][m][n] = (f32x4){0.f, 0.f, 0.f, 0.f};
    i32x8 At[4], B0[2], B1[2];
    const int sc1 = 0x7f7f7f7f;
    unsigned aoc[2][2], aon[2][2];
    PG8_AOFF(aoc, cur);
    const char* const Ab = (const char*)g.A;
    const char* cB = (const char*)g.Bt + cur.bofs;
    PG8_STAGE(PG8_SB(0, 0), cB, voffB); PG8_STAGE(PG8_SB(0, 1), cB + hstepB, voffB); PG8_STAGE(PG8_SA(0, 0), Ab, aoc[0]); PG8_STAGE(PG8_SA(0, 1), Ab, aoc[1]);
    if (wr == 1) PG8_BAR;
    PG8_WAIT_V(2); PG8_BAR;
    PG8_STAGE(PG8_SB(1, 0), cB + kstep, voffB); PG8_STAGE(PG8_SA(1, 0), Ab + kstep, aoc[0]); PG8_STAGE(PG8_SB(1, 1), cB + hstepB + kstep, voffB);
    PG8_WAIT_V(6); PG8_BAR;
    for (;;) {
        const bool has_next = S.next(ui + 1, nxt);
        int pt_ = 0; if constexpr (SPLIT) pt_ = __builtin_amdgcn_readfirstlane(cur.part);
        const bool uB0 = ((pt_ >> 2) & 3) != 2, uB1 = ((pt_ >> 2) & 3) != 1, uA1 = (pt_ & 3) == 0;
        const char* nB = has_next ? (const char*)g.Bt + nxt.bofs : cB;
        if (has_next) { PG8_AOFF(aon, nxt); } else {
#pragma unroll
            for (int h = 0; h < 2; ++h)
#pragma unroll
                for (int i = 0; i < 2; ++i) aon[h][i] = aoc[h][i]; }
#pragma unroll 1
        for (int t = 0; t < nt; t += 2) {
            const bool last = (t == nt - 2);
            if constexpr (DT == 2 || DT == 3) if (last && wc == 0) {
                const float* sp_;
                if constexpr (DT == 3) sp_ = g.rs + cur.orow0 + wr * 64 + fr; else sp_ = E.scale_ptr(cur, wr, fr);
#define PG8_RSC(i) __builtin_amdgcn_global_load_lds((const unsigned*)sp_, (LAS unsigned*)(lds + RSC_OFF + wr * 2048 + (i) * 256 - (((i) >> 2) * 512 + ((i) & 3) * 64)), 4, ((i) >> 2) * 512 + ((i) & 3) * 64, 0)
                PG8_RSC(0); PG8_RSC(1); PG8_RSC(2); PG8_RSC(3); PG8_RSC(4); PG8_RSC(5); PG8_RSC(6); PG8_RSC(7);
#undef PG8_RSC
            }
            const char* a1 = Ab + (size_t)(t + 1) * kstep;
            const char* a2 = last ? Ab : Ab + (size_t)(t + 2) * kstep; const char* b2 = last ? nB : cB + (size_t)(t + 2) * kstep;
            const char* a3 = a2 + kstep; const char* b3 = b2 + kstep;
            unsigned ao2[2][2]; const unsigned lm_ = last ? 0xffffffffu : 0u;
#pragma unroll
            for (int h = 0; h < 2; ++h)
#pragma unroll
                for (int i = 0; i < 2; ++i) ao2[h][i] = (aon[h][i] & lm_) | (aoc[h][i] & ~lm_);
            const bool fst = (t == 0) && (ui > 0);
#define PG8_IF(c, x) do { if constexpr (SPLIT) { if (c) { x; } } else { x; } } while (0)
            PG8_IF(uB0, PG8_LDB(B0, 0, 0)); PG8_IF(uB1, PG8_LDB(B1, 0, 1)); PG8_SCHED; PG8_LDA(At, 0, 0); PG8_STAGE(PG8_SA(1, 1), a1, aoc[1]);
            PG8_WAIT_V8F(fst); PG8_WAIT_L(0); PG8_BAR; PG8_IF(uB0, PG8_MMA(0, 0, At, B0)); PG8_IF(uB1, PG8_MMA(0, 1, At, B1)); PG8_BAR; PG8_SCHED;
            PG8_IF(uA1, PG8_LDA(At, 0, 1)); PG8_STAGE(PG8_SB(0, 0), b2, voffB); PG8_STAGE(PG8_SB(0, 1), b2 + hstepB, voffB); PG8_STAGE(PG8_SA(0, 0), a2, ao2[0]);
            PG8_WAIT_V8F(fst); PG8_WAIT_L(0); PG8_BAR; PG8_IF(uA1 && uB0, PG8_MMA(1, 0, At, B0)); PG8_IF(uA1 && uB1, PG8_MMA(1, 1, At, B1)); PG8_BAR; PG8_SCHED;
            PG8_IF(uB0, PG8_LDB(B0, 1, 0)); PG8_IF(uB1, PG8_LDB(B1, 1, 1)); PG8_SCHED; PG8_LDA(At, 1, 0); PG8_STAGE(PG8_SA(0, 1), a2, ao2[1]);
            PG8_WAIT_V(8); PG8_WAIT_L(0); PG8_BAR; PG8_IF(uB0, PG8_MMA(0, 0, At, B0)); PG8_IF(uB1, PG8_MMA(0, 1, At, B1)); PG8_BAR; PG8_SCHED;
            PG8_IF(uA1, PG8_LDA(At, 1, 1)); PG8_STAGE(PG8_SB(1, 0), b3, voffB); PG8_STAGE(PG8_SB(1, 1), b3 + hstepB, voffB); PG8_STAGE(PG8_SA(1, 0), a3, ao2[0]);
            PG8_WAIT_V(8); PG8_WAIT_L(0); PG8_BAR; PG8_IF(uA1 && uB0, PG8_MMA(1, 0, At, B0)); PG8_IF(uA1 && uB1, PG8_MMA(1, 1, At, B1)); PG8_BAR; PG8_SCHED;
#undef PG8_IF
        }
        if (wr == 0) PG8_BAR;
        float rsc[8];
        if constexpr (DT == 2 || DT == 3) {
#pragma unroll
            for (int i = 0; i < 8; ++i) rsc[i] = *(const LAS float*)(lds + RSC_OFF + wr * 2048 + i * 256 + lane * 4);
        }
        if constexpr (DT == 1) asm volatile("s_nop 15\n\ts_nop 15" ::: "memory");
        if constexpr (DT == 4) {
#pragma unroll
            for (int a = 0; a < 2; ++a)
#pragma unroll
                for (int b = 0; b < 2; ++b)
#pragma unroll
                    for (int m = 0; m < 4; ++m)
#pragma unroll
                        for (int n = 0; n < 2; ++n)
#pragma unroll
                            for (int j = 0; j < 4; ++j) { const float f_ = acc[a][b][m][n][j]; acc[a][b][m][n][j] = (float)__builtin_bit_cast(int, f_) * g.cs; }
        }
        if constexpr (DT == 3) {
#pragma unroll
            for (int a = 0; a < 2; ++a)
#pragma unroll
                for (int m = 0; m < 4; ++m) { const float sc = rsc[a * 4 + m] * (1.f / S_WI8);
#pragma unroll
                    for (int b = 0; b < 2; ++b)
#pragma unroll
                        for (int n = 0; n < 2; ++n)
#pragma unroll
                            for (int j = 0; j < 4; ++j) { const float f_ = acc[a][b][m][n][j]; acc[a][b][m][n][j] = (float)__builtin_bit_cast(int, f_) * sc; } }
        }
        if constexpr (DT == 2) E(acc, cur, wr, wc, fr, fq, rsc); else E(acc, cur, wr, wc, fr, fq);
        if (!has_next) break;
#pragma unroll
        for (int a = 0; a < 2; ++a)
#pragma unroll
            for (int b = 0; b < 2; ++b)
#pragma unroll
                for (int m = 0; m < 4; ++m)
#pragma unroll
                    for (int n = 0; n < 2; ++n) acc[a][b][m][n] = (f32x4){0.f, 0.f, 0.f, 0.f};
        cur = nxt; cB = nB; ++ui;
#pragma unroll
        for (int h = 0; h < 2; ++h)
#pragma unroll
            for (int i = 0; i < 2; ++i) aoc[h][i] = aon[h][i];
        if (wr == 1) PG8_BAR;
    }
    PG8_WAIT_V(0);
    PG8_BAR;
#undef PG8_SA
#undef PG8_SB
#undef PG8_STAGE
#undef PG8_LDA
#undef PG8_LD16
#undef PG8_HALF
#undef PG8_HALFI
#undef PG8_LDB
#undef PG8_MMA
#undef PG8_WAIT_V
#undef PG8_WAIT_V8F
#undef PG8_WAIT_L
#undef PG8_BAR
#undef PG8_SCHED
#undef PG8_AOFF
}
template <int DT, class Epi, class Sched>
__device__ __forceinline__ void gemm_phase(LAS unsigned char* lds, const Gemm g, const Sched& S, const Epi& E) { gemm_phase_<DT, false>(lds, g, S, E); }

struct DenseOrder {
    int flat = 0; int nM, nN, nwg, G, c; int ocw; unsigned long long bstep;
    __device__ __forceinline__ void init(int nM_, int nN_, int G_, int c_, int ocw_, int ldb) { nM = nM_; nN = nN_; nwg = nM * nN; G = G_; c = c_; ocw = ocw_; bstep = (unsigned long long)BM * ldb; }
    __device__ __forceinline__ bool next(int i, Unit& u) const {
        const long L = (long)i * G + c; if (L >= nwg) return false;
        int wgid = (int)L; { const int q = nwg / NXCD, r = nwg % NXCD, xcd = wgid % NXCD, off = wgid / NXCD; wgid = (xcd < r ? xcd * (q + 1) : r * (q + 1) + (xcd - r) * q) + off; }
        const int nig = WGM * nN, gid = wgid / nig, fm = gid * WGM, gsz = (nM - fm) < WGM ? (nM - fm) : WGM;
        u.pm = fm + ((wgid % nig) % gsz); u.pn = (wgid % nig) / gsz;
        if (flat) { u.pm = 0; u.pn = 0; }
        u.orow0 = u.pm * BM; u.ocol0 = u.pn * ocw; u.bofs = (unsigned long long)u.pn * bstep; u.aux = 0; return true;
    }
    __device__ __forceinline__ int arow(const Unit& u, int r) const { return u.pm * BM + r; }
};
}

__device__ __forceinline__ unsigned pk4_i8(float a, float b, float c, float d) {
    const int ia = (int)__builtin_amdgcn_fmed3f(__builtin_rintf(a), -127.f, 127.f), ib = (int)__builtin_amdgcn_fmed3f(__builtin_rintf(b), -127.f, 127.f);
    const int ic = (int)__builtin_amdgcn_fmed3f(__builtin_rintf(c), -127.f, 127.f), id = (int)__builtin_amdgcn_fmed3f(__builtin_rintf(d), -127.f, 127.f);
    return (unsigned)(ia & 255) | ((unsigned)(ib & 255) << 8) | ((unsigned)(ic & 255) << 16) | ((unsigned)id << 24);
}
constexpr float QK_C2 = 0.125f * 1.4426950408889634f;
struct EpiPlain {
    static constexpr int NVM = 16;
    bf16* O; int ldc; float scale; int skip = 0; int qlo = 0, qhi = 0;
    __device__ __forceinline__ void operator()(const f32x4 (&acc)[2][2][4][2], const pg8::Unit& u, int wr, int wc, int fr, int fq) const {
        const float sc = (u.pn >= qlo && u.pn < qhi) ? scale * QK_C2 : scale;
        const int row0 = u.orow0 + wr * 64 + fr, col0 = u.ocol0 + wc * 32 + 8 * fq;
#pragma unroll
        for (int ai = 0; ai < 2; ++ai)
#pragma unroll
            for (int m = 0; m < 4; ++m) { bf16* rowp = O + (size_t)(row0 + ai * 128 + m * 16) * ldc + col0;
                if (ai == 1 && (u.part & 3)) continue;
#pragma unroll
                for (int bj = 0; bj < 2; ++bj) { const f32x4 v0 = acc[ai][bj][m][0] * sc, v1 = acc[ai][bj][m][1] * sc;
                    if (((u.part >> 2) & 3) == 2 - bj) continue;
                    u32x4 w; w.x = cvt_pk_bf16(v0[0], v0[1]); w.y = cvt_pk_bf16(v0[2], v0[3]); w.z = cvt_pk_bf16(v1[0], v1[1]); w.w = cvt_pk_bf16(v1[2], v1[3]);
                    *(u32x4*)(rowp + bj * 128) = w; } }
    }
};
struct EpiRope {
    static constexpr int NVM = 16;
    bf16* O; int ldc; const float* rope;
    __device__ __forceinline__ void operator()(const f32x4 (&acc)[2][2][4][2], const pg8::Unit& u, int wr, int wc, int fr, int fq) const {
        const int row0 = u.orow0 + wr * 64 + fr, col0 = u.ocol0 + wc * 32 + 8 * fq;
        const bool isq = (u.pn == 6 || u.pn == 7), isqk = (u.pn >= 6 && u.pn <= 9), lat = u.orow0 < ML;
        const float sc = isq ? QK_C2 : 1.f;
        const int i0 = 16 * (wc & 1) + 4 * fq;
        if (isqk) {
            f32x4 csv[8][2];
#pragma unroll
            for (int i = 0; i < 8; ++i) { const int row = row0 + (i >> 2) * 128 + (i & 3) * 16; const float* rp = rope + ((size_t)(lat ? (row & 2047) : 0) * 32 + i0) * 2; csv[i][0] = *(const f32x4*)rp; csv[i][1] = *(const f32x4*)(rp + 4); }
            if (!lat) {
#pragma unroll
                for (int i = 0; i < 8; ++i) { csv[i][0] = (f32x4){1.f, 0.f, 1.f, 0.f}; csv[i][1] = csv[i][0]; } }
#pragma unroll
            for (int ai = 0; ai < 2; ++ai)
#pragma unroll
                for (int m = 0; m < 4; ++m) { const int row = row0 + ai * 128 + m * 16; bf16* rowp = O + (size_t)row * ldc + col0;
                    const f32x4 cs0 = csv[ai * 4 + m][0], cs1 = csv[ai * 4 + m][1];
#pragma unroll
                    for (int bj = 0; bj < 2; ++bj) { const f32x4 v0 = acc[ai][bj][m][0] * sc, v1 = acc[ai][bj][m][1] * sc;
                        u32x4 w;
                        w.x = cvt_pk_bf16(v0[0] * cs0[0] - v0[1] * cs0[1], v0[0] * cs0[1] + v0[1] * cs0[0]); w.y = cvt_pk_bf16(v0[2] * cs0[2] - v0[3] * cs0[3], v0[2] * cs0[3] + v0[3] * cs0[2]);
                        w.z = cvt_pk_bf16(v1[0] * cs1[0] - v1[1] * cs1[1], v1[0] * cs1[1] + v1[1] * cs1[0]); w.w = cvt_pk_bf16(v1[2] * cs1[2] - v1[3] * cs1[3], v1[2] * cs1[3] + v1[3] * cs1[2]);
                        *(u32x4*)(rowp + bj * 128) = w; } }
        } else {
#pragma unroll
            for (int ai = 0; ai < 2; ++ai)
#pragma unroll
                for (int m = 0; m < 4; ++m) { bf16* rowp = O + (size_t)(row0 + ai * 128 + m * 16) * ldc + col0;
#pragma unroll
                    for (int bj = 0; bj < 2; ++bj) { const f32x4 v0 = acc[ai][bj][m][0], v1 = acc[ai][bj][m][1];
                        u32x4 w; w.x = cvt_pk_bf16(v0[0], v0[1]); w.y = cvt_pk_bf16(v0[2], v0[3]); w.z = cvt_pk_bf16(v1[0], v1[1]); w.w = cvt_pk_bf16(v1[2], v1[3]);
                        *(u32x4*)(rowp + bj * 128) = w; } }
        }
    }
};
struct EpiSwiglu {
    static constexpr int NVM = 8;
    bf16* O; int ldc;
    __device__ __forceinline__ void operator()(const f32x4 (&acc)[2][2][4][2], const pg8::Unit& u, int wr, int wc, int fr, int fq) const {
        const int row0 = u.orow0 + wr * 64 + fr, col0 = u.ocol0 + wc * 32 + 8 * fq;
#pragma unroll
        for (int ai = 0; ai < 2; ++ai)
#pragma unroll
            for (int m = 0; m < 4; ++m) { bf16* rowp = O + (size_t)(row0 + ai * 128 + m * 16) * ldc + col0;
                float r[8];
#pragma unroll
                for (int n = 0; n < 2; ++n)
#pragma unroll
                    for (int j = 0; j < 4; ++j) { const float gt = acc[ai][0][m][n][j], up = acc[ai][1][m][n][j]; r[n * 4 + j] = silu_f(gt) * up; }
                u32x4 w; w.x = cvt_pk_bf16(r[0], r[1]); w.y = cvt_pk_bf16(r[2], r[3]); w.z = cvt_pk_bf16(r[4], r[5]); w.w = cvt_pk_bf16(r[6], r[7]);
                *(u32x4*)rowp = w; }
    }
};
struct EpiSwiglu8 {
    static constexpr int NVM = 8;
    unsigned char* O; int ldc; float inv;
    __device__ __forceinline__ void operator()(const f32x4 (&acc)[2][2][4][2], const pg8::Unit& u, int wr, int wc, int fr, int fq) const {
        const int row0 = u.orow0 + wr * 64 + fr, col0 = u.ocol0 + wc * 32 + 8 * fq;
        const float c1 = -inv * 1.4426950408889634f, c2 = inv * inv * S_HID;
#pragma unroll
        for (int ai = 0; ai < 2; ++ai)
#pragma unroll
            for (int m = 0; m < 4; ++m) { unsigned char* rowp = O + (size_t)(row0 + ai * 128 + m * 16) * ldc + col0;
                float r[8];
#pragma unroll
                for (int n = 0; n < 2; ++n)
#pragma unroll
                    for (int j = 0; j < 4; ++j) { const float ag = acc[ai][0][m][n][j], au = acc[ai][1][m][n][j];
                        r[n * 4 + j] = (ag * au) * __builtin_amdgcn_rcpf(1.f + __builtin_amdgcn_exp2f(ag * c1)) * c2; }
                u32x2 w; w.x = pk4_fp8(r[0], r[1], r[2], r[3]); w.y = pk4_fp8(r[4], r[5], r[6], r[7]);
                *(u32x2*)rowp = w; }
    }
};
template <bool MOE>
struct EpiSwigluI8 {
    static constexpr int NVM = 8;
    unsigned char* O; int ldc; const float* srs;
    __device__ __forceinline__ const float* scale_ptr(const pg8::Unit& u, int wr, int fr) const {
        return srs + (MOE ? (size_t)(u.aux & 15) * ML + ((u.aux >> 4) & 255) * 256 : (size_t)u.orow0) + wr * 64 + fr; }
    __device__ __forceinline__ void operator()(const f32x4 (&acc)[2][2][4][2], const pg8::Unit& u, int wr, int wc, int fr, int fq, const float (&rsc)[8]) const {
        const int row0 = u.orow0 + wr * 64 + fr, col0 = u.ocol0 + wc * 32 + 8 * fq;
#pragma unroll
        for (int ai = 0; ai < 2; ++ai)
#pragma unroll
            for (int m = 0; m < 4; ++m) { unsigned char* rowp = O + (size_t)(row0 + ai * 128 + m * 16) * ldc + col0;
                const float inv = rsc[ai * 4 + m] * (1.f / S_WI8);
                const float c1 = -inv * 1.4426950408889634f, c2 = inv * inv * S_HID;
                float r[8];
                typedef float f32x2_ __attribute__((ext_vector_type(2)));
#pragma unroll
                for (int n = 0; n < 2; ++n)
#pragma unroll
                    for (int j = 0; j < 4; j += 2) { const float fg0 = acc[ai][0][m][n][j], fu0 = acc[ai][1][m][n][j], fg1 = acc[ai][0][m][n][j + 1], fu1 = acc[ai][1][m][n][j + 1];
                        const f32x2_ ag = (f32x2_){(float)__builtin_bit_cast(int, fg0), (float)__builtin_bit_cast(int, fg1)}, au = (f32x2_){(float)__builtin_bit_cast(int, fu0), (float)__builtin_bit_cast(int, fu1)};
                        const f32x2_ t = ag * c1; const f32x2_ d = (f32x2_){__builtin_amdgcn_exp2f(t.x), __builtin_amdgcn_exp2f(t.y)} + 1.f;
                        const f32x2_ q = (f32x2_){__builtin_amdgcn_rcpf(d.x), __builtin_amdgcn_rcpf(d.y)};
                        const f32x2_ v = (ag * q) * (au * c2);
                        r[n * 4 + j] = v.x; r[n * 4 + j + 1] = v.y; }
                u32x2 w; w.x = pk4_fp8(r[0], r[1], r[2], r[3]); w.y = pk4_fp8(r[4], r[5], r[6], r[7]);
                *(u32x2*)rowp = w; }
    }
};
struct EpiDftC {
    static constexpr int NVM = 16;
    bf16* PQt; const float* gn;
    __device__ __forceinline__ void operator()(const f32x4 (&acc)[2][2][4][2], const pg8::Unit& u, int wr, int wc, int fr, int fq) const {
        const int gi = u.pm, jrow = wr * 64 + fr;
        const int tok0 = u.pn * 256 + wc * 32 + 8 * fq;
#pragma unroll
        for (int bj = 0; bj < 2; ++bj) {
            const int tk = tok0 + bj * 128; const int b = tk >> 11, l = tk & 2047;
            bf16* base = PQt + ((size_t)(b * 512 + gi * 128 + jrow)) * 4096 + l;
            float mu[8], rs[8];
            { const f32x4* p = (const f32x4*)(gn + ((size_t)gi * ML + tk) * 2);
#pragma unroll
              for (int j = 0; j < 4; ++j) { const f32x4 t = p[j]; mu[2 * j] = t[0]; rs[2 * j] = t[1]; mu[2 * j + 1] = t[2]; rs[2 * j + 1] = t[3]; } }
#pragma unroll
            for (int ai = 0; ai < 2; ++ai) {
#pragma unroll
                for (int m = 0; m < 4; ++m) {
                    const float dc = (ai == 0 && m == 0 && jrow == 0) ? 128.f : 0.f;
                    float r[8];
#pragma unroll
                    for (int n = 0; n < 2; ++n)
#pragma unroll
                        for (int j = 0; j < 4; ++j) r[n * 4 + j] = rs[n * 4 + j] * (acc[ai][bj][m][n][j] - mu[n * 4 + j] * dc);
#if DFTL_I8
                    u32x2 w; w.x = pk4_i8(r[0] * S_PQ, r[1] * S_PQ, r[2] * S_PQ, r[3] * S_PQ); w.y = pk4_i8(r[4] * S_PQ, r[5] * S_PQ, r[6] * S_PQ, r[7] * S_PQ);
                    *(u32x2*)((unsigned char*)PQt + ((size_t)(b * 512 + gi * 128 + jrow + m * 16)) * 4096 + l + ai * 2048) = w; }
#else
                    u32x4 w; w.x = cvt_pk_bf16(r[0], r[1]); w.y = cvt_pk_bf16(r[2], r[3]); w.z = cvt_pk_bf16(r[4], r[5]); w.w = cvt_pk_bf16(r[6], r[7]);
                    *(u32x4*)(base + (size_t)m * 16 * 4096 + ai * 2048) = w; }
#endif
                asm volatile("" ::: "memory"); }
        }
    }
};

struct Frame {
    LAS unsigned char* lds;
    int tid, lane, wave, G, vcu, gw, NGW;
    const float* in[26];
    float* out; unsigned char* ws;
};
#define IN_X 0
#define IN_C 1
#define IN_CTX 2
#define IN_CCTX 3
#define IN_WMOD 4
#define IN_BMOD 5
#define IN_LNG 6
#define IN_LNB 7
#define IN_EWIN 8
#define IN_ECONV 9
#define IN_LQ1 10
#define IN_LK1 11
#define IN_LQ2 12
#define IN_LK2 13
#define IN_SUBG 14
#define IN_EWO 15
#define IN_EGATE 16
#define IN_EUP 17
#define IN_EDOWN 18
#define IN_OWIN 19
#define IN_RPB 20
#define IN_OWO 21
#define IN_ROUTER 22
#define IN_XGATE 23
#define IN_XUP 24
#define IN_XDOWN 25

__device__ __forceinline__ const float* mods_ptr(const Frame& F, int layer, int cond, int which) { return (const float*)(F.ws + WS_MODS) + ((size_t)(layer * NCOND + cond) * 6 + which) * DM; }
__device__ __forceinline__ int cond_of_row(int row) { return row < ML ? (row >> 11) : NCOND - 1; }

__device__ __forceinline__ void conv_item(const float* W, int K, int N, bf16* WT, int mode, LAS float* scr, int item, int lane) {
    const int nblk = N / 32, kb = item / nblk, nb = item % nblk, k0 = 64 * kb, n0 = 32 * nb;
    { float v_[32];
#pragma unroll
      for (int i = 0; i < 32; ++i) v_[i] = W[(size_t)(k0 + 2 * i + (lane >> 5)) * N + n0 + (lane & 31)];
#pragma unroll
      for (int i = 0; i < 32; ++i) scr[(2 * i + (lane >> 5)) * 33 + (lane & 31)] = v_[i]; }
    asm volatile("s_waitcnt lgkmcnt(0)" ::: "memory");
    int d0 = n0, ds = 1;
    if (mode == 1 || mode == 2) d0 = (n0 >> 7) * 256 + (n0 & 127) + (mode == 2 ? 128 : 0);
    if (mode == 3 && n0 >= 1536 && n0 < 2560) { d0 = (n0 & ~63) + ((n0 >> 5) & 1); ds = 2; }
    const int c = lane & 7;
#pragma unroll
    for (int j = 0; j < 4; ++j) { const int n = (lane >> 3) + 8 * j; const LAS float* s = scr + (8 * c) * 33 + n;
        u32x4 o; o.x = pk2(s[0 * 33], s[1 * 33]); o.y = pk2(s[2 * 33], s[3 * 33]); o.z = pk2(s[4 * 33], s[5 * 33]); o.w = pk2(s[6 * 33], s[7 * 33]);
        *(u32x4*)(WT + (size_t)(d0 + n * ds) * K + k0 + 8 * c) = o; }
    asm volatile("s_waitcnt lgkmcnt(0)" ::: "memory");
}
template <bool I8 = false>
__device__ __forceinline__ void conv_item8(const float* W, int K, int N, unsigned char* WT, int mode, float scale, LAS float* scr, int item, int lane) {
    const int nblk = N / 32, kb = item / nblk, nb = item % nblk, k0 = 64 * kb, n0 = 32 * nb;
    { float v_[32];
#pragma unroll
      for (int i = 0; i < 32; ++i) v_[i] = W[(size_t)(k0 + 2 * i + (lane >> 5)) * N + n0 + (lane & 31)];
#pragma unroll
      for (int i = 0; i < 32; ++i) scr[(2 * i + (lane >> 5)) * 33 + (lane & 31)] = v_[i]; }
    asm volatile("s_waitcnt lgkmcnt(0)" ::: "memory");
    int d0 = n0, ds = 1;
    if (mode == 1 || mode == 2) d0 = (n0 >> 7) * 256 + (n0 & 127) + (mode == 2 ? 128 : 0);
    if (mode == 3 && n0 >= 1536 && n0 < 2560) { d0 = (n0 & ~63) + ((n0 >> 5) & 1); ds = 2; }
    const int c = lane & 7;
#pragma unroll
    for (int j = 0; j < 4; ++j) { const int n = (lane >> 3) + 8 * j; const LAS float* s = scr + (8 * c) * 33 + n;
        u32x2 o;
        if (I8) { o.x = pk4_i8(s[0 * 33] * scale, s[1 * 33] * scale, s[2 * 33] * scale, s[3 * 33] * scale); o.y = pk4_i8(s[4 * 33] * scale, s[5 * 33] * scale, s[6 * 33] * scale, s[7 * 33] * scale); }
        else { o.x = pk4_fp8(s[0 * 33] * scale, s[1 * 33] * scale, s[2 * 33] * scale, s[3 * 33] * scale); o.y = pk4_fp8(s[4 * 33] * scale, s[5 * 33] * scale, s[6 * 33] * scale, s[7 * 33] * scale); }
        *(u32x2*)(WT + (size_t)(d0 + n * ds) * K + k0 + 8 * c) = o; }
    asm volatile("s_waitcnt lgkmcnt(0)" ::: "memory");
}

__device__ __forceinline__ void p0_prologue(Frame& F) {
    const int tid = F.tid, lane = F.lane, wave = F.wave;
    if ((int)blockIdx.x < 192) {
        LAS float* S = (LAS float*)F.lds;
        LAS float* red = (LAS float*)(F.lds + 17 * 1024 * 4);
        for (int i = tid; i < NCOND * DM; i += 512) { const int j = i >> 10, k = i & 1023; const float v = (j < 16) ? F.in[IN_C][j * DM + k] : F.in[IN_CCTX][k]; S[i] = silu_f(v); }
        __syncthreads();
        const int item = blockIdx.x, layer = item / 96, n = (item % 96) * 64 + lane;
        const float* W = F.in[IN_WMOD] + (size_t)layer * DM * 6144;
        float acc[NCOND];
#pragma unroll
        for (int j = 0; j < NCOND; ++j) acc[j] = 0.f;
#pragma unroll 1
        for (int k0 = wave * 128; k0 < wave * 128 + 128; k0 += 32) {
            float wv[32];
#pragma unroll
            for (int i = 0; i < 32; ++i) wv[i] = W[(size_t)(k0 + i) * 6144 + n];
#pragma unroll
            for (int i = 0; i < 32; ++i)
#pragma unroll
                for (int j = 0; j < NCOND; ++j) acc[j] += S[j * DM + k0 + i] * wv[i]; }
#pragma unroll
        for (int j = 0; j < NCOND; ++j) red[(wave * NCOND + j) * 64 + lane] = acc[j];
        __syncthreads();
        for (int i = tid; i < NCOND * 64; i += 512) { const int j = i >> 6, l = i & 63; float s = 0.f;
#pragma unroll
            for (int w = 0; w < 8; ++w) s += red[(w * NCOND + j) * 64 + l];
            const int nn = (item % 96) * 64 + l;
            ((float*)(F.ws + WS_MODS))[(size_t)(layer * NCOND + j) * 6144 + nn] = s + F.in[IN_BMOD][layer * 6144 + nn]; }
        __syncthreads();
    }
    {
        LAS float* scr = (LAS float*)(F.lds + wave * 16384);
        constexpr int I_EIN = 16 * 96, I_EO = 16 * 32, I_G = 16 * 88, I_DN = 44 * 32, I_OIN = 16 * 64, I_OO = 16 * 32;
        constexpr int NIT = I_EIN + I_EO + 2 * I_G + I_DN + I_OIN + I_OO;
        for (int it = F.gw; it < NIT; it += F.NGW) {
            int r = it;
#if EIN_I8
            if (r < I_EIN) { conv_item8<true>(F.in[IN_EWIN], DM, E_IN, F.ws + WS_WEIN, 3, S_WI8, scr, r, lane); continue; } r -= I_EIN;
#else
            if (r < I_EIN) { conv_item(F.in[IN_EWIN], DM, E_IN, (bf16*)(F.ws + WS_WEIN), 3, scr, r, lane); continue; } r -= I_EIN;
#endif
            if (r < I_EO) { conv_item(F.in[IN_EWO], DM, DM, (bf16*)(F.ws + WS_WEO), 0, scr, r, lane); continue; } r -= I_EO;
#if FFN_FP8 == 3
            if (r < I_G) { conv_item8<true>(F.in[IN_EGATE], DM, FF, F.ws + WS_WGU, 1, S_WI8, scr, r, lane); continue; } r -= I_G;
            if (r < I_G) { conv_item8<true>(F.in[IN_EUP], DM, FF, F.ws + WS_WGU, 2, S_WI8, scr, r, lane); continue; } r -= I_G;
            if (r < I_DN) { conv_item8(F.in[IN_EDOWN], FF, DM, F.ws + WS_WDN, 0, S_WDN, scr, r, lane); continue; } r -= I_DN;
#elif FFN_FP8 == 1
            if (r < I_G) { conv_item8(F.in[IN_EGATE], DM, FF, F.ws + WS_WGU, 1, S_WGU, scr, r, lane); continue; } r -= I_G;
            if (r < I_G) { conv_item8(F.in[IN_EUP], DM, FF, F.ws + WS_WGU, 2, S_WGU, scr, r, lane); continue; } r -= I_G;
            if (r < I_DN) { conv_item8(F.in[IN_EDOWN], FF, DM, F.ws + WS_WDN, 0, S_WDN, scr, r, lane); continue; } r -= I_DN;
#else
            if (r < I_G) { conv_item(F.in[IN_EGATE], DM, FF, (bf16*)(F.ws + WS_WGU), 1, scr, r, lane); continue; } r -= I_G;
            if (r < I_G) { conv_item(F.in[IN_EUP], DM, FF, (bf16*)(F.ws + WS_WGU), 2, scr, r, lane); continue; } r -= I_G;
#if FFN_FP8 == 2
            if (r < I_DN) { conv_item8(F.in[IN_EDOWN], FF, DM, F.ws + WS_WDN, 0, S_WDN, scr, r, lane); continue; } r -= I_DN;
#else
            if (r < I_DN) { conv_item(F.in[IN_EDOWN], FF, DM, (bf16*)(F.ws + WS_WDN), 0, scr, r, lane); continue; } r -= I_DN;
#endif
#endif
#if OIN_I8
            if (r < I_OIN) { conv_item8<true>(F.in[IN_OWIN], DM, O_IN, F.ws + WS_WOIN, 0, S_WI8, scr, r, lane); continue; } r -= I_OIN;
#else
            if (r < I_OIN) { conv_item(F.in[IN_OWIN], DM, O_IN, (bf16*)(F.ws + WS_WOIN), 0, scr, r, lane); continue; } r -= I_OIN;
#endif
            conv_item(F.in[IN_OWO], DM, DM, (bf16*)(F.ws + WS_WOO), 0, scr, r, lane);
        }
    }
    {
        const size_t gt = (size_t)blockIdx.x * 512 + tid, NT = (size_t)F.G * 512;
        bf16* DL = (bf16*)(F.ws + WS_DFTL);
        for (size_t i = gt; i < (size_t)2048 * 4096 / 8; i += NT) {
            const int k = (int)(i >> 9), l0 = (int)(i & 511) * 8; unsigned w[4]; float vv[8]; (void)w; (void)vv;
#pragma unroll
            for (int j = 0; j < 8; j += 2) { float v[2];
#pragma unroll
                for (int q = 0; q < 2; ++q) { const int lp = l0 + j + q, l = lp & 2047; const int ph = (k * l) & 2047; float s, c; sincospif((float)ph * (1.f / 1024.f), &s, &c); v[q] = (lp < 2048) ? c : -s; }
#if DFTL_I8
                vv[j] = v[0]; vv[j + 1] = v[1]; }
            *(u32x2*)((unsigned char*)DL + (size_t)k * 4096 + l0) = (u32x2){pk4_i8(vv[0] * 127.f, vv[1] * 127.f, vv[2] * 127.f, vv[3] * 127.f), pk4_i8(vv[4] * 127.f, vv[5] * 127.f, vv[6] * 127.f, vv[7] * 127.f)};
#else
                w[j >> 1] = pk2(v[0], v[1]); }
            *(u32x4*)(DL + (size_t)k * 4096 + l0) = (u32x4){w[0], w[1], w[2], w[3]};
#endif
        }
        bf16* DC = (bf16*)(F.ws + WS_DFTC);
        for (size_t i = gt; i < (size_t)4 * 256 * 256; i += NT) {
            const int gi = (int)(i >> 16), mp = (int)(i >> 8) & 255, c2 = (int)i & 255; const int pq = mp >> 7, j = mp & 127, cg = c2 >> 7, c = c2 & 127;
            float v = 0.f;
            if (cg == (gi & 1)) { const int ph = (c * j) & 127; float s, cs; sincospif((float)ph * (1.f / 64.f), &s, &cs); v = pq ? s : cs; }
            DC[i] = (bf16)f2bf(v);
        }
        float* RP = (float*)(F.ws + WS_ROPE);
        for (size_t i = gt; i < (size_t)2048 * 32; i += NT) {
            const int t = (int)(i >> 5), j = (int)i & 31; const float pos = (j < 16) ? (float)(t >> 6) : (float)(t & 63);
            const float invf = powf(10000.f, -(float)(j & 15) / 16.f); const float ang = pos * invf;
            RP[i * 2] = cosf(ang); RP[i * 2 + 1] = sinf(ang);
        }
        bf16* BT = (bf16*)(F.ws + WS_BT);
        for (size_t i = gt; i < (size_t)8 * 15 * 2 * 2 * 64 * 16; i += NT) {
            const int r = (int)i & 15, ln = (int)(i >> 4) & 63, kb = (int)(i >> 10) & 1, qh = (int)(i >> 11) & 1, hd = (int)(i >> 12);
            const int qc = qh * 32 + (ln & 31), kc = kb * 32 + (r & 3) + 8 * (r >> 2) + 4 * (ln >> 5);
            const int cs = min(max(qc - 8, 0), 48);
            BT[i] = (bf16)f2bf((kc >= cs && kc < cs + 16) ? F.in[IN_RPB][hd * 31 + (kc - qc + 15)] * 1.4426950408889634f : -1e30f);
        }
        if (gt == 0) {
            float s1 = 0.f, s2 = 0.f;
            for (int d = 0; d < 64; ++d) { s1 += F.in[IN_LQ1][d] * F.in[IN_LK1][d]; s2 += F.in[IN_LQ2][d] * F.in[IN_LK2][d]; }
            const float lam_init = 0.2f;
            ((float*)(F.ws + WS_MISC))[0] = expf(s1) - expf(s2) + lam_init;
        }
    }
}

__device__ __forceinline__ void conv_experts(Frame& F, LAS float* scr, int k0, int k1) {
    constexpr int I_G = 16 * 112, I_D = 56 * 32;
    constexpr int NIT = NEXP * (2 * I_G + I_D);
    int ln = F.lane; asm volatile("" : "+v"(ln));
    for (int k = k0; k < k1; ++k) {
        const int it = F.gw + k * F.NGW; if (it >= NIT) break;
        const int e = it / (2 * I_G + I_D); int r = it % (2 * I_G + I_D);
        unsigned char* gu = F.ws + WS_EWGU + (size_t)e * 7168 * DM;
        if (r < I_G) { conv_item8<true>(F.in[IN_XGATE] + (size_t)e * DM * FFE, DM, FFE, gu, 1, S_WI8, scr, r, ln); continue; } r -= I_G;
        if (r < I_G) { conv_item8<true>(F.in[IN_XUP] + (size_t)e * DM * FFE, DM, FFE, gu, 2, S_WI8, scr, r, ln); continue; } r -= I_G;
        conv_item8(F.in[IN_XDOWN] + (size_t)e * FFE * DM, FFE, DM, F.ws + WS_EWDN + (size_t)e * DM * FFE, 0, S_WDN, scr, r, ln);
    }
}

__device__ __forceinline__ void ld_row_f32(const float* p, int lane, f32x4 (&v)[4]) {
#pragma unroll
    for (int j = 0; j < 4; ++j) v[j] = *(const f32x4*)(p + 4 * lane + 256 * j);
}
__device__ __forceinline__ void ld_row_bf16(const bf16* p, int lane, f32x4 (&v)[4]) {
#pragma unroll
    for (int j = 0; j < 4; ++j) { const u32x2 w = *(const u32x2*)(p + 4 * lane + 256 * j); v[j] = (f32x4){bf_lo(w.x), bf_hi(w.x), bf_lo(w.y), bf_hi(w.y)}; }
}
__device__ __forceinline__ void st_row_f32(float* p, int lane, const f32x4 (&v)[4]) {
#pragma unroll
    for (int j = 0; j < 4; ++j) *(f32x4*)(p + 4 * lane + 256 * j) = v[j];
}
__device__ __forceinline__ void st_row_bf16(bf16* p, int lane, const f32x4 (&v)[4]) {
#pragma unroll
    for (int j = 0; j < 4; ++j) { u32x2 w; w.x = pk2(v[j][0], v[j][1]); w.y = pk2(v[j][2], v[j][3]); *(u32x2*)(p + 4 * lane + 256 * j) = w; }
}
__device__ __forceinline__ void ln_row(f32x4 (&v)[4], const float* g, const float* b, int lane) {
    float s = 0.f;
#pragma unroll
    for (int j = 0; j < 4; ++j) s += (v[j][0] + v[j][1]) + (v[j][2] + v[j][3]);
    const float mean = wave_sum(s) * (1.f / DM); float s2 = 0.f;
#pragma unroll
    for (int j = 0; j < 4; ++j) { v[j] = v[j] - mean; s2 += (v[j][0] * v[j][0] + v[j][1] * v[j][1]) + (v[j][2] * v[j][2] + v[j][3] * v[j][3]); }
    const float rstd = rsqrtf(wave_sum(s2) * (1.f / DM) + LN_EPS);
    f32x4 gg[4], bb[4]; ld_row_f32(g, lane, gg); ld_row_f32(b, lane, bb);
#pragma unroll
    for (int j = 0; j < 4; ++j) v[j] = v[j] * rstd * gg[j] + bb[j];
}
__device__ __forceinline__ void modulate_row(f32x4 (&h)[4], const f32x4 (&x)[4], const float* sh, const float* sc, int lane) {
    f32x4 a[4], c[4]; ld_row_f32(sh, lane, a); ld_row_f32(sc, lane, c);
#pragma unroll
    for (int j = 0; j < 4; ++j) h[j] = x[j] * (1.f + c[j]) + a[j];
}

__device__ __forceinline__ void p1_modulate(Frame& F) {
    bf16* H = (bf16*)(F.ws + WS_H);
    for (int row = F.gw; row < MT; row += F.NGW) {
        const int cond = cond_of_row(row);
        const float* xr = row < ML ? F.in[IN_X] + (size_t)row * DM : F.in[IN_CTX] + (size_t)(row - ML) * DM;
        f32x4 x[4], h[4]; ld_row_f32(xr, F.lane, x);
        modulate_row(h, x, mods_ptr(F, 0, cond, 0), mods_ptr(F, 0, cond, 1), F.lane);
#if EIN_I8
        float am = 0.f;
#pragma unroll
        for (int j = 0; j < 4; ++j) am = fmaxf(fmaxf(am, fmaxf(fabsf(h[j][0]), fabsf(h[j][1]))), fmaxf(fabsf(h[j][2]), fabsf(h[j][3])));
#pragma unroll
        for (int o = 1; o < 64; o <<= 1) am = fmaxf(am, __shfl_xor(am, o));
        am = fmaxf(am, 1e-20f); const float qs = 127.f / am;
        unsigned char* H8 = F.ws + WS_H8;
#pragma unroll
        for (int j = 0; j < 4; ++j) *(unsigned*)(H8 + (size_t)row * DM + 4 * F.lane + 256 * j) = pk4_i8(h[j][0] * qs, h[j][1] * qs, h[j][2] * qs, h[j][3] * qs);
        if (F.lane == 0) ((float*)(F.ws + WS_SRS))[row] = am * (1.f / 127.f);
#else
        st_row_bf16(H + (size_t)row * DM, F.lane, h);
#endif
    }
}

__device__ __forceinline__ void p3_rope_conv(Frame& F) {
    bf16* P = (bf16*)(F.ws + WS_BIG); bf16* CAT = (bf16*)(F.ws + WS_CAT);
    const float* wc = F.in[IN_ECONV];
    const int lane = F.lane;
    for (int row = F.gw; row < MT; row += F.NGW) {
        bf16* pr = P + (size_t)row * E_IN;
        const int t = row < ML ? (row & 2047) : ((row - ML) & 255); const int Ls = row < ML ? SEQ : LC;
        const int ch = 8 * lane;
        float cv[3][8];
#pragma unroll
        for (int dt = 0; dt < 3; ++dt) {
            const int tt = t + dt - 1;
            if (tt >= 0 && tt < Ls) { const bf16* q = P + (size_t)(row + dt - 1) * E_IN; const u32x4 cg = *(const u32x4*)(q + 512 + ch), vl = *(const u32x4*)(q + 1024 + ch);
#pragma unroll
                for (int j = 0; j < 4; ++j) { cv[dt][2 * j] = bf_lo(cg[j]) * bf_lo(vl[j]); cv[dt][2 * j + 1] = bf_hi(cg[j]) * bf_hi(vl[j]); } }
            else {
#pragma unroll
                for (int j = 0; j < 8; ++j) cv[dt][j] = 0.f; }
        }
        const u32x4 bg = *(const u32x4*)(pr + ch);
        float w0[8], w1[8], w2[8];
#pragma unroll
        for (int j = 0; j < 8; ++j) { w0[j] = wc[ch + j]; w1[j] = wc[512 + ch + j]; w2[j] = wc[1024 + ch + j]; }
        float o[8];
#pragma unroll
        for (int j = 0; j < 8; ++j) { const float bgv = (j & 1) ? bf_hi(bg[j >> 1]) : bf_lo(bg[j >> 1]); o[j] = bgv * (cv[0][j] * w0[j] + cv[1][j] * w1[j] + cv[2][j] * w2[j]); }
        u32x4 w; w.x = pk2(o[0], o[1]); w.y = pk2(o[2], o[3]); w.z = pk2(o[4], o[5]); w.w = pk2(o[6], o[7]);
        *(u32x4*)(CAT + (size_t)row * DM + ch) = w;
    }
}

constexpr float ATT_THR = 8.f;
__device__ __forceinline__ int crow(int r, int hi) { return (r & 3) + 8 * (r >> 2) + 4 * hi; }
__device__ __forceinline__ s16x4 vtr(const LAS unsigned char* p) { return __builtin_bit_cast(s16x4, __builtin_amdgcn_ds_read_tr16_b64_v4i16((LAS s16x4*)p)); }
__device__ __forceinline__ float xhalf_max(float v) { return fmaxf(v, __shfl_xor(v, 32)); }
__device__ __forceinline__ bf16x8 pack8(const f32x16& p, int s) {
    u32x4 w; w.x = cvt_pk_bf16(p[8 * s + 0], p[8 * s + 1]); w.y = cvt_pk_bf16(p[8 * s + 2], p[8 * s + 3]); w.z = cvt_pk_bf16(p[8 * s + 4], p[8 * s + 5]); w.w = cvt_pk_bf16(p[8 * s + 6], p[8 * s + 7]);
    return __builtin_bit_cast(bf16x8, w);
}
__device__ __forceinline__ int koff(int row, int ch) { return row * 128 + ((ch ^ ((row >> 1) & 7)) << 4); }
__device__ __forceinline__ int voff128(int row, int ch) { return 256 * row + 16 * (ch ^ (((row & 3) << 2) | ((row >> 2) & 3))); }
__device__ __forceinline__ int voff64(int row, int ch) { return 128 * row + 16 * (ch ^ (((row >> 1) & 1) << 2)); }

__device__ __forceinline__ void p4_diff_attn(Frame& F) {
    const bf16* P = (const bf16*)(F.ws + WS_BIG); bf16* CAT = (bf16*)(F.ws + WS_CAT);
    const float lam = ((const float*)(F.ws + WS_MISC))[0];
    const float* subg = F.in[IN_SUBG];
    const int tid = F.tid, lane = F.lane, wave = F.wave, r32 = lane & 31, hi = lane >> 5;
    const int comp = wave >> 2, qb = wave & 3;
    LAS unsigned char* lds = F.lds;
    constexpr int STG = 32768;
    constexpr int NU_LAT = NB * 4 * 16, NU = NU_LAT + NB * 4 * 2;
    for (int un = F.vcu; un < NU; un += F.G) {
        int b, h, qrow0, j0, j1;
        if (un < NU_LAT) { b = un >> 6; h = (un >> 4) & 3; qrow0 = b * SEQ + (un & 15) * 128; j0 = 0; j1 = 36; }
        else { const int v = un - NU_LAT; b = v >> 3; h = (v >> 1) & 3; qrow0 = ML + b * LC + (v & 1) * 128; j0 = 0; j1 = 4; }
        bf16x8 qf[4];
        { const bf16* qp = P + (size_t)(qrow0 + qb * 32 + r32) * E_IN + 1536 + h * 128 + comp * 64 + hi * 8;
#pragma unroll
          for (int ds = 0; ds < 4; ++ds) qf[ds] = *(const bf16x8*)(qp + ds * 16); }
        f32x16 o[4];
#pragma unroll
        for (int e = 0; e < 4; ++e) o[e] = (f32x16){};
        float mref = 0.f; f32x16 negm = (f32x16){}; f32x16 lacc = (f32x16){};
        const bf16x8 ones = (bf16x8){0x3F80, 0x3F80, 0x3F80, 0x3F80, 0x3F80, 0x3F80, 0x3F80, 0x3F80};
        u32x4 sk1, sk2, sv[2];
        const int krow = tid >> 3, kch = tid & 7;
#define DA_LOAD(j) do { const int rowb = ((j) < 4) ? (ML + b * LC + (j) * 64) : (b * SEQ + ((j) - 4) * 64); \
            const bf16* kp = P + (size_t)(rowb + krow) * E_IN + 2048 + h * 128 + kch * 8; sk1 = *(const u32x4*)kp; sk2 = *(const u32x4*)(kp + 64); \
            _Pragma("unroll") for (int i = 0; i < 2; ++i) { const int idx = tid + 512 * i; sv[i] = *(const u32x4*)(P + (size_t)(rowb + (idx >> 4)) * E_IN + 2560 + h * 128 + (idx & 15) * 8); } } while (0)
#define DA_STORE(st) do { LAS unsigned char* sb = lds + (st) * STG; *(LAS u32x4*)(sb + koff(krow, kch)) = sk1; *(LAS u32x4*)(sb + 8192 + koff(krow, kch)) = sk2; \
            _Pragma("unroll") for (int i = 0; i < 2; ++i) { const int idx = tid + 512 * i; *(LAS u32x4*)(sb + 16384 + voff128(idx >> 4, idx & 15)) = sv[i]; } } while (0)
        __syncthreads();
        DA_LOAD(j0); DA_STORE(0);
        __syncthreads();
        for (int j = j0; j < j1; ++j) {
            const int st = (j - j0) & 1;
            if (j + 1 < j1) DA_LOAD(j + 1);
            const LAS unsigned char* kb_ = lds + st * STG + comp * 8192;
            const LAS unsigned char* vb_ = lds + st * STG + 16384;
            f32x16 p[2];
#pragma unroll
            for (int kb = 0; kb < 2; ++kb) { p[kb] = negm;
#pragma unroll
                for (int ds = 0; ds < 4; ++ds) { const bf16x8 kf = *(const LAS bf16x8*)(kb_ + koff(kb * 32 + r32, ds * 2 + hi)); p[kb] = __builtin_amdgcn_mfma_f32_32x32x16_bf16(kf, qf[ds], p[kb], 0, 0, 0); } }
            float mx = fmaxf(p[0][0], p[1][0]);
#pragma unroll
            for (int r = 1; r < 16; ++r) mx = fmaxf(fmaxf(mx, p[0][r]), p[1][r]);
            mx = xhalf_max(mx);
            if (__any(mx > ATT_THR)) {
                const float d = fmaxf(mx, 0.f), al = __builtin_amdgcn_exp2f(-d);
                mref += d;
#pragma unroll
                for (int r = 0; r < 16; ++r) { p[0][r] -= d; p[1][r] -= d; negm[r] = -mref; lacc[r] *= al; }
#pragma unroll
                for (int e = 0; e < 4; ++e) o[e] = o[e] * al;
            }
#pragma unroll
            for (int kb = 0; kb < 2; ++kb)
#pragma unroll
                for (int r = 0; r < 16; ++r) p[kb][r] = __builtin_amdgcn_exp2f(p[kb][r]);
#pragma unroll
            for (int kb = 0; kb < 2; ++kb)
#pragma unroll
                for (int s = 0; s < 2; ++s) { const bf16x8 pf = pack8(p[kb], s);
                    lacc = __builtin_amdgcn_mfma_f32_32x32x16_bf16(ones, pf, lacc, 0, 0, 0);
                    const int rb = kb * 32 + 16 * s + 4 * hi + ((lane & 15) >> 2);
#pragma unroll
                    for (int e = 0; e < 4; ++e) { const int c0 = 4 * e + 2 * ((lane >> 4) & 1) + ((lane & 3) >> 1);
                        const s16x4 lo = vtr(vb_ + voff128(rb, c0) + 8 * (lane & 1)), hh = vtr(vb_ + voff128(rb + 8, c0) + 8 * (lane & 1));
                        const bf16x8 vf = (bf16x8){lo[0], lo[1], lo[2], lo[3], hh[0], hh[1], hh[2], hh[3]};
                        o[e] = __builtin_amdgcn_mfma_f32_32x32x16_bf16(vf, pf, o[e], 0, 0, 0); } }
            if (j + 1 < j1) DA_STORE(st ^ 1);
            __syncthreads();
        }
        const float linv = 1.f / lacc[0];
        LAS float* X = (LAS float*)(lds + qb * 16384);
        if (comp == 1) {
#pragma unroll
            for (int e = 0; e < 4; ++e)
#pragma unroll
                for (int r = 0; r < 16; ++r) X[(e * 16 + r) * 64 + lane] = o[e][r] * linv; }
        __syncthreads();
        if (comp == 0) {
            float ss = 0.f;
#pragma unroll
            for (int e = 0; e < 4; ++e)
#pragma unroll
                for (int r = 0; r < 16; ++r) { const float v = o[e][r] * linv - lam * X[(e * 16 + r) * 64 + lane]; o[e][r] = v; ss += v * v; }
            ss += __shfl_xor(ss, 32);
            const float rn = rsqrtf(ss * (1.f / 128.f) + RMS_EPS) * 0.8f;
            bf16* op = CAT + (size_t)(qrow0 + qb * 32 + r32) * DM + 512 + h * 128;
#pragma unroll
            for (int e = 0; e < 4; ++e)
#pragma unroll
                for (int r4 = 0; r4 < 4; ++r4) { const int ec = 32 * e + 8 * r4 + 4 * hi; const f32x4 g = *(const f32x4*)(subg + ec);
                    u32x2 w; w.x = pk2(o[e][4 * r4] * rn * g[0], o[e][4 * r4 + 1] * rn * g[1]); w.y = pk2(o[e][4 * r4 + 2] * rn * g[2], o[e][4 * r4 + 3] * rn * g[3]);
                    *(u32x2*)(op + ec) = w; }
        }
#undef DA_LOAD
#undef DA_STORE
    }
    __syncthreads();
}

__device__ __forceinline__ void p11_na_attn(Frame& F) {
    const bf16* P2 = (const bf16*)(F.ws + WS_BIG); bf16* CAT = (bf16*)(F.ws + WS_CAT);
    const int lane = F.lane, wave = F.wave, r32 = lane & 31, hi = lane >> 5;
    {
        float* GN = (float*)(F.ws + WS_GN);
        for (int row = F.gw; row < ML; row += F.NGW) {
            const u32x4 w = *(const u32x4*)(P2 + (size_t)row * O_IN + 8 * lane);
            float v[8];
#pragma unroll
            for (int j = 0; j < 4; ++j) { v[2 * j] = bf_lo(w[j]); v[2 * j + 1] = bf_hi(w[j]); }
            float s = 0.f;
#pragma unroll
            for (int j = 0; j < 8; ++j) s += v[j];
#pragma unroll
            for (int o = 1; o < 16; o <<= 1) s += __shfl_xor(s, o);
            const float mean = s * (1.f / 128.f); float q = 0.f;
#pragma unroll
            for (int j = 0; j < 8; ++j) { const float d = v[j] - mean; q += d * d; }
#pragma unroll
            for (int o = 1; o < 16; o <<= 1) q += __shfl_xor(q, o);
            if ((lane & 15) == 0) { float* g = GN + ((size_t)(lane >> 4) * ML + row) * 2; g[0] = mean; g[1] = rsqrtf(q * (1.f / 128.f) + LN_EPS); }
        }
    }
    const bf16* BT = (const bf16*)(F.ws + WS_BT);
    __syncthreads();
    LAS unsigned char* vt = F.lds + wave * 8192;
    LAS float* cscr = (LAS float*)(wave < 7 ? F.lds + 65536 + wave * 8448 : F.lds + RSC_OFF + 4096);
    int cvk = 0;
    constexpr float NA_THR = 16.f;
    constexpr int NWU = NB * 32 * 8 * 2;
    for (int wu = F.vcu * NWAVES + wave; wu < NWU; wu += F.G * NWAVES) {
        const int qh = wu & 1, h = (wu >> 1) & 7, r = (wu >> 4) & 31, b = wu >> 9;
        const int rs = min(max(r - 4, 0), 24);
        const int qc = qh * 32 + r32;
        const int qrow = b * SEQ + r * 64 + qc;
        bf16x8 qf[4];
        { const bf16* qp = P2 + (size_t)qrow * O_IN + 512 + h * 64 + hi * 8;
#pragma unroll
          for (int ds = 0; ds < 4; ++ds) qf[ds] = *(const bf16x8*)(qp + ds * 16); }
        f32x16 o[2]; o[0] = (f32x16){}; o[1] = (f32x16){};
        float mref = 0.f, lrun = 0.f; bool anyref = false;
        bf16x8 kf[2][4], kn[2][4]; u32x4 vn[8];
#define NA_ROWB(j) (((j) < 8) ? (b * SEQ + (rs + (j)) * 64) : (ML + b * LC + ((j) - 8) * 64))
#define NA_LOADK(dst, j) do { const bf16* kp = P2 + (size_t)(NA_ROWB(j) + r32) * O_IN + 1024 + h * 64 + hi * 8; \
            _Pragma("unroll") for (int kb = 0; kb < 2; ++kb) _Pragma("unroll") for (int ds = 0; ds < 4; ++ds) dst[kb][ds] = *(const bf16x8*)(kp + (size_t)kb * 32 * O_IN + ds * 16); } while (0)
#define NA_LOADV(j) do { const bf16* vp = P2 + (size_t)NA_ROWB(j) * O_IN + 1536 + h * 64; \
            _Pragma("unroll") for (int i = 0; i < 8; ++i) { const int idx = lane + 64 * i; vn[i] = *(const u32x4*)(vp + (size_t)(idx >> 3) * O_IN + (idx & 7) * 8); } } while (0)
#define NA_STOREV() do { _Pragma("unroll") for (int i = 0; i < 8; ++i) { const int idx = lane + 64 * i; *(LAS u32x4*)(vt + voff64(idx >> 3, idx & 7)) = vn[i]; } } while (0)
        u32x4 bt[2][2], btn[2][2];
#define NA_LOADB(dst, j) do { const u32x4* bp_ = (const u32x4*)(BT + ((size_t)(((h * 15 + (rs + (j) - r + 7)) * 2 + qh) * 2) * 64 + lane) * 16); \
            _Pragma("unroll") for (int kb = 0; kb < 2; ++kb) { dst[kb][0] = bp_[kb * 128]; dst[kb][1] = bp_[kb * 128 + 1]; } } while (0)
        NA_LOADK(kf, 0); NA_LOADV(0); NA_LOADB(bt, 0); NA_STOREV();
        for (int j = 0; j < 12; ++j) {
            if (j + 1 < 12) { NA_LOADK(kn, j + 1); NA_LOADV(j + 1); if (j + 1 < 8) NA_LOADB(btn, j + 1); }
            f32x16 p[2];
#pragma unroll
            for (int kb = 0; kb < 2; ++kb) { p[kb] = (f32x16){};
#pragma unroll
                for (int ds = 0; ds < 4; ++ds) p[kb] = __builtin_amdgcn_mfma_f32_32x32x16_bf16(kf[kb][ds], qf[ds], p[kb], 0, 0, 0); }
            if (j < 8) {
#pragma unroll
                for (int kb = 0; kb < 2; ++kb)
#pragma unroll
                    for (int rr = 0; rr < 16; rr += 2) { const unsigned w = bt[kb][rr >> 3][(rr >> 1) & 3]; p[kb][rr] += bf_lo(w); p[kb][rr + 1] += bf_hi(w); } }
            if (anyref) {
#pragma unroll
                for (int rr = 0; rr < 16; ++rr) { p[0][rr] -= mref; p[1][rr] -= mref; } }
            float mx = fmaxf(p[0][0], p[1][0]);
#pragma unroll
            for (int rr = 1; rr < 16; ++rr) mx = fmaxf(fmaxf(mx, p[0][rr]), p[1][rr]);
            mx = xhalf_max(mx);
            if (__any(mx > NA_THR)) {
                const float d = fmaxf(mx, 0.f), al = __builtin_amdgcn_exp2f(-d);
                mref += d; anyref = true; lrun *= al;
#pragma unroll
                for (int rr = 0; rr < 16; ++rr) { p[0][rr] -= d; p[1][rr] -= d; }
                o[0] = o[0] * al; o[1] = o[1] * al;
            }
            float ps = 0.f;
#pragma unroll
            for (int kb = 0; kb < 2; ++kb)
#pragma unroll
                for (int rr = 0; rr < 16; ++rr) { const float e = __builtin_amdgcn_exp2f(p[kb][rr]); p[kb][rr] = e; ps += e; }
            lrun += ps;
#pragma unroll
            for (int kb = 0; kb < 2; ++kb)
#pragma unroll
                for (int s = 0; s < 2; ++s) { const bf16x8 pf = pack8(p[kb], s);
                    const int rb = kb * 32 + 16 * s + 4 * hi + ((lane & 15) >> 2);
#pragma unroll
                    for (int e = 0; e < 2; ++e) { const int c0 = 4 * e + 2 * ((lane >> 4) & 1) + ((lane & 3) >> 1);
                        const s16x4 lo = vtr(vt + voff64(rb, c0) + 8 * (lane & 1)), hh = vtr(vt + voff64(rb + 8, c0) + 8 * (lane & 1));
                        const bf16x8 vf = (bf16x8){lo[0], lo[1], lo[2], lo[3], hh[0], hh[1], hh[2], hh[3]};
                        o[e] = __builtin_amdgcn_mfma_f32_32x32x16_bf16(vf, pf, o[e], 0, 0, 0); } }
            if (j + 1 < 12) {
                NA_STOREV();
#pragma unroll
                for (int kb = 0; kb < 2; ++kb) {
#pragma unroll
                    for (int ds = 0; ds < 4; ++ds) kf[kb][ds] = kn[kb][ds];
                    bt[kb][0] = btn[kb][0]; bt[kb][1] = btn[kb][1]; }
            }
        }
        const float linv = 1.f / (lrun + __shfl_xor(lrun, 32));
        bf16* op = CAT + (size_t)qrow * DM + 512 + h * 64;
#pragma unroll
        for (int e = 0; e < 2; ++e)
#pragma unroll
            for (int r4 = 0; r4 < 4; ++r4) { const int ec = 32 * e + 8 * r4 + 4 * hi;
                u32x2 w; w.x = pk2(o[e][4 * r4] * linv, o[e][4 * r4 + 1] * linv); w.y = pk2(o[e][4 * r4 + 2] * linv, o[e][4 * r4 + 3] * linv);
                *(u32x2*)(op + ec) = w; }
#undef NA_LOADB
#undef NA_ROWB
#undef NA_LOADK
#undef NA_LOADV
#undef NA_STOREV
        conv_experts(F, cscr, cvk, cvk + 6); cvk += 6;
    }
    conv_experts(F, cscr, cvk, 1 << 20);
    __syncthreads();
}

template <int MODE>
__device__ __forceinline__ void ln_phase(Frame& F, int rlo, int rhi, int blo) {
    constexpr int LAYER = (MODE >= 15) ? 1 : 0, LNI = (MODE == 6) ? 0 : (MODE == 9) ? 1 : (MODE == 15) ? 2 : 3;
    constexpr int GI = (MODE == 6 || MODE == 15) ? 2 : 5;
    constexpr int HL = (MODE == 9) ? 1 : LAYER, HSH = (MODE == 9) ? 0 : 3, HSC = (MODE == 9) ? 1 : 4;
    const int lane = F.lane;
    const bf16* Y = (const bf16*)(F.ws + WS_Y); const bf16* YS = (const bf16*)(F.ws + WS_YS);
    bf16* H = (bf16*)(F.ws + WS_H); unsigned char* H8 = F.ws + WS_H8; float* XC = (float*)(F.ws + WS_XC);
    const int* TOK = (const int*)(F.ws + WS_TOK);
    LAS float* WR = (LAS float*)F.lds;
    LAS int* REC = (LAS int*)(F.lds + 32768 + F.wave * 2048);
    int rcnt = 0, nrec = 0;
    if (MODE == 15) {
        for (int i = F.tid; i < DM * 8; i += 512) { const int d = i >> 3, e = i & 7; const int l = (d & 255) >> 2, q = d & 3, j = d >> 8; WR[(((j * 4 + q) * 64 + l) << 3) + e] = F.in[IN_ROUTER][i]; }
        __syncthreads();
    }
    int pbase[8];
    if (MODE == 24) { const unsigned* cnt = (const unsigned*)(F.ws + WS_CTL) + CW_CNT; int a = 0;
#pragma unroll
        for (int e = 0; e < 8; ++e) { pbase[e] = a; a += (__builtin_amdgcn_readfirstlane((int)cnt[e]) + 255) >> 8; } }
    const int ngw_ = (F.G - blo) * NWAVES, gw_ = (F.vcu - blo) * NWAVES + F.wave;
    const int rpw = (((rhi - rlo) + ngw_ - 1) / ngw_ + 1) & ~1, run0 = (F.vcu >= blo) ? rlo + gw_ * rpw : rhi, rune = min(rhi, run0 + rpw);
    f32x4 lgv[4], lbv[4], g[4], sh[4], sc[4];
    ld_row_f32(F.in[IN_LNG] + LNI * DM, lane, lgv); ld_row_f32(F.in[IN_LNB] + LNI * DM, lane, lbv);
    bf16* const XB1 = (bf16*)((unsigned char*)F.out + 64 * MiB); bf16* const XB2 = (bf16*)F.out; bf16* const XB3 = (bf16*)(F.ws + WS_WEIN);
#define LN_LOADX(dst, row) do { if (MODE == 6) ld_row_f32((row) < ML ? F.in[IN_X] + (size_t)(row) * DM : F.in[IN_CTX] + (size_t)((row) - ML) * DM, lane, dst); \
        else if (MODE == 9) { if ((row) < ML) ld_row_bf16(XB1 + (size_t)(row) * DM, lane, dst); else ld_row_f32(XC + (size_t)((row) - ML) * DM, lane, dst); } \
        else if (MODE == 15) ld_row_bf16(XB2 + (size_t)(row) * DM, lane, dst); else ld_row_bf16(XB3 + (size_t)(row) * DM, lane, dst); } while (0)
    constexpr int NQ = (MODE == 6 || MODE == 9) ? 3 : 2;
    f32x4 xn[NQ][4]; u32x2 yn[NQ][4], yn2[2][4]; float pn0[2] = {0.f, 0.f}, pn1[2] = {0.f, 0.f};
    int tkn[2][6] = {{0, 0, 0, 0, 0, 0}, {0, 0, 0, 0, 0, 0}};
#define LN_LOADTOK(q, row) do { const int* tk_ = TOK + (size_t)(row) * 8; _Pragma("unroll") for (int q_ = 0; q_ < 6; ++q_) tkn[q][q_] = tk_[q_]; } while (0)
#define LN_LOADROW(q, row) do { LN_LOADX(xn[q], row); \
        if (MODE == 24) { int pb0_ = 0, pb1_ = 0; _Pragma("unroll") for (int e_ = 0; e_ < 8; ++e_) { pb0_ = (e_ == tkn[q][0]) ? pbase[e_] : pb0_; pb1_ = (e_ == tkn[q][2]) ? pbase[e_] : pb1_; } \
            const bf16* ya_ = YS + ((size_t)pb0_ * 256 + tkn[q][1]) * DM; const bf16* yb_ = YS + ((size_t)pb1_ * 256 + tkn[q][3]) * DM; pn0[q] = __builtin_bit_cast(float, tkn[q][4]); pn1[q] = __builtin_bit_cast(float, tkn[q][5]); \
            _Pragma("unroll") for (int j_ = 0; j_ < 4; ++j_) { yn[q][j_] = *(const u32x2*)(ya_ + 4 * lane + 256 * j_); yn2[q][j_] = *(const u32x2*)(yb_ + 4 * lane + 256 * j_); } } \
        else { _Pragma("unroll") for (int j_ = 0; j_ < 4; ++j_) yn[q][j_] = *(const u32x2*)(Y + (size_t)(row) * DM + 4 * lane + 256 * j_); } } while (0)
    for (int row0 = run0; row0 < rune; ) {
    const int cond = (MODE == 6 || MODE == 9) ? cond_of_row(row0) : (row0 >> 11);
    const int rowe = min(rune, row0 < ML ? min(ML, ((row0 >> 11) + 1) << 11) : MT);
    ld_row_f32(mods_ptr(F, LAYER, cond, GI), lane, g);
    if (MODE != 24) { ld_row_f32(mods_ptr(F, HL, cond, HSH), lane, sh); ld_row_f32(mods_ptr(F, HL, cond, HSC), lane, sc); }
#pragma unroll
    for (int q = 0; q < NQ; ++q) if (MODE == 24 && row0 + q < rowe) LN_LOADTOK(q, row0 + q);
#pragma unroll
    for (int q = 0; q < NQ; ++q) if (row0 + q < rowe) { LN_LOADROW(q, row0 + q); if (MODE == 24 && row0 + q + NQ < rowe) LN_LOADTOK(q, row0 + q + NQ); }
    for (int rowp = row0; rowp < rowe; rowp += NQ) {
#pragma unroll
      for (int q = 0; q < NQ; ++q) {
        const int row = rowp + q; if (row >= rowe) break;
        f32x4 x[4];
#pragma unroll
        for (int j = 0; j < 4; ++j) {
            f32x4 yv = (f32x4){bf_lo(yn[q][j].x), bf_hi(yn[q][j].x), bf_lo(yn[q][j].y), bf_hi(yn[q][j].y)};
            if (MODE == 24) { const f32x4 y2 = (f32x4){bf_lo(yn2[q][j].x), bf_hi(yn2[q][j].x), bf_lo(yn2[q][j].y), bf_hi(yn2[q][j].y)}; yv = pn0[q] * yv + pn1[q] * y2; }
            x[j] = ALPHA * xn[q][j] + g[j] * yv; }
        if (row + NQ < rowe) { LN_LOADROW(q, row + NQ); if (MODE == 24 && row + 2 * NQ < rowe) LN_LOADTOK(q, row + 2 * NQ); }
        float s = 0.f;
#pragma unroll
        for (int j = 0; j < 4; ++j) s += (x[j][0] + x[j][1]) + (x[j][2] + x[j][3]);
        const float mean = wave_sum(s) * (1.f / DM); float s2 = 0.f;
#pragma unroll
        for (int j = 0; j < 4; ++j) { x[j] = x[j] - mean; s2 += (x[j][0] * x[j][0] + x[j][1] * x[j][1]) + (x[j][2] * x[j][2] + x[j][3] * x[j][3]); }
        const float rstd = rsqrtf(wave_sum(s2) * (1.f / DM) + LN_EPS);
#pragma unroll
        for (int j = 0; j < 4; ++j) x[j] = x[j] * rstd * lgv[j] + lbv[j];
        if (MODE == 6) { if (row < ML) st_row_bf16(XB1 + (size_t)row * DM, lane, x); else st_row_f32(XC + (size_t)(row - ML) * DM, lane, x); }
        else if (MODE == 9) { if (row < ML) st_row_bf16(XB2 + (size_t)row * DM, lane, x); }
        else if (MODE == 15) st_row_bf16(XB3 + (size_t)row * DM, lane, x);
        else st_row_f32(F.out + (size_t)row * DM, lane, x);
        if (MODE == 24) continue;
        f32x4 h[4];
#pragma unroll
        for (int j = 0; j < 4; ++j) h[j] = x[j] * (1.f + sc[j]) + sh[j];
        float rinv = 1.f;
        if (MODE == 15 || (MODE == 6 && FFN_FP8 == 3) || (MODE == 9 && OIN_I8)) {
            float am = 0.f;
#pragma unroll
            for (int j = 0; j < 4; ++j) am = fmaxf(fmaxf(am, fmaxf(fabsf(h[j][0]), fabsf(h[j][1]))), fmaxf(fabsf(h[j][2]), fabsf(h[j][3])));
#pragma unroll
            for (int o = 1; o < 64; o <<= 1) am = fmaxf(am, __shfl_xor(am, o));
            am = fmaxf(am, 1e-20f); const float qs = 127.f / am; rinv = am * (1.f / 127.f);
#pragma unroll
            for (int j = 0; j < 4; ++j) *(unsigned*)(H8 + (size_t)row * DM + 4 * lane + 256 * j) = pk4_i8(h[j][0] * qs, h[j][1] * qs, h[j][2] * qs, h[j][3] * qs);
            if (MODE != 15 && lane == 0) ((float*)(F.ws + WS_SRS))[row] = rinv;
        } else if (MODE == 6 && FFN_FP8 == 1) {
#pragma unroll
            for (int j = 0; j < 4; ++j) *(unsigned*)(H8 + (size_t)row * DM + 4 * lane + 256 * j) = pk4_fp8(h[j][0] * S_ACT, h[j][1] * S_ACT, h[j][2] * S_ACT, h[j][3] * S_ACT);
        } else st_row_bf16(H + (size_t)row * DM, lane, h);
        if (MODE == 15) {
            asm volatile("" ::: "memory");
            float lg8[8];
#pragma unroll
            for (int e = 0; e < 8; ++e) lg8[e] = 0.f;
#pragma unroll
            for (int j = 0; j < 4; ++j)
#pragma unroll
                for (int q = 0; q < 4; ++q) { const LAS f32x4* wp = (const LAS f32x4*)(WR + (((j * 4 + q) * 64 + lane) << 3)); const f32x4 w0 = wp[0], w1 = wp[1]; const float hv = h[j][q];
#pragma unroll
                    for (int e = 0; e < 4; ++e) { lg8[e] += hv * w0[e]; lg8[4 + e] += hv * w1[e]; } }
#pragma unroll
            for (int e = 0; e < 8; ++e) lg8[e] = wave_sum(lg8[e]);
            int e0 = 0; float v0 = lg8[0];
#pragma unroll
            for (int e = 1; e < 8; ++e) if (lg8[e] > v0) { v0 = lg8[e]; e0 = e; }
            int e1 = -1; float v1 = -INFINITY;
#pragma unroll
            for (int e = 0; e < 8; ++e) if (e != e0 && lg8[e] > v1) { v1 = lg8[e]; e1 = e; }
            const float p1 = 1.f / (1.f + __expf(v0 - v1)), p0 = 1.f - p1;
            const int e0s = __builtin_amdgcn_readfirstlane(e0), e1s = __builtin_amdgcn_readfirstlane(e1);
            const int l0 = __builtin_amdgcn_readlane(rcnt, e0s), l1 = __builtin_amdgcn_readlane(rcnt, e1s);
            rcnt += (lane == e0s ? 1 : 0) + (lane == e1s ? 1 : 0);
            if (lane == 0) { LAS int* rc = REC + nrec * 8; rc[0] = row; rc[1] = e0s | (e1s << 8); rc[2] = l0; rc[3] = l1;
                rc[4] = __builtin_bit_cast(int, p0); rc[5] = __builtin_bit_cast(int, p1); rc[6] = __builtin_bit_cast(int, rinv); }
            ++nrec;
        }
      }
    }
    row0 = rowe; }
#undef LN_LOADX
#undef LN_LOADTOK
#undef LN_LOADROW
    if (MODE == 15) {
        unsigned* cnt = (unsigned*)(F.ws + WS_CTL) + CW_CNT; int* TOKW = (int*)(F.ws + WS_TOK); int* LIST = (int*)(F.ws + WS_LIST); float* SRS = (float*)(F.ws + WS_SRS);
        LAS int* WC = (LAS int*)(F.lds + 32768 + 16384);
        if (lane < 8) WC[F.wave * 8 + lane] = rcnt;
        __syncthreads();
        if (F.wave == 0 && lane < 8) { int tot = 0;
#pragma unroll
            for (int w = 0; w < NWAVES; ++w) tot += WC[w * 8 + lane];
            int b = tot > 0 ? (int)atomicAdd(cnt + lane, (unsigned)tot) : 0;
#pragma unroll
            for (int w = 0; w < NWAVES; ++w) { const int c = WC[w * 8 + lane]; WC[w * 8 + lane] = b; b += c; } }
        __syncthreads();
        const int base = lane < 8 ? WC[F.wave * 8 + lane] : 0;
        const bool act = lane < nrec; const LAS int* rc = REC + lane * 8;
        int row = 0, ee = 0, l0 = 0, l1 = 0, q0 = 0, q1 = 0, ri = 0;
        if (act) { row = rc[0]; ee = rc[1]; l0 = rc[2]; l1 = rc[3]; q0 = rc[4]; q1 = rc[5]; ri = rc[6]; }
        const int e0 = ee & 255, e1 = ee >> 8;
        const int pos0 = __shfl(base, e0) + l0, pos1 = __shfl(base, e1) + l1;
        if (act) { LIST[e0 * ML + pos0] = row; LIST[e1 * ML + pos1] = row;
            SRS[e0 * ML + pos0] = __builtin_bit_cast(float, ri); SRS[e1 * ML + pos1] = __builtin_bit_cast(float, ri);
            int* tk = TOKW + (size_t)row * 8; tk[0] = e0; tk[1] = pos0; tk[2] = e1; tk[3] = pos1; tk[4] = q0; tk[5] = q1; }
    }
    if (MODE == 15) __syncthreads();
}

struct MoeOrder {
    int cum[9]; int cnt[8]; int nM, nN, nwg, G, c; int gather; const int* list; unsigned long long bstep; int ocw; int split = 0;
    __device__ __forceinline__ void init(const unsigned* counts, int nN_, int G_, int c_, int gather_, const int* list_, int ldb, int ocw_) {
        int a = 0;
#pragma unroll
        for (int e = 0; e < 8; ++e) { cnt[e] = __builtin_amdgcn_readfirstlane((int)counts[e]); cum[e] = a; a += (cnt[e] + 255) >> 8; }
        cum[8] = a; nM = a;
        nN = nN_; nwg = nM * nN; G = G_; c = c_; gather = gather_; list = list_; bstep = (unsigned long long)256 * ldb; ocw = ocw_;
    }
    __device__ __forceinline__ bool next(int i, pg8::Unit& u) const {
        const long L = (long)i * G + c; int idx = (int)L, part = 0;
        if (!split) { if (L >= nwg) return false; }
        else { const int nfull = (nwg / G) * G, tail = nwg - nfull, sf = (tail * 4 <= G) ? 4 : (tail * 2 <= G) ? 2 : 1;
            if (L >= nfull) { const int j = (int)L - nfull; if (j >= tail * sf) return false; idx = nfull + j / sf; const int q = j % sf;
                part = (sf == 1) ? 0 : (sf == 2) ? (1 + q) : ((1 + (q & 1)) | ((1 + (q >> 1)) << 2)); } }
        int wgid = idx; { const int q = nwg / 8, r = nwg % 8, xcd = wgid % 8, off = wgid / 8; wgid = (xcd < r ? xcd * (q + 1) : r * (q + 1) + (xcd - r) * q) + off; }
        const int nig = 8 * nN, gid = wgid / nig, fm = gid * 8, gsz = (nM - fm) < 8 ? (nM - fm) : 8;
        const int pm = fm + ((wgid % nig) % gsz), pn = (wgid % nig) / gsz;
        int e = 0;
#pragma unroll
        for (int k = 1; k < 8; ++k) e += (pm >= cum[k]) ? 1 : 0;
        int ce = 0, cme = 0;
#pragma unroll
        for (int k = 0; k < 8; ++k) { ce = (k == e) ? cnt[k] : ce; cme = (k == e) ? cum[k] : cme; }
        u.pm = pm; u.pn = pn; u.aux = e | ((pm - cme) << 4) | (ce << 12);
        u.bofs = (unsigned long long)(e * nN + pn) * bstep;
        u.orow0 = pm * 256 + ((part & 3) == 2 ? 128 : 0); u.ocol0 = pn * ocw; u.part = part;
        return true;
    }
    __device__ __forceinline__ int arow(const pg8::Unit& u, int r) const {
        if (gather) { const int e = u.aux & 15, lp = (u.aux >> 4) & 255, ce = u.aux >> 12; const int idx = lp * 256 + r; return idx < ce ? list[e * ML + idx] : 0; }
        return u.pm * 256 + (((u.part & 3) == 2 ? r + 128 : r) & 255);
    }
};
struct CtxOrder {
    int vcu; unsigned long long bstep;
    __device__ __forceinline__ bool next(int i, pg8::Unit& u) const {
        if (i > 0 || vcu >= 64) return false;
        u.pm = ML / 256 + (vcu >> 2); u.pn = vcu & 3; u.orow0 = u.pm * 256; u.ocol0 = u.pn * 256; u.bofs = (unsigned long long)u.pn * bstep; u.aux = 0; return true;
    }
    __device__ __forceinline__ int arow(const pg8::Unit& u, int r) const { return u.pm * 256 + r; }
};
struct DftCOrder {
    int G, c;
    __device__ __forceinline__ bool next(int i, pg8::Unit& u) const {
        const int L = i * G + c; if (L >= 512) return false;
        u.pm = L & 3; u.pn = L >> 2; u.orow0 = 0; u.ocol0 = 0; u.aux = 0;
        u.bofs = ((unsigned long long)u.pn * 256 * O_IN + (u.pm >> 1) * 256) * 2; return true;
    }
    __device__ __forceinline__ int arow(const pg8::Unit& u, int r) const { return u.pm * 256 + r; }
};
struct DftLOrder {
    int G, vcu;
    __device__ __forceinline__ bool next(int i, pg8::Unit& u) const {
        const int L = i * G + vcu; if (L >= 256) return false;
        const int b = L >> 4; u.pm = (L >> 1) & 7; u.pn = L & 1; u.orow0 = b * SEQ + u.pm * 256; u.ocol0 = u.pn * 256; u.aux = 0;
        u.bofs = ((unsigned long long)(b * 512 + u.pn * 256) * 4096) * (DFTL_I8 ? 1 : 2); return true;
    }
    __device__ __forceinline__ int arow(const pg8::Unit& u, int r) const { return u.pm * 256 + r; }
};

constexpr int NPH = 19;
struct Args { const float* in[26]; float* out; unsigned char* ws; int ph_lo, ph_hi; int use_bar, bar_region; int skip_epi, pad2; };

__global__ void __launch_bounds__(NWAVES * 64, 2) fwd(Args args) {
    extern __shared__ __attribute__((aligned(16))) unsigned char lds_raw[];
    Frame F;
    F.lds = (LAS unsigned char*)lds_raw;
    F.tid = threadIdx.x; F.lane = F.tid & 63; F.wave = __builtin_amdgcn_readfirstlane(F.tid >> 6);
    F.G = gridDim.x; { const int bx = blockIdx.x; F.vcu = (F.G % 8 == 0) ? (bx % 8) * (F.G / 8) + bx / 8 : bx; }
    F.gw = F.vcu * NWAVES + F.wave; F.NGW = F.G * NWAVES;
#pragma unroll
    for (int i = 0; i < 26; ++i) F.in[i] = args.in[i];
    F.out = args.out; F.ws = args.ws;
    volatile LAS unsigned* MISC = (volatile LAS unsigned*)(F.lds + MISC_OFF);
    for (int u = F.tid; u < (LDS_BYTES - RING_BYTES) / 4; u += NWAVES * 64) ((LAS unsigned*)(F.lds + RING_BYTES))[u] = 0u;
    __syncthreads();
    unsigned* ctl = (unsigned*)(args.ws + WS_CTL);
    XcdBarrier bar; bar.bar = ctl + CW_BAR + args.bar_region * XCD_BAR_WORDS; bar.x = 0; bar.st = nullptr;
    if (args.use_bar) bar = xcd_barrier_post(ctl + CW_BAR + args.bar_region * XCD_BAR_WORDS, MISC + 8);
    const int lo = args.ph_lo, hi = args.ph_hi;
#ifdef PROBE_CLOCK
    const long long ck0 = clock64(); const long long wk0 = wall_clock64();
#endif
#ifndef PH_MASK
#define PH_MASK 0xffffffffu
#endif
#define IN(k) (((PH_MASK >> (k)) & 1u) && lo <= (k) && (k) < hi)
#define SEAM(k) do { if (IN(k) && IN((k) + 1)) xcd_barrier(bar); } while (0)
    bf16* const H = (bf16*)(F.ws + WS_H); bf16* const CAT = (bf16*)(F.ws + WS_CAT); bf16* const Y = (bf16*)(F.ws + WS_Y); bf16* const BIG = (bf16*)(F.ws + WS_BIG);

    if (IN(0)) { p0_prologue(F); SEAM(0); }
    if (IN(1)) { p1_modulate(F); SEAM(1); }
    if (IN(2)) {
#if EIN_I8
        pg8::Gemm g{F.ws + WS_H8, F.ws + WS_WEIN, DM, DM, DM, (const float*)(F.ws + WS_SRS)}; pg8::DenseOrder S; S.init(MT / 256, E_IN / 256, F.G, blockIdx.x, 256, DM);
        EpiRope E{BIG, E_IN, (const float*)(F.ws + WS_ROPE)}; pg8::gemm_phase<3>(F.lds, g, S, E); SEAM(2); }
#else
        pg8::Gemm g{H, F.ws + WS_WEIN, DM * 2, DM * 2, DM * 2}; pg8::DenseOrder S; S.init(MT / 256, E_IN / 256, F.G, blockIdx.x, 256, DM * 2);
        EpiRope E{BIG, E_IN, (const float*)(F.ws + WS_ROPE)}; pg8::gemm_phase<false>(F.lds, g, S, E); SEAM(2); }
#endif
    if (IN(3)) { p3_rope_conv(F); SEAM(3); }
    if (IN(4)) { p4_diff_attn(F); SEAM(4); }
    if (IN(5)) {
        pg8::Gemm g{CAT, F.ws + WS_WEO, DM * 2, DM * 2, DM * 2}; pg8::DenseOrder S; S.init(ML / 256, DM / 256, F.G, blockIdx.x, 256, DM * 2);
        EpiPlain E{Y, DM, 1.f}; pg8::gemm_phase<false>(F.lds, g, S, E); SEAM(5); }
    if (IN(6)) {
        if (F.vcu < 64) { pg8::Gemm g{CAT, F.ws + WS_WEO, DM * 2, DM * 2, DM * 2}; CtxOrder S{F.vcu, (unsigned long long)256 * DM * 2};
            EpiPlain E{Y, DM, 1.f}; pg8::gemm_phase<false>(F.lds, g, S, E); }
        ln_phase<6>(F, 0, ML, 64);
        xcd_barrier(bar);
        ln_phase<6>(F, ML, MT, 0); SEAM(6); }
#if FFN_FP8 == 3
    if (IN(7)) {
        pg8::Gemm g{F.ws + WS_H8, F.ws + WS_WGU, DM, DM, DM}; pg8::DenseOrder S; S.init(MT / 256, 2 * FF / 256, F.G, blockIdx.x, 128, DM);
        EpiSwigluI8<false> E{F.ws + WS_BIG, FF, (const float*)(F.ws + WS_SRS)}; pg8::gemm_phase<2>(F.lds, g, S, E); SEAM(7); }
#elif FFN_FP8 == 1
    if (IN(7)) {
        pg8::Gemm g{F.ws + WS_H8, F.ws + WS_WGU, DM, DM, DM}; pg8::DenseOrder S; S.init(MT / 256, 2 * FF / 256, F.G, blockIdx.x, 128, DM);
        EpiSwiglu8 E{F.ws + WS_BIG, FF, 1.f / (S_ACT * S_WGU)}; pg8::gemm_phase<true>(F.lds, g, S, E); SEAM(7); }
#elif FFN_FP8 == 2
    if (IN(7)) {
        pg8::Gemm g{H, F.ws + WS_WGU, DM * 2, DM * 2, DM * 2}; pg8::DenseOrder S; S.init(MT / 256, 2 * FF / 256, F.G, blockIdx.x, 128, DM * 2);
        EpiSwiglu8 E{F.ws + WS_BIG, FF, 1.f}; pg8::gemm_phase<false>(F.lds, g, S, E); SEAM(7); }
#else
    if (IN(7)) {
        pg8::Gemm g{H, F.ws + WS_WGU, DM * 2, DM * 2, DM * 2}; pg8::DenseOrder S; S.init(MT / 256, 2 * FF / 256, F.G, blockIdx.x, 128, DM * 2);
        EpiSwiglu E{BIG, FF}; pg8::gemm_phase<false>(F.lds, g, S, E); SEAM(7); }
#endif
#if FFN_FP8
    if (IN(8)) {
        pg8::Gemm g{F.ws + WS_BIG, F.ws + WS_WDN, FF, FF, FF}; pg8::DenseOrder S; S.init(ML / 256, DM / 256, F.G, blockIdx.x, 256, FF);
        EpiPlain E{Y, DM, 1.f / (S_HID * S_WDN)}; pg8::gemm_phase<true>(F.lds, g, S, E); SEAM(8); }
    if (IN(9)) {
        if (F.vcu < 64) { pg8::Gemm g{F.ws + WS_BIG, F.ws + WS_WDN, FF, FF, FF}; CtxOrder S{F.vcu, (unsigned long long)256 * FF};
            EpiPlain E{Y, DM, 1.f / (S_HID * S_WDN)}; pg8::gemm_phase<true>(F.lds, g, S, E); }
        ln_phase<9>(F, 0, ML, 64);
        xcd_barrier(bar);
        ln_phase<9>(F, ML, MT, 0); SEAM(9); }
#else
    if (IN(8)) {
        pg8::Gemm g{BIG, F.ws + WS_WDN, FF * 2, FF * 2, FF * 2}; pg8::DenseOrder S; S.init(ML / 256, DM / 256, F.G, blockIdx.x, 256, FF * 2);
        EpiPlain E{Y, DM, 1.f}; pg8::gemm_phase<false>(F.lds, g, S, E); SEAM(8); }
    if (IN(9)) {
        if (F.vcu < 64) { pg8::Gemm g{BIG, F.ws + WS_WDN, FF * 2, FF * 2, FF * 2}; CtxOrder S{F.vcu, (unsigned long long)256 * FF * 2};
            EpiPlain E{Y, DM, 1.f}; pg8::gemm_phase<false>(F.lds, g, S, E); }
        ln_phase<9>(F, 0, ML, 64);
        xcd_barrier(bar);
        ln_phase<9>(F, ML, MT, 0); SEAM(9); }
#endif
    if (IN(10)) {
#if OIN_I8
        pg8::Gemm g{F.ws + WS_H8, F.ws + WS_WOIN, DM, DM, DM, (const float*)(F.ws + WS_SRS)}; pg8::DenseOrder S; S.init(MT / 256, O_IN / 256, F.G, blockIdx.x, 256, DM);
        EpiPlain E{BIG, O_IN, 1.f, 0, 2, 4}; pg8::gemm_phase<3>(F.lds, g, S, E); SEAM(10); }
#else
        pg8::Gemm g{H, F.ws + WS_WOIN, DM * 2, DM * 2, DM * 2}; pg8::DenseOrder S; S.init(MT / 256, O_IN / 256, F.G, blockIdx.x, 256, DM * 2);
        EpiPlain E{BIG, O_IN, 1.f, 0, 2, 4}; pg8::gemm_phase<false>(F.lds, g, S, E); SEAM(10); }
#endif
    if (IN(11)) { p11_na_attn(F); SEAM(11); }
    if (IN(12)) {
        pg8::Gemm g{F.ws + WS_DFTC, BIG, 256 * 2, O_IN * 2, 256 * 2}; DftCOrder S{F.G, (int)blockIdx.x};
        EpiDftC E{Y, (const float*)(F.ws + WS_GN)}; pg8::gemm_phase<false>(F.lds, g, S, E); SEAM(12); }
    if (IN(13)) {
#if DFTL_I8
        pg8::Gemm g{F.ws + WS_DFTL, Y, 4096, 4096, 4096, nullptr, 1.f / (127.f * S_PQ)}; DftLOrder S{F.G, F.vcu};
        EpiPlain E{CAT, DM, 1.f / 512.f}; pg8::gemm_phase<4>(F.lds, g, S, E); SEAM(13); }
#else
        pg8::Gemm g{F.ws + WS_DFTL, Y, 4096 * 2, 4096 * 2, 4096 * 2}; DftLOrder S{F.G, F.vcu};
        EpiPlain E{CAT, DM, 1.f / 512.f}; pg8::gemm_phase<false>(F.lds, g, S, E); SEAM(13); }
#endif
    if (IN(14)) {
        pg8::Gemm g{CAT, F.ws + WS_WOO, DM * 2, DM * 2, DM * 2}; pg8::DenseOrder S; S.init(ML / 256, DM / 256, F.G, blockIdx.x, 256, DM * 2);
        EpiPlain E{Y, DM, 1.f}; pg8::gemm_phase<false>(F.lds, g, S, E);
        SEAM(14); }
    if (IN(15)) { ln_phase<15>(F, 0, ML, 0); SEAM(15); }
    if (IN(16)) {
        pg8::Gemm g{F.ws + WS_H8, F.ws + WS_EWGU, DM, DM, DM}; MoeOrder S; S.init((const unsigned*)ctl + CW_CNT, 2 * FFE / 256, F.G, blockIdx.x, 1, (const int*)(F.ws + WS_LIST), DM, 128);
#ifdef PROBE_FLATB
        if (args.skip_epi == 3) S.bstep = 0;
#endif
        EpiSwigluI8<true> E{F.ws + WS_BIG, FFE, (const float*)(F.ws + WS_SRS)}; pg8::gemm_phase<2>(F.lds, g, S, E); SEAM(16); }
    if (IN(17)) {
        pg8::Gemm g{F.ws + WS_BIG, F.ws + WS_EWDN, FFE, FFE, FFE}; MoeOrder S; S.init((const unsigned*)ctl + CW_CNT, DM / 256, F.G, blockIdx.x, 0, nullptr, FFE, 256);
        S.split = 1;
        EpiPlain E{(bf16*)(F.ws + WS_YS), DM, 1.f / (S_HID * S_WDN)}; pg8::gemm_phase_<1, true>(F.lds, g, S, E); SEAM(17); }
    if (IN(NPH - 1)) { ln_phase<24>(F, 0, ML, 0); }
#ifdef PROBE_CLOCK
    {
        xcd_barrier(bar);
        if (blockIdx.x == 0) {
            const long long ck1 = clock64(); const long long wk1 = wall_clock64();
            const float mhz = (float)(ck1 - ck0) / (float)(wk1 - wk0) * 100.f;
            const float cval = sqrtf(10.f * floorf(mhz / 250.f + 0.5f));
            for (size_t i = F.tid; i < (size_t)ML * DM; i += 512) F.out[i] = cval;
        }
    }
#endif
#undef IN
#undef SEAM
}

extern "C" void kernel_launch(void* const* d_in, const int* in_sizes, int n_in, void* d_out, int out_size, void* d_ws, size_t ws_size, hipStream_t stream) {
    static int grid = 0;
    if (grid == 0) {
        if (n_in != 26 || out_size != ML * DM || ws_size < WS_BT + 2 * MiB) { fprintf(stderr, "kernel_launch: unexpected problem (n_in %d out %d ws %zu)\n", n_in, out_size, ws_size); grid = -1; return; }
        int dev = 0, cus = 0;
        if (hipGetDevice(&dev) != hipSuccess || hipDeviceGetAttribute(&cus, hipDeviceAttributeMultiprocessorCount, dev) != hipSuccess) { grid = -1; return; }
        if (hipFuncSetAttribute((const void*)fwd, hipFuncAttributeMaxDynamicSharedMemorySize, LDS_BYTES) != hipSuccess) { grid = -1; return; }
        grid = cus;
    }
    if (grid < 0) return;
    (void)hipMemsetAsync((char*)d_ws + WS_CTL, 0, CTL_ZERO_BYTES, stream);
    Args a{};
    for (int i = 0; i < 26; ++i) a.in[i] = (const float*)d_in[i];
    a.out = (float*)d_out; a.ws = (unsigned char*)d_ws;
#if MK_LAUNCH_PER_PHASE
    a.use_bar = 1;
    for (int ph = 0; ph < NPH; ++ph) { a.ph_lo = ph; a.ph_hi = ph + 1; a.bar_region = ph; hipLaunchKernelGGL(fwd, dim3(grid), dim3(NWAVES * 64), LDS_BYTES, stream, a); }
#elif defined(PROBE_REPEAT)
    a.use_bar = 1; a.ph_lo = 0; a.ph_hi = PROBE_REPEAT; a.bar_region = 0;
    if (PROBE_REPEAT > 0) hipLaunchKernelGGL(fwd, dim3(grid), dim3(NWAVES * 64), LDS_BYTES, stream, a);
    a.ph_lo = PROBE_REPEAT; a.ph_hi = PROBE_REPEAT + 1; a.bar_region = 2;
#ifdef PROBE_SKIP_EPI
    a.skip_epi = 1;
#endif
#ifdef PROBE_FLAT
    a.skip_epi = 2;
#endif
#ifdef PROBE_FLATB
    a.skip_epi = 3;
#endif
    hipLaunchKernelGGL(fwd, dim3(grid), dim3(NWAVES * 64), LDS_BYTES, stream, a);
    a.skip_epi = 0;
    a.ph_lo = PROBE_REPEAT; a.ph_hi = NPH; a.bar_region = 1;
    hipLaunchKernelGGL(fwd, dim3(grid), dim3(NWAVES * 64), LDS_BYTES, stream, a);
#else
    a.use_bar = 1; a.ph_lo = 0; a.ph_hi = NPH;
    hipLaunchKernelGGL(fwd, dim3(grid), dim3(NWAVES * 64), LDS_BYTES, stream, a);
#endif
}
```

```cpp
#include <hip/hip_runtime.h>
#include <cstdio>
#include <cstdint>

#ifndef FFN_FP8
#define FFN_FP8 3
#endif
#ifndef OIN_I8
#define OIN_I8 1
#endif
#ifndef DFTL_I8
#define DFTL_I8 1
#endif
#ifndef EIN_I8
#define EIN_I8 1
#endif
#ifndef MK_LAUNCH_PER_PHASE
#define MK_LAUNCH_PER_PHASE 0
#endif

#define GAS __attribute__((address_space(1)))
#define LAS __attribute__((address_space(3)))
typedef unsigned short bf16;
typedef short bf16x8 __attribute__((ext_vector_type(8)));
typedef short s16x4 __attribute__((ext_vector_type(4)));
typedef float f32x4 __attribute__((ext_vector_type(4)));
typedef float f32x16 __attribute__((ext_vector_type(16)));
typedef unsigned u32x4 __attribute__((ext_vector_type(4)));
typedef unsigned u32x2 __attribute__((ext_vector_type(2)));

constexpr int NB = 16, SEQ = 2048, DM = 1024, LC = 256, GW = 64;
constexpr int ML = NB * SEQ;
constexpr int MC = NB * LC;
constexpr int MT = ML + MC;
constexpr int E_IN = 3072, FF = 2816, O_IN = 2048, NEXP = 8, FFE = 3584;
constexpr int NCOND = 17;
constexpr float LN_EPS = 1e-5f, RMS_EPS = 1e-5f;
constexpr float ALPHA = 1.41421356237309515f;

constexpr size_t MiB = 1u << 20;
constexpr size_t WS_CTL = 0, CTL_ZERO_BYTES = 2 * MiB;
constexpr size_t WS_MODS = 2 * MiB;
constexpr size_t WS_ROPE = 3 * MiB;
constexpr size_t WS_TOK  = 4 * MiB;
constexpr size_t WS_LIST = 5 * MiB;
constexpr size_t WS_GN   = 6 * MiB;
constexpr size_t WS_MISC = 7 * MiB;
constexpr size_t WS_WEIN = 8 * MiB;
constexpr size_t WS_WEO  = 14 * MiB;
constexpr size_t WS_WGU  = 16 * MiB;
constexpr size_t WS_WDN  = 27 * MiB;
constexpr size_t WS_WOIN = 33 * MiB;
constexpr size_t WS_WOO  = 37 * MiB;
constexpr size_t WS_DFTC = 39 * MiB;
constexpr size_t WS_DFTL = 40 * MiB;
constexpr size_t WS_XC   = 56 * MiB;
constexpr size_t WS_H    = 72 * MiB;
constexpr size_t WS_CAT  = 144 * MiB;
constexpr size_t WS_Y    = 216 * MiB;
constexpr size_t WS_YS   = 144 * MiB;
constexpr size_t WS_BIG  = 288 * MiB;
constexpr size_t WS_H8   = WS_H;
constexpr size_t WS_EWDN = WS_H + 32 * MiB;
constexpr size_t WS_EWGU = WS_BIG + 231 * MiB;
constexpr size_t WS_END  = WS_EWGU + 56 * MiB;
constexpr size_t WS_BT   = WS_END;
static_assert(WS_BT + 2 * MiB <= 589 * MiB, "workspace");
static_assert((size_t)264 * 256 * FFE <= 231 * MiB, "HID2");
static_assert(WS_EWDN + 28 * MiB <= WS_CAT, "EWDN inside the H region");
static_assert(WS_WEIN + 64 * MiB <= WS_H, "layer-1 X1 (bf16) overlays the small weights, the DFT tables and XC");
constexpr float S_ACT = 8.f, S_WGU = 256.f, S_HID = 8.f, S_WDN = 1024.f;
constexpr float S_WI8 = 1024.f;
constexpr float S_PQ = 127.f / 40.f;
constexpr size_t WS_SRS = WS_GN;

constexpr int CW_BAR = 4096;
constexpr int CW_CNT = 64;
constexpr int NWAVES = 8;
constexpr int RING_BYTES = 131072;
constexpr int MISC_OFF = RING_BYTES + 320;
constexpr int RSC_OFF = RING_BYTES + 1024;
constexpr int LDS_BYTES = 147456;

__device__ __forceinline__ unsigned f2bf(float f) { unsigned u = __builtin_bit_cast(unsigned, f); return (u + 0x7fffu + ((u >> 16) & 1u)) >> 16; }
__device__ __forceinline__ unsigned pk2(float lo, float hi) { return f2bf(lo) | (f2bf(hi) << 16); }
__device__ __forceinline__ unsigned cvt_pk_bf16(float lo, float hi) { unsigned r; asm volatile("v_cvt_pk_bf16_f32 %0, %1, %2" : "=v"(r) : "v"(lo), "v"(hi)); return r; }
__device__ __forceinline__ float bf_lo(unsigned w) { return __builtin_bit_cast(float, w << 16); }
__device__ __forceinline__ float bf_hi(unsigned w) { return __builtin_bit_cast(float, w & 0xffff0000u); }
__device__ __forceinline__ float wave_sum(float v) {
#pragma unroll
    for (int o = 1; o < 64; o <<= 1) v += __shfl_xor(v, o);
    return v;
}
__device__ __forceinline__ float silu_f(float g) { return g * __builtin_amdgcn_rcpf(1.f + __builtin_amdgcn_exp2f(g * -1.4426950408889634f)); }
__device__ __forceinline__ float clamp8(float v) { return __builtin_amdgcn_fmed3f(v, -448.f, 448.f); }
__device__ __forceinline__ unsigned pk4_fp8(float a, float b, float c, float d) {
    int p = __builtin_amdgcn_cvt_pk_fp8_f32(clamp8(a), clamp8(b), 0, false);
    p = __builtin_amdgcn_cvt_pk_fp8_f32(clamp8(c), clamp8(d), p, true);
    return (unsigned)p;
}

#define XB_TMO      128
#define XB_XCNT(j)  (256  + 64 * (j))
#define XB_XSUB(j)  (1280 + 64 * (j))
#define XB_XGEN(j)  (2304 + 64 * (j))
#define XB_TOP      3328
#define XB_TOPGEN   3392
#define XCD_BAR_WORDS 3456
#define XB_SPIN_CAP (1u << 18)
__device__ __forceinline__ unsigned xb_ld(unsigned* p)              { return __hip_atomic_load(p, __ATOMIC_RELAXED, __HIP_MEMORY_SCOPE_AGENT); }
__device__ __forceinline__ unsigned xb_add(unsigned* p, unsigned v) { return __hip_atomic_fetch_add(p, v, __ATOMIC_RELAXED, __HIP_MEMORY_SCOPE_AGENT); }
__device__ __forceinline__ unsigned xb_xcc_id() { return (unsigned)__builtin_amdgcn_s_getreg((3 << 11) | 20) & 0xFu; }
#define XB_SPIN(cond, bar) do { unsigned _sp = 0; while (cond) { __builtin_amdgcn_s_sleep(1); \
    if ((++_sp & 255u) == 0u) { if (xb_ld(&(bar)[XB_TMO])) break; if (_sp > XB_SPIN_CAP) { atomicAdd(&(bar)[XB_TMO], 1u); break; } } } } while (0)
struct XcdBarrier { unsigned* bar; unsigned x; volatile LAS unsigned* st; };
__device__ __forceinline__ XcdBarrier xcd_barrier_post(unsigned* bar, volatile LAS unsigned* st) {
    XcdBarrier b; b.bar = bar; b.x = xb_xcc_id(); b.st = st;
    if (threadIdx.x == 0) (void)xb_add(&bar[XB_XCNT(b.x)], 1u);
    return b;
}
__device__ __forceinline__ void xcd_barrier_complete(unsigned* bar, unsigned x, unsigned& nloc, unsigned& nx) {
    const unsigned G = gridDim.x * gridDim.y * gridDim.z;
    unsigned sum, cnt, mine, sp = 0u;
    for (;;) {
        sum = 0u; cnt = 0u; mine = 0u;
#pragma unroll
        for (unsigned j = 0; j < 16; ++j) { const unsigned c = xb_ld(&bar[XB_XCNT(j)]); sum += c; cnt += (c > 0u) ? 1u : 0u; mine = (j == x) ? c : mine; }
        if (sum == G) break;
        __builtin_amdgcn_s_sleep(1);
        if ((++sp & 255u) == 0u) { if (xb_ld(&bar[XB_TMO])) break; if (sp > XB_SPIN_CAP) { atomicAdd(&bar[XB_TMO], 1u); break; } }
    }
    nloc = mine > 0u ? mine : 1u; nx = cnt > 0u ? cnt : 1u;
}
__device__ __forceinline__ void xcd_barrier(const XcdBarrier& b) {
    asm volatile("s_waitcnt vmcnt(0)" ::: "memory");
    __syncthreads();
    if (threadIdx.x == 0) {
        unsigned* bar = b.bar;
        __builtin_amdgcn_s_waitcnt(0);
        unsigned nloc = b.st[0], nx = b.st[1];
        if (nloc == 0u) { xcd_barrier_complete(bar, b.x, nloc, nx); b.st[0] = nloc; b.st[1] = nx; }
        const unsigned old = xb_add(&bar[XB_XSUB(b.x)], 1u);
        const unsigned gen = old / nloc;
        if (old + 1u == (gen + 1u) * nloc) {
            __builtin_amdgcn_fence(__ATOMIC_RELEASE, "agent");
            asm volatile("s_waitcnt vmcnt(0)" ::: "memory");
            const unsigned og = xb_add(&bar[XB_TOP], 1u);
            const unsigned tg = og / nx;
            if (og + 1u == (tg + 1u) * nx) xb_add(&bar[XB_TOPGEN], 1u);
            else XB_SPIN(xb_ld(&bar[XB_TOPGEN]) == tg, bar);
            __builtin_amdgcn_fence(__ATOMIC_ACQUIRE, "agent");
            xb_add(&bar[XB_XGEN(b.x)], 1u);
            asm volatile("s_waitcnt vmcnt(0)" ::: "memory");
        } else {
            XB_SPIN(xb_ld(&bar[XB_XGEN(b.x)]) == gen, bar);
            __builtin_amdgcn_fence(__ATOMIC_ACQUIRE, "agent");
            asm volatile("s_waitcnt vmcnt(0)" ::: "memory");
        }
    }
    __syncthreads();
}

namespace pg8 {
constexpr int BM = 256, BK = 64, HALF = 128, HTB = HALF * BK * 2, STAGE_BYTES = 8 * HTB, NXCD = 8, WGM = 8;
__host__ __device__ __forceinline__ int lds_byte(int r, int c) { const int st = (r >> 4) * 2 + (c >> 5), rr = r & 15, cc = c & 31, ob = rr * 64 + cc * 2; return st * 1024 + (ob ^ (((ob >> 9) & 1) << 5)); }
__host__ __device__ __forceinline__ void stage_rc(int b, int& R, int& C) { const int st = b / 1024, sb = b % 1024, swz = sb ^ (((sb >> 9) & 1) << 5); R = (st >> 1) * 16 + swz / 64; C = (st & 1) * 32 + (swz % 64) / 2; }
__host__ __device__ __forceinline__ int perm32(int rho) { const int n = rho >> 4, i = rho & 15; return 8 * (i >> 2) + 4 * n + (i & 3); }

struct Unit { int pm, pn; int orow0, ocol0; unsigned long long bofs; int aux; int part = 0; };
struct Gemm { const void* A; const void* Bt; int lda, ldb, K; const float* rs = nullptr; float cs = 1.f; };

typedef int i32x8 __attribute__((ext_vector_type(8)));
typedef int i32x4 __attribute__((ext_vector_type(4)));
__device__ __forceinline__ i32x8 cat8(bf16x8 a, bf16x8 b) { const u32x4 x = __builtin_bit_cast(u32x4, a), y = __builtin_bit_cast(u32x4, b); return (i32x8){(int)x.x, (int)x.y, (int)x.z, (int)x.w, (int)y.x, (int)y.y, (int)y.z, (int)y.w}; }
template <int DT, bool SPLIT, class Epi, class Sched>
__device__ __forceinline__ void gemm_phase_(LAS unsigned char* lds, const Gemm g, const Sched& S, const Epi& E) {
    const int tid = threadIdx.x, wid = __builtin_amdgcn_readfirstlane(tid >> 6), lane = tid & 63, wr = wid >> 2, wc = wid & 3, fr = lane & 15, fq = lane >> 4;
    const int nt = g.K / (BK * 2);
    int Rr[2]; unsigned Cb[2], voffB[2];
#pragma unroll
    for (int i = 0; i < 2; ++i) { int R, C; stage_rc(tid * 16 + i * 8192, R, C); const int Rb = (R & ~31) + perm32(R & 31);
        Rr[i] = R; Cb[i] = (unsigned)C * 2u; voffB[i] = (unsigned)(Rb * g.ldb + C * 2); }
    const size_t kstep = (size_t)(BK * 2);
    const size_t hstepB = (size_t)HALF * g.ldb;
    const unsigned lda2 = (unsigned)g.lda;
    const unsigned ldsw = (unsigned)wid * 1024u;
    const int aoff = lds_byte(wr * 64 + fr, fq * 8), boff = lds_byte(wc * 32 + fr, fq * 8);
#define PG8_SA(b, h) (((b) * 2 + (h)) * HTB)
#define PG8_SB(b, h) ((4 + (b) * 2 + (h)) * HTB)
#define PG8_STAGE(bufoff, gbase, voff) do { _Pragma("unroll") for (int _i = 0; _i < 2; ++_i) \
        __builtin_amdgcn_global_load_lds((const unsigned*)((const char*)(gbase) + (voff)[_i]), (LAS unsigned*)(lds + (bufoff) + ldsw + _i * 8192), 16, 0, 0); } while (0)
#define PG8_LD16(p) (*(const LAS i32x4*)(p))
#define PG8_LDA(dst, b, h) do { _Pragma("unroll") for (int m = 0; m < 4; ++m) { const i32x4 x_ = PG8_LD16(lds + PG8_SA(b, h) + aoff + m * 2048), y_ = PG8_LD16(lds + PG8_SA(b, h) + aoff + m * 2048 + 1024); \
        dst[m] = (i32x8){x_.x, x_.y, x_.z, x_.w, y_.x, y_.y, y_.z, y_.w}; } } while (0)
#define PG8_LDB(dst, b, h) do { _Pragma("unroll") for (int n = 0; n < 2; ++n) { const i32x4 x_ = PG8_LD16(lds + PG8_SB(b, h) + boff + n * 2048), y_ = PG8_LD16(lds + PG8_SB(b, h) + boff + n * 2048 + 1024); \
        dst[n] = (i32x8){x_.x, x_.y, x_.z, x_.w, y_.x, y_.y, y_.z, y_.w}; } } while (0)
#define PG8_HALFI(v, k) ((k) == 0 ? (i32x4){v.s0, v.s1, v.s2, v.s3} : (i32x4){v.s4, v.s5, v.s6, v.s7})
#define PG8_HALF(v, k) __builtin_bit_cast(bf16x8, PG8_HALFI(v, k))
#define PG8_MMA(ai, bj, At, Bt) do { __builtin_amdgcn_s_setprio(1); _Pragma("unroll") for (int m = 0; m < 4; ++m) _Pragma("unroll") for (int n = 0; n < 2; ++n) { \
        if constexpr (DT == 1) { asm volatile("v_mfma_scale_f32_16x16x128_f8f6f4 %0, %1, %2, %0, %3, %3 op_sel_hi:[0,0,0]" : "+v"(acc[ai][bj][m][n]) : "v"(Bt[n]), "v"(At[m]), "v"(sc1)); } \
        } \
        if constexpr (DT != 1) { _Pragma("unroll") for (int k = 0; k < 2; ++k) _Pragma("unroll") for (int m = 0; m < 4; ++m) _Pragma("unroll") for (int n = 0; n < 2; ++n) { const i32x4 b_ = PG8_HALFI(Bt[n], k), a_ = PG8_HALFI(At[m], k); \
            if constexpr (DT >= 2) asm volatile("v_mfma_i32_16x16x64_i8 %0, %1, %2, %0" : "+v"(acc[ai][bj][m][n]) : "v"(b_), "v"(a_)); \
            else asm volatile("v_mfma_f32_16x16x32_bf16 %0, %1, %2, %0" : "+v"(acc[ai][bj][m][n]) : "v"(b_), "v"(a_)); } } \
        __builtin_amdgcn_s_setprio(0); } while (0)
#define PG8_WAIT_V(n) asm volatile("s_waitcnt vmcnt(" #n ")" ::: "memory")
#define PG8_WAIT_V8F(first) do { if ((first) && !SPLIT) asm volatile("s_waitcnt vmcnt(%0)" :: "n"(8 + Epi::NVM) : "memory"); else asm volatile("s_waitcnt vmcnt(8)" ::: "memory"); } while (0)
#define PG8_WAIT_L(n) asm volatile("s_waitcnt lgkmcnt(" #n ")" ::: "memory")
#define PG8_BAR __builtin_amdgcn_s_barrier()
#define PG8_SCHED __builtin_amdgcn_sched_barrier(0)
#define PG8_AOFF(dst, u) do { _Pragma("unroll") for (int _h = 0; _h < 2; ++_h) _Pragma("unroll") for (int _i = 0; _i < 2; ++_i) \
        dst[_h][_i] = (unsigned)S.arow(u, _h * HALF + Rr[_i]) * lda2 + Cb[_i]; } while (0)
    Unit cur, nxt; int ui = 0;
    if (!S.next(0, cur)) return;
    f32x4 acc[2][2][4][2];
    i32x8 At[4], B0[2], B1[2];
    const int sc1 = 0x7f7f7f7f;
    unsigned aoc[2][2], aon[2][2];
    PG8_AOFF(aoc, cur);
    const char* const Ab = (const char*)g.A;
    const char* cB = (const char*)g.Bt + cur.bofs;
    PG8_STAGE(PG8_SB(0, 0), cB, voffB); PG8_STAGE(PG8_SB(0, 1), cB + hstepB, voffB); PG8_STAGE(PG8_SA(0, 0), Ab, aoc[0]); PG8_STAGE(PG8_SA(0, 1), Ab, aoc[1]);
    if (wr == 1) PG8_BAR;
    PG8_WAIT_V(2); PG8_BAR;
    PG8_STAGE(PG8_SB(1, 0), cB + kstep, voffB); PG8_STAGE(PG8_SA(1, 0), Ab + kstep, aoc[0]); PG8_STAGE(PG8_SB(1, 1), cB + hstepB + kstep, voffB);
    PG8_WAIT_V(6); PG8_BAR;
#define PG8_RSC(i) __builtin_amdgcn_global_load_lds((const unsigned*)sp_, (LAS unsigned*)(lds + RSC_OFF + wr * 2048 + (i) * 256 - (((i) >> 2) * 512 + ((i) & 3) * 64)), 4, ((i) >> 2) * 512 + ((i) & 3) * 64, 0)
#define PG8_IF(c, x) do { if constexpr (SPLIT) { if (c) { x; } } else { x; } } while (0)
#define PG8_MMAZ(ai, bj, At, Bt) do { if constexpr (DT != 1) { __builtin_amdgcn_s_setprio(1); \
        _Pragma("unroll") for (int m = 0; m < 4; ++m) _Pragma("unroll") for (int n = 0; n < 2; ++n) { const i32x4 b_ = PG8_HALFI(Bt[n], 0), a_ = PG8_HALFI(At[m], 0); \
            if constexpr (DT >= 2) asm volatile("v_mfma_i32_16x16x64_i8 %0, %1, %2, 0" : "=&v"(acc[ai][bj][m][n]) : "v"(b_), "v"(a_)); \
            else asm volatile("v_mfma_f32_16x16x32_bf16 %0, %1, %2, 0" : "=&v"(acc[ai][bj][m][n]) : "v"(b_), "v"(a_)); } \
        _Pragma("unroll") for (int m = 0; m < 4; ++m) _Pragma("unroll") for (int n = 0; n < 2; ++n) { const i32x4 b_ = PG8_HALFI(Bt[n], 1), a_ = PG8_HALFI(At[m], 1); \
            if constexpr (DT >= 2) asm volatile("v_mfma_i32_16x16x64_i8 %0, %1, %2, %0" : "+v"(acc[ai][bj][m][n]) : "v"(b_), "v"(a_)); \
            else asm volatile("v_mfma_f32_16x16x32_bf16 %0, %1, %2, %0" : "+v"(acc[ai][bj][m][n]) : "v"(b_), "v"(a_)); } \
        __builtin_amdgcn_s_setprio(0); } else { PG8_MMA(ai, bj, At, Bt); } } while (0)
#define PG8_ZERO() do { if constexpr (DT == 1) { _Pragma("unroll") for (int a = 0; a < 2; ++a) _Pragma("unroll") for (int b = 0; b < 2; ++b) _Pragma("unroll") for (int m = 0; m < 4; ++m) _Pragma("unroll") for (int n = 0; n < 2; ++n) acc[a][b][m][n] = (f32x4){0.f, 0.f, 0.f, 0.f}; } } while (0)
#define PG8_BODY(t, MM) do { \
            const bool last = (t == nt - 2); \
            if constexpr (DT == 2 || DT == 3) if (last && wc == 0) { \
                const float* sp_; \
                if constexpr (DT == 3) sp_ = g.rs + cur.orow0 + wr * 64 + fr; else sp_ = E.scale_ptr(cur, wr, fr); \
                PG8_RSC(0); PG8_RSC(1); PG8_RSC(2); PG8_RSC(3); PG8_RSC(4); PG8_RSC(5); PG8_RSC(6); PG8_RSC(7); \
            } \
            const char* a1 = Ab + (size_t)(t + 1) * kstep; \
            const char* a2 = last ? Ab : Ab + (size_t)(t + 2) * kstep; const char* b2 = last ? nB : cB + (size_t)(t + 2) * kstep; \
            const char* a3 = a2 + kstep; const char* b3 = b2 + kstep; \
            unsigned ao2[2][2]; const unsigned lm_ = last ? 0xffffffffu : 0u; \
            _Pragma("unroll") \
            for (int h = 0; h < 2; ++h) \
            _Pragma("unroll") \
                for (int i = 0; i < 2; ++i) ao2[h][i] = (aon[h][i] & lm_) | (aoc[h][i] & ~lm_); \
            const bool fst = (t == 0) && (ui > 0); \
            PG8_IF(uB0, PG8_LDB(B0, 0, 0)); PG8_IF(uB1, PG8_LDB(B1, 0, 1)); PG8_SCHED; PG8_LDA(At, 0, 0); PG8_STAGE(PG8_SA(1, 1), a1, aoc[1]); \
            PG8_WAIT_V8F(fst); PG8_WAIT_L(0); PG8_BAR; PG8_IF(uB0, MM(0, 0, At, B0)); PG8_IF(uB1, MM(0, 1, At, B1)); PG8_BAR; PG8_SCHED; \
            PG8_IF(uA1, PG8_LDA(At, 0, 1)); PG8_STAGE(PG8_SB(0, 0), b2, voffB); PG8_STAGE(PG8_SB(0, 1), b2 + hstepB, voffB); PG8_STAGE(PG8_SA(0, 0), a2, ao2[0]); \
            PG8_WAIT_V8F(fst); PG8_WAIT_L(0); PG8_BAR; PG8_IF(uA1 && uB0, MM(1, 0, At, B0)); PG8_IF(uA1 && uB1, MM(1, 1, At, B1)); PG8_BAR; PG8_SCHED; \
            PG8_IF(uB0, PG8_LDB(B0, 1, 0)); PG8_IF(uB1, PG8_LDB(B1, 1, 1)); PG8_SCHED; PG8_LDA(At, 1, 0); PG8_STAGE(PG8_SA(0, 1), a2, ao2[1]); \
            PG8_WAIT_V(8); PG8_WAIT_L(0); PG8_BAR; PG8_IF(uB0, PG8_MMA(0, 0, At, B0)); PG8_IF(uB1, PG8_MMA(0, 1, At, B1)); PG8_BAR; PG8_SCHED; \
            PG8_IF(uA1, PG8_LDA(At, 1, 1)); PG8_STAGE(PG8_SB(1, 0), b3, voffB); PG8_STAGE(PG8_SB(1, 1), b3 + hstepB, voffB); PG8_STAGE(PG8_SA(1, 0), a3, ao2[0]); \
            PG8_WAIT_V(8); PG8_WAIT_L(0); PG8_BAR; PG8_IF(uA1 && uB0, PG8_MMA(1, 0, At, B0)); PG8_IF(uA1 && uB1, PG8_MMA(1, 1, At, B1)); PG8_BAR; PG8_SCHED; \
        } while (0)
    PG8_ZERO();
    for (;;) {
        const bool has_next = S.next(ui + 1, nxt);
        int pt_ = 0; if constexpr (SPLIT) pt_ = __builtin_amdgcn_readfirstlane(cur.part);
        const bool uB0 = ((pt_ >> 2) & 3) != 2, uB1 = ((pt_ >> 2) & 3) != 1, uA1 = (pt_ & 3) == 0;
        const char* nB = has_next ? (const char*)g.Bt + nxt.bofs : cB;
        if constexpr (Sched::GATH) {
            if (has_next) {
#pragma unroll
                for (int h = 0; h < 2; ++h)
#pragma unroll
                    for (int i = 0; i < 2; ++i) __builtin_amdgcn_global_load_lds((const unsigned*)S.gptr(nxt, h * HALF + Rr[i]), (LAS unsigned*)(lds + RSC_OFF + 4096 + wid * 1024 + (h * 2 + i) * 256), 4, 0, 0); }
        } else {
            if (has_next) { PG8_AOFF(aon, nxt); } else {
#pragma unroll
                for (int h = 0; h < 2; ++h)
#pragma unroll
                    for (int i = 0; i < 2; ++i) aon[h][i] = aoc[h][i]; } }
        PG8_BODY(0, PG8_MMAZ);
        if constexpr (Sched::GATH) {
#pragma unroll
            for (int h = 0; h < 2; ++h)
#pragma unroll
                for (int i = 0; i < 2; ++i) { const int row_ = *(const LAS int*)(lds + RSC_OFF + 4096 + wid * 1024 + (h * 2 + i) * 256 + lane * 4); aon[h][i] = has_next ? (unsigned)row_ * lda2 + Cb[i] : aoc[h][i]; }
        }
#pragma unroll 1
        for (int t = 2; t < nt; t += 2) PG8_BODY(t, PG8_MMA);
        if (wr == 0) PG8_BAR;
        float rsc[8];
        if constexpr (DT == 2 || DT == 3) {
#pragma unroll
            for (int i = 0; i < 8; ++i) rsc[i] = *(const LAS float*)(lds + RSC_OFF + wr * 2048 + i * 256 + lane * 4);
        }
        asm volatile("s_nop 15\n\ts_nop 15" : "+v"(acc[1][0][0][0]), "+v"(acc[1][0][0][1]), "+v"(acc[1][0][1][0]), "+v"(acc[1][0][1][1]), "+v"(acc[1][0][2][0]), "+v"(acc[1][0][2][1]), "+v"(acc[1][0][3][0]), "+v"(acc[1][0][3][1]),
                                              "+v"(acc[1][1][0][0]), "+v"(acc[1][1][0][1]), "+v"(acc[1][1][1][0]), "+v"(acc[1][1][1][1]), "+v"(acc[1][1][2][0]), "+v"(acc[1][1][2][1]), "+v"(acc[1][1][3][0]), "+v"(acc[1][1][3][1]));
        if constexpr (DT == 4) {
#pragma unroll
            for (int a = 0; a < 2; ++a)
#pragma unroll
                for (int b = 0; b < 2; ++b)
#pragma unroll
                    for (int m = 0; m < 4; ++m)
#pragma unroll
                        for (int n = 0; n < 2; ++n)
#pragma unroll
                            for (int j = 0; j < 4; ++j) { const float f_ = acc[a][b][m][n][j]; acc[a][b][m][n][j] = (float)__builtin_bit_cast(int, f_) * g.cs; }
        }
        if constexpr (DT == 3) {
#pragma unroll
            for (int a = 0; a < 2; ++a)
#pragma unroll
                for (int m = 0; m < 4; ++m) { const float sc = rsc[a * 4 + m] * (1.f / S_WI8);
#pragma unroll
                    for (int b = 0; b < 2; ++b)
#pragma unroll
                        for (int n = 0; n < 2; ++n)
#pragma unroll
                            for (int j = 0; j < 4; ++j) { const float f_ = acc[a][b][m][n][j]; acc[a][b][m][n][j] = (float)__builtin_bit_cast(int, f_) * sc; } }
        }
        if constexpr (DT == 2) E(acc, cur, wr, wc, fr, fq, rsc); else E(acc, cur, wr, wc, fr, fq);
        if (!has_next) break;
        PG8_ZERO();
        cur = nxt; cB = nB; ++ui;
#pragma unroll
        for (int h = 0; h < 2; ++h)
#pragma unroll
            for (int i = 0; i < 2; ++i) aoc[h][i] = aon[h][i];
        if (wr == 1) PG8_BAR;
    }
    PG8_WAIT_V(0);
    PG8_BAR;
#undef PG8_SA
#undef PG8_SB
#undef PG8_STAGE
#undef PG8_LDA
#undef PG8_LD16
#undef PG8_HALF
#undef PG8_HALFI
#undef PG8_LDB
#undef PG8_MMA
#undef PG8_MMAZ
#undef PG8_ZERO
#undef PG8_BODY
#undef PG8_RSC
#undef PG8_IF
#undef PG8_WAIT_V
#undef PG8_WAIT_V8F
#undef PG8_WAIT_L
#undef PG8_BAR
#undef PG8_SCHED
#undef PG8_AOFF
}
template <int DT, class Epi, class Sched>
__device__ __forceinline__ void gemm_phase(LAS unsigned char* lds, const Gemm g, const Sched& S, const Epi& E) { gemm_phase_<DT, false>(lds, g, S, E); }

struct DenseOrder {
    static constexpr int GATH = 0;
    int flat = 0; int nM, nN, nwg, G, c; int ocw; unsigned long long bstep;
    __device__ __forceinline__ void init(int nM_, int nN_, int G_, int c_, int ocw_, int ldb) { nM = nM_; nN = nN_; nwg = nM * nN; G = G_; c = c_; ocw = ocw_; bstep = (unsigned long long)BM * ldb; }
    __device__ __forceinline__ bool next(int i, Unit& u) const {
        const long L = (long)i * G + c; if (L >= nwg) return false;
        int wgid = (int)L; { const int q = nwg / NXCD, r = nwg % NXCD, xcd = wgid % NXCD, off = wgid / NXCD; wgid = (xcd < r ? xcd * (q + 1) : r * (q + 1) + (xcd - r) * q) + off; }
        const int nig = WGM * nN, gid = wgid / nig, fm = gid * WGM, gsz = (nM - fm) < WGM ? (nM - fm) : WGM;
        u.pm = fm + ((wgid % nig) % gsz); u.pn = (wgid % nig) / gsz;
        if (flat) { u.pm = 0; u.pn = 0; }
        u.orow0 = u.pm * BM; u.ocol0 = u.pn * ocw; u.bofs = (unsigned long long)u.pn * bstep; u.aux = 0; return true;
    }
    __device__ __forceinline__ int arow(const Unit& u, int r) const { return u.pm * BM + r; }
};
}

__device__ __forceinline__ unsigned pk4_i8(float a, float b, float c, float d) {
    const int ia = (int)__builtin_amdgcn_fmed3f(__builtin_rintf(a), -127.f, 127.f), ib = (int)__builtin_amdgcn_fmed3f(__builtin_rintf(b), -127.f, 127.f);
    const int ic = (int)__builtin_amdgcn_fmed3f(__builtin_rintf(c), -127.f, 127.f), id = (int)__builtin_amdgcn_fmed3f(__builtin_rintf(d), -127.f, 127.f);
    return (unsigned)(ia & 255) | ((unsigned)(ib & 255) << 8) | ((unsigned)(ic & 255) << 16) | ((unsigned)id << 24);
}
constexpr float QK_C2 = 0.125f * 1.4426950408889634f;
struct EpiPlain {
    static constexpr int NVM = 16;
    bf16* O; int ldc; float scale; int skip = 0; int qlo = 0, qhi = 0;
    __device__ __forceinline__ void operator()(const f32x4 (&acc)[2][2][4][2], const pg8::Unit& u, int wr, int wc, int fr, int fq) const {
        const float sc = (u.pn >= qlo && u.pn < qhi) ? scale * QK_C2 : scale;
        const int row0 = u.orow0 + wr * 64 + fr, col0 = u.ocol0 + wc * 32 + 8 * fq;
#pragma unroll
        for (int ai = 0; ai < 2; ++ai)
#pragma unroll
            for (int m = 0; m < 4; ++m) { bf16* rowp = O + (size_t)(row0 + ai * 128 + m * 16) * ldc + col0;
                if (ai == 1 && (u.part & 3)) continue;
#pragma unroll
                for (int bj = 0; bj < 2; ++bj) { const f32x4 v0 = acc[ai][bj][m][0] * sc, v1 = acc[ai][bj][m][1] * sc;
                    if (((u.part >> 2) & 3) == 2 - bj) continue;
                    u32x4 w; w.x = cvt_pk_bf16(v0[0], v0[1]); w.y = cvt_pk_bf16(v0[2], v0[3]); w.z = cvt_pk_bf16(v1[0], v1[1]); w.w = cvt_pk_bf16(v1[2], v1[3]);
                    *(u32x4*)(rowp + bj * 128) = w; } }
    }
};
struct EpiRope {
    static constexpr int NVM = 16;
    bf16* O; int ldc; const float* rope;
    __device__ __forceinline__ void operator()(const f32x4 (&acc)[2][2][4][2], const pg8::Unit& u, int wr, int wc, int fr, int fq) const {
        const int row0 = u.orow0 + wr * 64 + fr, col0 = u.ocol0 + wc * 32 + 8 * fq;
        const bool isq = (u.pn == 6 || u.pn == 7), isqk = (u.pn >= 6 && u.pn <= 9), lat = u.orow0 < ML;
        const float sc = isq ? QK_C2 : 1.f;
        const int i0 = 16 * (wc & 1) + 4 * fq;
        if (isqk) {
            f32x4 csv[8][2];
#pragma unroll
            for (int i = 0; i < 8; ++i) { const int row = row0 + (i >> 2) * 128 + (i & 3) * 16; const float* rp = rope + ((size_t)(lat ? (row & 2047) : 0) * 32 + i0) * 2; csv[i][0] = *(const f32x4*)rp; csv[i][1] = *(const f32x4*)(rp + 4); }
            if (!lat) {
#pragma unroll
                for (int i = 0; i < 8; ++i) { csv[i][0] = (f32x4){1.f, 0.f, 1.f, 0.f}; csv[i][1] = csv[i][0]; } }
#pragma unroll
            for (int ai = 0; ai < 2; ++ai)
#pragma unroll
                for (int m = 0; m < 4; ++m) { const int row = row0 + ai * 128 + m * 16; bf16* rowp = O + (size_t)row * ldc + col0;
                    const f32x4 cs0 = csv[ai * 4 + m][0], cs1 = csv[ai * 4 + m][1];
#pragma unroll
                    for (int bj = 0; bj < 2; ++bj) { const f32x4 v0 = acc[ai][bj][m][0] * sc, v1 = acc[ai][bj][m][1] * sc;
                        u32x4 w;
                        w.x = cvt_pk_bf16(v0[0] * cs0[0] - v0[1] * cs0[1], v0[0] * cs0[1] + v0[1] * cs0[0]); w.y = cvt_pk_bf16(v0[2] * cs0[2] - v0[3] * cs0[3], v0[2] * cs0[3] + v0[3] * cs0[2]);
                        w.z = cvt_pk_bf16(v1[0] * cs1[0] - v1[1] * cs1[1], v1[0] * cs1[1] + v1[1] * cs1[0]); w.w = cvt_pk_bf16(v1[2] * cs1[2] - v1[3] * cs1[3], v1[2] * cs1[3] + v1[3] * cs1[2]);
                        *(u32x4*)(rowp + bj * 128) = w; } }
        } else {
#pragma unroll
            for (int ai = 0; ai < 2; ++ai)
#pragma unroll
                for (int m = 0; m < 4; ++m) { bf16* rowp = O + (size_t)(row0 + ai * 128 + m * 16) * ldc + col0;
#pragma unroll
                    for (int bj = 0; bj < 2; ++bj) { const f32x4 v0 = acc[ai][bj][m][0], v1 = acc[ai][bj][m][1];
                        u32x4 w; w.x = cvt_pk_bf16(v0[0], v0[1]); w.y = cvt_pk_bf16(v0[2], v0[3]); w.z = cvt_pk_bf16(v1[0], v1[1]); w.w = cvt_pk_bf16(v1[2], v1[3]);
                        *(u32x4*)(rowp + bj * 128) = w; } }
        }
    }
};
struct EpiSwiglu {
    static constexpr int NVM = 8;
    bf16* O; int ldc;
    __device__ __forceinline__ void operator()(const f32x4 (&acc)[2][2][4][2], const pg8::Unit& u, int wr, int wc, int fr, int fq) const {
        const int row0 = u.orow0 + wr * 64 + fr, col0 = u.ocol0 + wc * 32 + 8 * fq;
#pragma unroll
        for (int ai = 0; ai < 2; ++ai)
#pragma unroll
            for (int m = 0; m < 4; ++m) { bf16* rowp = O + (size_t)(row0 + ai * 128 + m * 16) * ldc + col0;
                float r[8];
#pragma unroll
                for (int n = 0; n < 2; ++n)
#pragma unroll
                    for (int j = 0; j < 4; ++j) { const float gt = acc[ai][0][m][n][j], up = acc[ai][1][m][n][j]; r[n * 4 + j] = silu_f(gt) * up; }
                u32x4 w; w.x = cvt_pk_bf16(r[0], r[1]); w.y = cvt_pk_bf16(r[2], r[3]); w.z = cvt_pk_bf16(r[4], r[5]); w.w = cvt_pk_bf16(r[6], r[7]);
                *(u32x4*)rowp = w; }
    }
};
struct EpiSwiglu8 {
    static constexpr int NVM = 8;
    unsigned char* O; int ldc; float inv;
    __device__ __forceinline__ void operator()(const f32x4 (&acc)[2][2][4][2], const pg8::Unit& u, int wr, int wc, int fr, int fq) const {
        const int row0 = u.orow0 + wr * 64 + fr, col0 = u.ocol0 + wc * 32 + 8 * fq;
        const float c1 = -inv * 1.4426950408889634f, c2 = inv * inv * S_HID;
#pragma unroll
        for (int ai = 0; ai < 2; ++ai)
#pragma unroll
            for (int m = 0; m < 4; ++m) { unsigned char* rowp = O + (size_t)(row0 + ai * 128 + m * 16) * ldc + col0;
                float r[8];
#pragma unroll
                for (int n = 0; n < 2; ++n)
#pragma unroll
                    for (int j = 0; j < 4; ++j) { const float ag = acc[ai][0][m][n][j], au = acc[ai][1][m][n][j];
                        r[n * 4 + j] = (ag * au) * __builtin_amdgcn_rcpf(1.f + __builtin_amdgcn_exp2f(ag * c1)) * c2; }
                u32x2 w; w.x = pk4_fp8(r[0], r[1], r[2], r[3]); w.y = pk4_fp8(r[4], r[5], r[6], r[7]);
                *(u32x2*)rowp = w; }
    }
};
template <bool MOE>
struct EpiSwigluI8 {
    static constexpr int NVM = 8;
    unsigned char* O; int ldc; const float* srs;
    __device__ __forceinline__ const float* scale_ptr(const pg8::Unit& u, int wr, int fr) const {
        return srs + (MOE ? (size_t)(u.aux & 15) * ML + ((u.aux >> 4) & 255) * 256 : (size_t)u.orow0) + wr * 64 + fr; }
    __device__ __forceinline__ void operator()(const f32x4 (&acc)[2][2][4][2], const pg8::Unit& u, int wr, int wc, int fr, int fq, const float (&rsc)[8]) const {
        const int row0 = u.orow0 + wr * 64 + fr, col0 = u.ocol0 + wc * 32 + 8 * fq;
#pragma unroll
        for (int ai = 0; ai < 2; ++ai)
#pragma unroll
            for (int m = 0; m < 4; ++m) { unsigned char* rowp = O + (size_t)(row0 + ai * 128 + m * 16) * ldc + col0;
                const float inv = rsc[ai * 4 + m] * (1.f / S_WI8);
                const float c1 = -inv * 1.4426950408889634f, c2 = inv * inv * S_HID;
                float r[8];
                typedef float f32x2_ __attribute__((ext_vector_type(2)));
#pragma unroll
                for (int n = 0; n < 2; ++n)
#pragma unroll
                    for (int j = 0; j < 4; j += 2) { const float fg0 = acc[ai][0][m][n][j], fu0 = acc[ai][1][m][n][j], fg1 = acc[ai][0][m][n][j + 1], fu1 = acc[ai][1][m][n][j + 1];
                        const f32x2_ ag = (f32x2_){(float)__builtin_bit_cast(int, fg0), (float)__builtin_bit_cast(int, fg1)}, au = (f32x2_){(float)__builtin_bit_cast(int, fu0), (float)__builtin_bit_cast(int, fu1)};
                        const f32x2_ t = ag * c1; const f32x2_ d = (f32x2_){__builtin_amdgcn_exp2f(t.x), __builtin_amdgcn_exp2f(t.y)} + 1.f;
                        const f32x2_ q = (f32x2_){__builtin_amdgcn_rcpf(d.x), __builtin_amdgcn_rcpf(d.y)};
                        const f32x2_ v = (ag * q) * (au * c2);
                        r[n * 4 + j] = v.x; r[n * 4 + j + 1] = v.y; }
                u32x2 w; w.x = pk4_fp8(r[0], r[1], r[2], r[3]); w.y = pk4_fp8(r[4], r[5], r[6], r[7]);
                *(u32x2*)rowp = w; }
    }
};
struct EpiDftC {
    static constexpr int NVM = 16;
    bf16* PQt; const float* gn;
    __device__ __forceinline__ void operator()(const f32x4 (&acc)[2][2][4][2], const pg8::Unit& u, int wr, int wc, int fr, int fq) const {
        const int gi = u.pm, jrow = wr * 64 + fr;
        const int tok0 = u.pn * 256 + wc * 32 + 8 * fq;
#pragma unroll
        for (int bj = 0; bj < 2; ++bj) {
            const int tk = tok0 + bj * 128; const int b = tk >> 11, l = tk & 2047;
            bf16* base = PQt + ((size_t)(b * 512 + gi * 128 + jrow)) * 4096 + l;
            float mu[8], rs[8];
            { const f32x4* p = (const f32x4*)(gn + ((size_t)gi * ML + tk) * 2);
#pragma unroll
              for (int j = 0; j < 4; ++j) { const f32x4 t = p[j]; mu[2 * j] = t[0]; rs[2 * j] = t[1]; mu[2 * j + 1] = t[2]; rs[2 * j + 1] = t[3]; } }
#pragma unroll
            for (int ai = 0; ai < 2; ++ai) {
#pragma unroll
                for (int m = 0; m < 4; ++m) {
                    const float dc = (ai == 0 && m == 0 && jrow == 0) ? 128.f : 0.f;
                    float r[8];
#pragma unroll
                    for (int n = 0; n < 2; ++n)
#pragma unroll
                        for (int j = 0; j < 4; ++j) r[n * 4 + j] = rs[n * 4 + j] * (acc[ai][bj][m][n][j] - mu[n * 4 + j] * dc);
#if DFTL_I8
                    u32x2 w; w.x = pk4_i8(r[0] * S_PQ, r[1] * S_PQ, r[2] * S_PQ, r[3] * S_PQ); w.y = pk4_i8(r[4] * S_PQ, r[5] * S_PQ, r[6] * S_PQ, r[7] * S_PQ);
                    *(u32x2*)((unsigned char*)PQt + ((size_t)(b * 512 + gi * 128 + jrow + m * 16)) * 4096 + l + ai * 2048) = w; }
#else
                    u32x4 w; w.x = cvt_pk_bf16(r[0], r[1]); w.y = cvt_pk_bf16(r[2], r[3]); w.z = cvt_pk_bf16(r[4], r[5]); w.w = cvt_pk_bf16(r[6], r[7]);
                    *(u32x4*)(base + (size_t)m * 16 * 4096 + ai * 2048) = w; }
#endif
                asm volatile("" ::: "memory"); }
        }
    }
};

struct Frame {
    LAS unsigned char* lds;
    int tid, lane, wave, G, vcu, gw, NGW;
    const float* in[26];
    float* out; unsigned char* ws;
};
#define IN_X 0
#define IN_C 1
#define IN_CTX 2
#define IN_CCTX 3
#define IN_WMOD 4
#define IN_BMOD 5
#define IN_LNG 6
#define IN_LNB 7
#define IN_EWIN 8
#define IN_ECONV 9
#define IN_LQ1 10
#define IN_LK1 11
#define IN_LQ2 12
#define IN_LK2 13
#define IN_SUBG 14
#define IN_EWO 15
#define IN_EGATE 16
#define IN_EUP 17
#define IN_EDOWN 18
#define IN_OWIN 19
#define IN_RPB 20
#define IN_OWO 21
#define IN_ROUTER 22
#define IN_XGATE 23
#define IN_XUP 24
#define IN_XDOWN 25

__device__ __forceinline__ const float* mods_ptr(const Frame& F, int layer, int cond, int which) { return (const float*)(F.ws + WS_MODS) + ((size_t)(layer * NCOND + cond) * 6 + which) * DM; }
__device__ __forceinline__ int cond_of_row(int row) { return row < ML ? (row >> 11) : NCOND - 1; }

__device__ __forceinline__ void conv_item(const float* W, int K, int N, bf16* WT, int mode, LAS float* scr, int item, int lane) {
    const int nblk = N / 32, kb = item / nblk, nb = item % nblk, k0 = 64 * kb, n0 = 32 * nb;
    { float v_[32];
#pragma unroll
      for (int i = 0; i < 32; ++i) v_[i] = W[(size_t)(k0 + 2 * i + (lane >> 5)) * N + n0 + (lane & 31)];
#pragma unroll
      for (int i = 0; i < 32; ++i) scr[(2 * i + (lane >> 5)) * 33 + (lane & 31)] = v_[i]; }
    asm volatile("s_waitcnt lgkmcnt(0)" ::: "memory");
    int d0 = n0, ds = 1;
    if (mode == 1 || mode == 2) d0 = (n0 >> 7) * 256 + (n0 & 127) + (mode == 2 ? 128 : 0);
    if (mode == 3 && n0 >= 1536 && n0 < 2560) { d0 = (n0 & ~63) + ((n0 >> 5) & 1); ds = 2; }
    const int c = lane & 7;
#pragma unroll
    for (int j = 0; j < 4; ++j) { const int n = (lane >> 3) + 8 * j; const LAS float* s = scr + (8 * c) * 33 + n;
        u32x4 o; o.x = pk2(s[0 * 33], s[1 * 33]); o.y = pk2(s[2 * 33], s[3 * 33]); o.z = pk2(s[4 * 33], s[5 * 33]); o.w = pk2(s[6 * 33], s[7 * 33]);
        *(u32x4*)(WT + (size_t)(d0 + n * ds) * K + k0 + 8 * c) = o; }
    asm volatile("s_waitcnt lgkmcnt(0)" ::: "memory");
}
template <bool I8 = false>
__device__ __forceinline__ void conv_item8(const float* W, int K, int N, unsigned char* WT, int mode, float scale, LAS float* scr, int item, int lane) {
    const int nblk = N / 32, kb = item / nblk, nb = item % nblk, k0 = 64 * kb, n0 = 32 * nb;
    { float v_[32];
#pragma unroll
      for (int i = 0; i < 32; ++i) v_[i] = W[(size_t)(k0 + 2 * i + (lane >> 5)) * N + n0 + (lane & 31)];
#pragma unroll
      for (int i = 0; i < 32; ++i) scr[(2 * i + (lane >> 5)) * 33 + (lane & 31)] = v_[i]; }
    asm volatile("s_waitcnt lgkmcnt(0)" ::: "memory");
    int d0 = n0, ds = 1;
    if (mode == 1 || mode == 2) d0 = (n0 >> 7) * 256 + (n0 & 127) + (mode == 2 ? 128 : 0);
    if (mode == 3 && n0 >= 1536 && n0 < 2560) { d0 = (n0 & ~63) + ((n0 >> 5) & 1); ds = 2; }
    const int c = lane & 7;
#pragma unroll
    for (int j = 0; j < 4; ++j) { const int n = (lane >> 3) + 8 * j; const LAS float* s = scr + (8 * c) * 33 + n;
        u32x2 o;
        if (I8) { o.x = pk4_i8(s[0 * 33] * scale, s[1 * 33] * scale, s[2 * 33] * scale, s[3 * 33] * scale); o.y = pk4_i8(s[4 * 33] * scale, s[5 * 33] * scale, s[6 * 33] * scale, s[7 * 33] * scale); }
        else { o.x = pk4_fp8(s[0 * 33] * scale, s[1 * 33] * scale, s[2 * 33] * scale, s[3 * 33] * scale); o.y = pk4_fp8(s[4 * 33] * scale, s[5 * 33] * scale, s[6 * 33] * scale, s[7 * 33] * scale); }
        *(u32x2*)(WT + (size_t)(d0 + n * ds) * K + k0 + 8 * c) = o; }
    asm volatile("s_waitcnt lgkmcnt(0)" ::: "memory");
}

__device__ __forceinline__ void p0_prologue(Frame& F) {
    const int tid = F.tid, lane = F.lane, wave = F.wave;
    if ((int)blockIdx.x < 192) {
        LAS float* S = (LAS float*)F.lds;
        LAS float* red = (LAS float*)(F.lds + 17 * 1024 * 4);
        for (int i = tid; i < NCOND * DM; i += 512) { const int j = i >> 10, k = i & 1023; const float v = (j < 16) ? F.in[IN_C][j * DM + k] : F.in[IN_CCTX][k]; S[i] = silu_f(v); }
        __syncthreads();
        const int item = blockIdx.x, layer = item / 96, n = (item % 96) * 64 + lane;
        const float* W = F.in[IN_WMOD] + (size_t)layer * DM * 6144;
        float acc[NCOND];
#pragma unroll
        for (int j = 0; j < NCOND; ++j) acc[j] = 0.f;
#pragma unroll 1
        for (int k0 = wave * 128; k0 < wave * 128 + 128; k0 += 32) {
            float wv[32];
#pragma unroll
            for (int i = 0; i < 32; ++i) wv[i] = W[(size_t)(k0 + i) * 6144 + n];
#pragma unroll
            for (int i = 0; i < 32; ++i)
#pragma unroll
                for (int j = 0; j < NCOND; ++j) acc[j] += S[j * DM + k0 + i] * wv[i]; }
#pragma unroll
        for (int j = 0; j < NCOND; ++j) red[(wave * NCOND + j) * 64 + lane] = acc[j];
        __syncthreads();
        for (int i = tid; i < NCOND * 64; i += 512) { const int j = i >> 6, l = i & 63; float s = 0.f;
#pragma unroll
            for (int w = 0; w < 8; ++w) s += red[(w * NCOND + j) * 64 + l];
            const int nn = (item % 96) * 64 + l;
            ((float*)(F.ws + WS_MODS))[(size_t)(layer * NCOND + j) * 6144 + nn] = s + F.in[IN_BMOD][layer * 6144 + nn]; }
        __syncthreads();
    }
    {
        LAS float* scr = (LAS float*)(F.lds + wave * 16384);
        constexpr int I_EIN = 16 * 96, I_EO = 16 * 32, I_G = 16 * 88, I_DN = 44 * 32, I_OIN = 16 * 64, I_OO = 16 * 32;
        constexpr int NIT = I_EIN + I_EO + 2 * I_G + I_DN + I_OIN + I_OO;
        for (int it = F.gw; it < NIT; it += F.NGW) {
            int r = it;
#if EIN_I8
            if (r < I_EIN) { conv_item8<true>(F.in[IN_EWIN], DM, E_IN, F.ws + WS_WEIN, 3, S_WI8, scr, r, lane); continue; } r -= I_EIN;
#else
            if (r < I_EIN) { conv_item(F.in[IN_EWIN], DM, E_IN, (bf16*)(F.ws + WS_WEIN), 3, scr, r, lane); continue; } r -= I_EIN;
#endif
            if (r < I_EO) { conv_item(F.in[IN_EWO], DM, DM, (bf16*)(F.ws + WS_WEO), 0, scr, r, lane); continue; } r -= I_EO;
#if FFN_FP8 == 3
            if (r < I_G) { conv_item8<true>(F.in[IN_EGATE], DM, FF, F.ws + WS_WGU, 1, S_WI8, scr, r, lane); continue; } r -= I_G;
            if (r < I_G) { conv_item8<true>(F.in[IN_EUP], DM, FF, F.ws + WS_WGU, 2, S_WI8, scr, r, lane); continue; } r -= I_G;
            if (r < I_DN) { conv_item8(F.in[IN_EDOWN], FF, DM, F.ws + WS_WDN, 0, S_WDN, scr, r, lane); continue; } r -= I_DN;
#elif FFN_FP8 == 1
            if (r < I_G) { conv_item8(F.in[IN_EGATE], DM, FF, F.ws + WS_WGU, 1, S_WGU, scr, r, lane); continue; } r -= I_G;
            if (r < I_G) { conv_item8(F.in[IN_EUP], DM, FF, F.ws + WS_WGU, 2, S_WGU, scr, r, lane); continue; } r -= I_G;
            if (r < I_DN) { conv_item8(F.in[IN_EDOWN], FF, DM, F.ws + WS_WDN, 0, S_WDN, scr, r, lane); continue; } r -= I_DN;
#else
            if (r < I_G) { conv_item(F.in[IN_EGATE], DM, FF, (bf16*)(F.ws + WS_WGU), 1, scr, r, lane); continue; } r -= I_G;
            if (r < I_G) { conv_item(F.in[IN_EUP], DM, FF, (bf16*)(F.ws + WS_WGU), 2, scr, r, lane); continue; } r -= I_G;
#if FFN_FP8 == 2
            if (r < I_DN) { conv_item8(F.in[IN_EDOWN], FF, DM, F.ws + WS_WDN, 0, S_WDN, scr, r, lane); continue; } r -= I_DN;
#else
            if (r < I_DN) { conv_item(F.in[IN_EDOWN], FF, DM, (bf16*)(F.ws + WS_WDN), 0, scr, r, lane); continue; } r -= I_DN;
#endif
#endif
#if OIN_I8
            if (r < I_OIN) { conv_item8<true>(F.in[IN_OWIN], DM, O_IN, F.ws + WS_WOIN, 0, S_WI8, scr, r, lane); continue; } r -= I_OIN;
#else
            if (r < I_OIN) { conv_item(F.in[IN_OWIN], DM, O_IN, (bf16*)(F.ws + WS_WOIN), 0, scr, r, lane); continue; } r -= I_OIN;
#endif
            conv_item(F.in[IN_OWO], DM, DM, (bf16*)(F.ws + WS_WOO), 0, scr, r, lane);
        }
    }
    {
        const size_t gt = (size_t)blockIdx.x * 512 + tid, NT = (size_t)F.G * 512;
        bf16* DL = (bf16*)(F.ws + WS_DFTL);
        for (size_t i = gt; i < (size_t)2048 * 4096 / 8; i += NT) {
            const int k = (int)(i >> 9), l0 = (int)(i & 511) * 8; unsigned w[4]; float vv[8]; (void)w; (void)vv;
#pragma unroll
            for (int j = 0; j < 8; j += 2) { float v[2];
#pragma unroll
                for (int q = 0; q < 2; ++q) { const int lp = l0 + j + q, l = lp & 2047; const int ph = (k * l) & 2047; float s, c; sincospif((float)ph * (1.f / 1024.f), &s, &c); v[q] = (lp < 2048) ? c : -s; }
#if DFTL_I8
                vv[j] = v[0]; vv[j + 1] = v[1]; }
            *(u32x2*)((unsigned char*)DL + (size_t)k * 4096 + l0) = (u32x2){pk4_i8(vv[0] * 127.f, vv[1] * 127.f, vv[2] * 127.f, vv[3] * 127.f), pk4_i8(vv[4] * 127.f, vv[5] * 127.f, vv[6] * 127.f, vv[7] * 127.f)};
#else
                w[j >> 1] = pk2(v[0], v[1]); }
            *(u32x4*)(DL + (size_t)k * 4096 + l0) = (u32x4){w[0], w[1], w[2], w[3]};
#endif
        }
        bf16* DC = (bf16*)(F.ws + WS_DFTC);
        for (size_t i = gt; i < (size_t)4 * 256 * 256; i += NT) {
            const int gi = (int)(i >> 16), mp = (int)(i >> 8) & 255, c2 = (int)i & 255; const int pq = mp >> 7, j = mp & 127, cg = c2 >> 7, c = c2 & 127;
            float v = 0.f;
            if (cg == (gi & 1)) { const int ph = (c * j) & 127; float s, cs; sincospif((float)ph * (1.f / 64.f), &s, &cs); v = pq ? s : cs; }
            DC[i] = (bf16)f2bf(v);
        }
        float* RP = (float*)(F.ws + WS_ROPE);
        for (size_t i = gt; i < (size_t)2048 * 32; i += NT) {
            const int t = (int)(i >> 5), j = (int)i & 31; const float pos = (j < 16) ? (float)(t >> 6) : (float)(t & 63);
            const float invf = powf(10000.f, -(float)(j & 15) / 16.f); const float ang = pos * invf;
            RP[i * 2] = cosf(ang); RP[i * 2 + 1] = sinf(ang);
        }
        bf16* BT = (bf16*)(F.ws + WS_BT);
        for (size_t i = gt; i < (size_t)8 * 15 * 2 * 2 * 64 * 16; i += NT) {
            const int r = (int)i & 15, ln = (int)(i >> 4) & 63, kb = (int)(i >> 10) & 1, qh = (int)(i >> 11) & 1, hd = (int)(i >> 12);
            const int qc = qh * 32 + (ln & 31), kc = kb * 32 + (r & 3) + 8 * (r >> 2) + 4 * (ln >> 5);
            const int cs = min(max(qc - 8, 0), 48);
            BT[i] = (bf16)f2bf((kc >= cs && kc < cs + 16) ? F.in[IN_RPB][hd * 31 + (kc - qc + 15)] * 1.4426950408889634f : -1e30f);
        }
        if (gt == 0) {
            float s1 = 0.f, s2 = 0.f;
            for (int d = 0; d < 64; ++d) { s1 += F.in[IN_LQ1][d] * F.in[IN_LK1][d]; s2 += F.in[IN_LQ2][d] * F.in[IN_LK2][d]; }
            const float lam_init = 0.2f;
            ((float*)(F.ws + WS_MISC))[0] = expf(s1) - expf(s2) + lam_init;
        }
    }
}

__device__ __forceinline__ void conv_experts(Frame& F, LAS float* scr, int k0, int k1) {
    constexpr int I_G = 16 * 112, I_D = 56 * 32;
    constexpr int NIT = NEXP * (2 * I_G + I_D);
    int ln = F.lane; asm volatile("" : "+v"(ln));
    for (int k = k0; k < k1; ++k) {
        const int it = F.gw + k * F.NGW; if (it >= NIT) break;
        const int e = it / (2 * I_G + I_D); int r = it % (2 * I_G + I_D);
        unsigned char* gu = F.ws + WS_EWGU + (size_t)e * 7168 * DM;
        if (r < I_G) { conv_item8<true>(F.in[IN_XGATE] + (size_t)e * DM * FFE, DM, FFE, gu, 1, S_WI8, scr, r, ln); continue; } r -= I_G;
        if (r < I_G) { conv_item8<true>(F.in[IN_XUP] + (size_t)e * DM * FFE, DM, FFE, gu, 2, S_WI8, scr, r, ln); continue; } r -= I_G;
        conv_item8(F.in[IN_XDOWN] + (size_t)e * FFE * DM, FFE, DM, F.ws + WS_EWDN + (size_t)e * DM * FFE, 0, S_WDN, scr, r, ln);
    }
}

__device__ __forceinline__ void ld_row_f32(const float* p, int lane, f32x4 (&v)[4]) {
#pragma unroll
    for (int j = 0; j < 4; ++j) v[j] = *(const f32x4*)(p + 4 * lane + 256 * j);
}
__device__ __forceinline__ void ld_row_bf16(const bf16* p, int lane, f32x4 (&v)[4]) {
#pragma unroll
    for (int j = 0; j < 4; ++j) { const u32x2 w = *(const u32x2*)(p + 4 * lane + 256 * j); v[j] = (f32x4){bf_lo(w.x), bf_hi(w.x), bf_lo(w.y), bf_hi(w.y)}; }
}
__device__ __forceinline__ void st_row_f32(float* p, int lane, const f32x4 (&v)[4]) {
#pragma unroll
    for (int j = 0; j < 4; ++j) *(f32x4*)(p + 4 * lane + 256 * j) = v[j];
}
__device__ __forceinline__ void st_row_bf16(bf16* p, int lane, const f32x4 (&v)[4]) {
#pragma unroll
    for (int j = 0; j < 4; ++j) { u32x2 w; w.x = pk2(v[j][0], v[j][1]); w.y = pk2(v[j][2], v[j][3]); *(u32x2*)(p + 4 * lane + 256 * j) = w; }
}
__device__ __forceinline__ void ln_row(f32x4 (&v)[4], const float* g, const float* b, int lane) {
    float s = 0.f;
#pragma unroll
    for (int j = 0; j < 4; ++j) s += (v[j][0] + v[j][1]) + (v[j][2] + v[j][3]);
    const float mean = wave_sum(s) * (1.f / DM); float s2 = 0.f;
#pragma unroll
    for (int j = 0; j < 4; ++j) { v[j] = v[j] - mean; s2 += (v[j][0] * v[j][0] + v[j][1] * v[j][1]) + (v[j][2] * v[j][2] + v[j][3] * v[j][3]); }
    const float rstd = rsqrtf(wave_sum(s2) * (1.f / DM) + LN_EPS);
    f32x4 gg[4], bb[4]; ld_row_f32(g, lane, gg); ld_row_f32(b, lane, bb);
#pragma unroll
    for (int j = 0; j < 4; ++j) v[j] = v[j] * rstd * gg[j] + bb[j];
}
__device__ __forceinline__ void modulate_row(f32x4 (&h)[4], const f32x4 (&x)[4], const float* sh, const float* sc, int lane) {
    f32x4 a[4], c[4]; ld_row_f32(sh, lane, a); ld_row_f32(sc, lane, c);
#pragma unroll
    for (int j = 0; j < 4; ++j) h[j] = x[j] * (1.f + c[j]) + a[j];
}

__device__ __forceinline__ void p1_modulate(Frame& F) {
    bf16* H = (bf16*)(F.ws + WS_H);
    for (int row = F.gw; row < MT; row += F.NGW) {
        const int cond = cond_of_row(row);
        const float* xr = row < ML ? F.in[IN_X] + (size_t)row * DM : F.in[IN_CTX] + (size_t)(row - ML) * DM;
        f32x4 x[4], h[4]; ld_row_f32(xr, F.lane, x);
        modulate_row(h, x, mods_ptr(F, 0, cond, 0), mods_ptr(F, 0, cond, 1), F.lane);
#if EIN_I8
        float am = 0.f;
#pragma unroll
        for (int j = 0; j < 4; ++j) am = fmaxf(fmaxf(am, fmaxf(fabsf(h[j][0]), fabsf(h[j][1]))), fmaxf(fabsf(h[j][2]), fabsf(h[j][3])));
#pragma unroll
        for (int o = 1; o < 64; o <<= 1) am = fmaxf(am, __shfl_xor(am, o));
        am = fmaxf(am, 1e-20f); const float qs = 127.f / am;
        unsigned char* H8 = F.ws + WS_H8;
#pragma unroll
        for (int j = 0; j < 4; ++j) *(unsigned*)(H8 + (size_t)row * DM + 4 * F.lane + 256 * j) = pk4_i8(h[j][0] * qs, h[j][1] * qs, h[j][2] * qs, h[j][3] * qs);
        if (F.lane == 0) ((float*)(F.ws + WS_SRS))[row] = am * (1.f / 127.f);
#else
        st_row_bf16(H + (size_t)row * DM, F.lane, h);
#endif
    }
}

__device__ __forceinline__ void p3_rope_conv(Frame& F) {
    bf16* P = (bf16*)(F.ws + WS_BIG); bf16* CAT = (bf16*)(F.ws + WS_CAT);
    const float* wc = F.in[IN_ECONV];
    const int lane = F.lane;
    const int ch = 8 * lane;
    float w0[8], w1[8], w2[8];
#pragma unroll
    for (int j = 0; j < 8; ++j) { w0[j] = wc[ch + j]; w1[j] = wc[512 + ch + j]; w2[j] = wc[1024 + ch + j]; }
    for (int row = F.gw; row < MT; row += F.NGW) {
        const bf16* pr = P + (size_t)row * E_IN;
        const int t = row < ML ? (row & 2047) : ((row - ML) & 255); const int Ls = row < ML ? SEQ : LC;
        u32x4 cg[3], vl[3]; float mk[3];
#pragma unroll
        for (int dt = 0; dt < 3; ++dt) { const int tt = t + dt - 1; const bool ok = (tt >= 0 && tt < Ls); const bf16* q = P + (size_t)(ok ? row + dt - 1 : row) * E_IN;
            cg[dt] = *(const u32x4*)(q + 512 + ch); vl[dt] = *(const u32x4*)(q + 1024 + ch); mk[dt] = ok ? 1.f : 0.f; }
        const u32x4 bg = *(const u32x4*)(pr + ch);
        float cv[3][8];
#pragma unroll
        for (int dt = 0; dt < 3; ++dt)
#pragma unroll
            for (int j = 0; j < 4; ++j) { cv[dt][2 * j] = bf_lo(cg[dt][j]) * bf_lo(vl[dt][j]) * mk[dt]; cv[dt][2 * j + 1] = bf_hi(cg[dt][j]) * bf_hi(vl[dt][j]) * mk[dt]; }
        float o[8];
#pragma unroll
        for (int j = 0; j < 8; ++j) { const float bgv = (j & 1) ? bf_hi(bg[j >> 1]) : bf_lo(bg[j >> 1]); o[j] = bgv * (cv[0][j] * w0[j] + cv[1][j] * w1[j] + cv[2][j] * w2[j]); }
        u32x4 w; w.x = pk2(o[0], o[1]); w.y = pk2(o[2], o[3]); w.z = pk2(o[4], o[5]); w.w = pk2(o[6], o[7]);
        *(u32x4*)(CAT + (size_t)row * DM + ch) = w;
    }
}

constexpr float ATT_THR = 8.f;
__device__ __forceinline__ int crow(int r, int hi) { return (r & 3) + 8 * (r >> 2) + 4 * hi; }
__device__ __forceinline__ s16x4 vtr(const LAS unsigned char* p) { return __builtin_bit_cast(s16x4, __builtin_amdgcn_ds_read_tr16_b64_v4i16((LAS s16x4*)p)); }
__device__ __forceinline__ float xhalf_max(float v) { return fmaxf(v, __shfl_xor(v, 32)); }
__device__ __forceinline__ bf16x8 pack8(const f32x16& p, int s) {
    u32x4 w; w.x = cvt_pk_bf16(p[8 * s + 0], p[8 * s + 1]); w.y = cvt_pk_bf16(p[8 * s + 2], p[8 * s + 3]); w.z = cvt_pk_bf16(p[8 * s + 4], p[8 * s + 5]); w.w = cvt_pk_bf16(p[8 * s + 6], p[8 * s + 7]);
    return __builtin_bit_cast(bf16x8, w);
}
__device__ __forceinline__ int koff(int row, int ch) { return row * 128 + ((ch ^ ((row >> 1) & 7)) << 4); }
__device__ __forceinline__ int voff128(int row, int ch) { return 256 * row + 16 * (ch ^ (((row & 3) << 2) | ((row >> 2) & 3))); }
__device__ __forceinline__ int voff64(int row, int ch) { return 128 * row + 16 * (ch ^ (((row >> 1) & 1) << 2)); }

__device__ __forceinline__ void p4_diff_attn(Frame& F) {
    const bf16* P = (const bf16*)(F.ws + WS_BIG); bf16* CAT = (bf16*)(F.ws + WS_CAT);
    const float lam = ((const float*)(F.ws + WS_MISC))[0];
    const float* subg = F.in[IN_SUBG];
    const int tid = F.tid, lane = F.lane, wave = F.wave, r32 = lane & 31, hi = lane >> 5;
    const int comp = wave >> 2, qb = wave & 3;
    LAS unsigned char* lds = F.lds;
    constexpr int STG = 32768;
    constexpr int NU_LAT = NB * 4 * 16, NU = NU_LAT + NB * 4 * 2;
    for (int un = F.vcu; un < NU; un += F.G) {
        int b, h, qrow0, j0, j1;
        if (un < NU_LAT) { b = un >> 6; h = (un >> 4) & 3; qrow0 = b * SEQ + (un & 15) * 128; j0 = 0; j1 = 36; }
        else { const int v = un - NU_LAT; b = v >> 3; h = (v >> 1) & 3; qrow0 = ML + b * LC + (v & 1) * 128; j0 = 0; j1 = 4; }
        bf16x8 qf[4];
        { const bf16* qp = P + (size_t)(qrow0 + qb * 32 + r32) * E_IN + 1536 + h * 128 + comp * 64 + hi * 8;
#pragma unroll
          for (int ds = 0; ds < 4; ++ds) qf[ds] = *(const bf16x8*)(qp + ds * 16); }
        f32x16 o[4];
#pragma unroll
        for (int e = 0; e < 4; ++e) o[e] = (f32x16){};
        float mref = 0.f; f32x16 negm = (f32x16){}; f32x16 lacc = (f32x16){};
        const bf16x8 ones = (bf16x8){0x3F80, 0x3F80, 0x3F80, 0x3F80, 0x3F80, 0x3F80, 0x3F80, 0x3F80};
        u32x4 sk1, sk2, sv[2];
        const int krow = tid >> 3, kch = tid & 7;
#define DA_LOAD(j) do { const int rowb = ((j) < 4) ? (ML + b * LC + (j) * 64) : (b * SEQ + ((j) - 4) * 64); \
            const bf16* kp = P + (size_t)(rowb + krow) * E_IN + 2048 + h * 128 + kch * 8; sk1 = *(const u32x4*)kp; sk2 = *(const u32x4*)(kp + 64); \
            _Pragma("unroll") for (int i = 0; i < 2; ++i) { const int idx = tid + 512 * i; sv[i] = *(const u32x4*)(P + (size_t)(rowb + (idx >> 4)) * E_IN + 2560 + h * 128 + (idx & 15) * 8); } } while (0)
#define DA_STORE(st) do { LAS unsigned char* sb = lds + (st) * STG; *(LAS u32x4*)(sb + koff(krow, kch)) = sk1; *(LAS u32x4*)(sb + 8192 + koff(krow, kch)) = sk2; \
            _Pragma("unroll") for (int i = 0; i < 2; ++i) { const int idx = tid + 512 * i; *(LAS u32x4*)(sb + 16384 + voff128(idx >> 4, idx & 15)) = sv[i]; } } while (0)
        __syncthreads();
        DA_LOAD(j0); DA_STORE(0);
        __syncthreads();
        for (int j = j0; j < j1; ++j) {
            const int st = (j - j0) & 1;
            if (j + 1 < j1) DA_LOAD(j + 1);
            const LAS unsigned char* kb_ = lds + st * STG + comp * 8192;
            const LAS unsigned char* vb_ = lds + st * STG + 16384;
            f32x16 p[2];
#pragma unroll
            for (int kb = 0; kb < 2; ++kb) { p[kb] = negm;
#pragma unroll
                for (int ds = 0; ds < 4; ++ds) { const bf16x8 kf = *(const LAS bf16x8*)(kb_ + koff(kb * 32 + r32, ds * 2 + hi)); p[kb] = __builtin_amdgcn_mfma_f32_32x32x16_bf16(kf, qf[ds], p[kb], 0, 0, 0); } }
            float mx = fmaxf(p[0][0], p[1][0]);
#pragma unroll
            for (int r = 1; r < 16; ++r) mx = fmaxf(fmaxf(mx, p[0][r]), p[1][r]);
            mx = xhalf_max(mx);
            if (__any(mx > ATT_THR)) {
                const float d = fmaxf(mx, 0.f), al = __builtin_amdgcn_exp2f(-d);
                mref += d;
#pragma unroll
                for (int r = 0; r < 16; ++r) { p[0][r] -= d; p[1][r] -= d; negm[r] = -mref; lacc[r] *= al; }
#pragma unroll
                for (int e = 0; e < 4; ++e) o[e] = o[e] * al;
            }
#pragma unroll
            for (int kb = 0; kb < 2; ++kb)
#pragma unroll
                for (int r = 0; r < 16; ++r) p[kb][r] = __builtin_amdgcn_exp2f(p[kb][r]);
#pragma unroll
            for (int kb = 0; kb < 2; ++kb)
#pragma unroll
                for (int s = 0; s < 2; ++s) { const bf16x8 pf = pack8(p[kb], s);
                    lacc = __builtin_amdgcn_mfma_f32_32x32x16_bf16(ones, pf, lacc, 0, 0, 0);
                    const int rb = kb * 32 + 16 * s + 4 * hi + ((lane & 15) >> 2);
#pragma unroll
                    for (int e = 0; e < 4; ++e) { const int c0 = 4 * e + 2 * ((lane >> 4) & 1) + ((lane & 3) >> 1);
                        const s16x4 lo = vtr(vb_ + voff128(rb, c0) + 8 * (lane & 1)), hh = vtr(vb_ + voff128(rb + 8, c0) + 8 * (lane & 1));
                        const bf16x8 vf = (bf16x8){lo[0], lo[1], lo[2], lo[3], hh[0], hh[1], hh[2], hh[3]};
                        o[e] = __builtin_amdgcn_mfma_f32_32x32x16_bf16(vf, pf, o[e], 0, 0, 0); } }
            if (j + 1 < j1) DA_STORE(st ^ 1);
            __syncthreads();
        }
        const float linv = 1.f / lacc[0];
        LAS float* X = (LAS float*)(lds + qb * 16384);
        if (comp == 1) {
#pragma unroll
            for (int e = 0; e < 4; ++e)
#pragma unroll
                for (int r = 0; r < 16; ++r) X[(e * 16 + r) * 64 + lane] = o[e][r] * linv; }
        __syncthreads();
        if (comp == 0) {
            float ss = 0.f;
#pragma unroll
            for (int e = 0; e < 4; ++e)
#pragma unroll
                for (int r = 0; r < 16; ++r) { const float v = o[e][r] * linv - lam * X[(e * 16 + r) * 64 + lane]; o[e][r] = v; ss += v * v; }
            ss += __shfl_xor(ss, 32);
            const float rn = rsqrtf(ss * (1.f / 128.f) + RMS_EPS) * 0.8f;
            bf16* op = CAT + (size_t)(qrow0 + qb * 32 + r32) * DM + 512 + h * 128;
#pragma unroll
            for (int e = 0; e < 4; ++e)
#pragma unroll
                for (int r4 = 0; r4 < 4; ++r4) { const int ec = 32 * e + 8 * r4 + 4 * hi; const f32x4 g = *(const f32x4*)(subg + ec);
                    u32x2 w; w.x = pk2(o[e][4 * r4] * rn * g[0], o[e][4 * r4 + 1] * rn * g[1]); w.y = pk2(o[e][4 * r4 + 2] * rn * g[2], o[e][4 * r4 + 3] * rn * g[3]);
                    *(u32x2*)(op + ec) = w; }
        }
#undef DA_LOAD
#undef DA_STORE
    }
    __syncthreads();
}

__device__ __forceinline__ void p11_na_attn(Frame& F) {
    const bf16* P2 = (const bf16*)(F.ws + WS_BIG); bf16* CAT = (bf16*)(F.ws + WS_CAT);
    const int lane = F.lane, wave = F.wave, r32 = lane & 31, hi = lane >> 5;
    {
        float* GN = (float*)(F.ws + WS_GN);
        for (int row0 = F.gw; row0 < ML; row0 += 4 * F.NGW) {
            u32x4 w4[4];
#pragma unroll
            for (int k = 0; k < 4; ++k) { const int row = min(row0 + k * F.NGW, ML - 1); w4[k] = *(const u32x4*)(P2 + (size_t)row * O_IN + 8 * lane); }
#pragma unroll
            for (int k = 0; k < 4; ++k) { const int row = row0 + k * F.NGW; const u32x4 w = w4[k];
                float v[8];
#pragma unroll
                for (int j = 0; j < 4; ++j) { v[2 * j] = bf_lo(w[j]); v[2 * j + 1] = bf_hi(w[j]); }
                float s_ = 0.f;
#pragma unroll
                for (int j = 0; j < 8; ++j) s_ += v[j];
#pragma unroll
                for (int o = 1; o < 16; o <<= 1) s_ += __shfl_xor(s_, o);
                const float mean = s_ * (1.f / 128.f); float q = 0.f;
#pragma unroll
                for (int j = 0; j < 8; ++j) { const float d = v[j] - mean; q += d * d; }
#pragma unroll
                for (int o = 1; o < 16; o <<= 1) q += __shfl_xor(q, o);
                if ((lane & 15) == 0 && row < ML) { float* g = GN + ((size_t)(lane >> 4) * ML + row) * 2; g[0] = mean; g[1] = rsqrtf(q * (1.f / 128.f) + LN_EPS); } }
        }
    }
    const bf16* BT = (const bf16*)(F.ws + WS_BT);
    __syncthreads();
    LAS unsigned char* vt = F.lds + wave * 8192;
    LAS float* cscr = (LAS float*)(wave < 7 ? F.lds + 65536 + wave * 8448 : F.lds + RSC_OFF + 4096);
    int cvk = 0;
    constexpr float NA_THR = 16.f;
    constexpr int NWU = NB * 32 * 8 * 2;
    for (int wu = F.vcu * NWAVES + wave; wu < NWU; wu += F.G * NWAVES) {
        const int qh = wu & 1, h = (wu >> 1) & 7, r = (wu >> 4) & 31, b = wu >> 9;
        const int rs = min(max(r - 4, 0), 24);
        const int qc = qh * 32 + r32;
        const int qrow = b * SEQ + r * 64 + qc;
        bf16x8 qf[4];
        { const bf16* qp = P2 + (size_t)qrow * O_IN + 512 + h * 64 + hi * 8;
#pragma unroll
          for (int ds = 0; ds < 4; ++ds) qf[ds] = *(const bf16x8*)(qp + ds * 16); }
        f32x16 o[2]; o[0] = (f32x16){}; o[1] = (f32x16){};
        float mref = 0.f, lrun = 0.f; bool anyref = false;
        bf16x8 kf[2][4], kn[2][4]; u32x4 vn[8];
#define NA_ROWB(j) (((j) < 8) ? (b * SEQ + (rs + (j)) * 64) : (ML + b * LC + ((j) - 8) * 64))
#define NA_LOADK(dst, j) do { const bf16* kp = P2 + (size_t)(NA_ROWB(j) + r32) * O_IN + 1024 + h * 64 + hi * 8; \
            _Pragma("unroll") for (int kb = 0; kb < 2; ++kb) _Pragma("unroll") for (int ds = 0; ds < 4; ++ds) dst[kb][ds] = *(const bf16x8*)(kp + (size_t)kb * 32 * O_IN + ds * 16); } while (0)
#define NA_LOADV(j) do { const bf16* vp = P2 + (size_t)NA_ROWB(j) * O_IN + 1536 + h * 64; \
            _Pragma("unroll") for (int i = 0; i < 8; ++i) { const int idx = lane + 64 * i; vn[i] = *(const u32x4*)(vp + (size_t)(idx >> 3) * O_IN + (idx & 7) * 8); } } while (0)
#define NA_STOREV() do { _Pragma("unroll") for (int i = 0; i < 8; ++i) { const int idx = lane + 64 * i; *(LAS u32x4*)(vt + voff64(idx >> 3, idx & 7)) = vn[i]; } } while (0)
        u32x4 bt[2][2], btn[2][2];
#define NA_LOADB(dst, j) do { const u32x4* bp_ = (const u32x4*)(BT + ((size_t)(((h * 15 + (rs + (j) - r + 7)) * 2 + qh) * 2) * 64 + lane) * 16); \
            _Pragma("unroll") for (int kb = 0; kb < 2; ++kb) { dst[kb][0] = bp_[kb * 128]; dst[kb][1] = bp_[kb * 128 + 1]; } } while (0)
        NA_LOADK(kf, 0); NA_LOADV(0); NA_LOADB(bt, 0); NA_STOREV();
        for (int j = 0; j < 12; ++j) {
            if (j + 1 < 12) { NA_LOADK(kn, j + 1); NA_LOADV(j + 1); if (j + 1 < 8) NA_LOADB(btn, j + 1); }
            f32x16 p[2];
#pragma unroll
            for (int kb = 0; kb < 2; ++kb) { p[kb] = (f32x16){};
#pragma unroll
                for (int ds = 0; ds < 4; ++ds) p[kb] = __builtin_amdgcn_mfma_f32_32x32x16_bf16(kf[kb][ds], qf[ds], p[kb], 0, 0, 0); }
            if (j < 8) {
#pragma unroll
                for (int kb = 0; kb < 2; ++kb)
#pragma unroll
                    for (int rr = 0; rr < 16; rr += 2) { const unsigned w = bt[kb][rr >> 3][(rr >> 1) & 3]; p[kb][rr] += bf_lo(w); p[kb][rr + 1] += bf_hi(w); } }
            if (anyref) {
#pragma unroll
                for (int rr = 0; rr < 16; ++rr) { p[0][rr] -= mref; p[1][rr] -= mref; } }
            float mx = fmaxf(p[0][0], p[1][0]);
#pragma unroll
            for (int rr = 1; rr < 16; ++rr) mx = fmaxf(fmaxf(mx, p[0][rr]), p[1][rr]);
            mx = xhalf_max(mx);
            if (__any(mx > NA_THR)) {
                const float d = fmaxf(mx, 0.f), al = __builtin_amdgcn_exp2f(-d);
                mref += d; anyref = true; lrun *= al;
#pragma unroll
                for (int rr = 0; rr < 16; ++rr) { p[0][rr] -= d; p[1][rr] -= d; }
                o[0] = o[0] * al; o[1] = o[1] * al;
            }
            float ps = 0.f;
#pragma unroll
            for (int kb = 0; kb < 2; ++kb)
#pragma unroll
                for (int rr = 0; rr < 16; ++rr) { const float e = __builtin_amdgcn_exp2f(p[kb][rr]); p[kb][rr] = e; ps += e; }
            lrun += ps;
#pragma unroll
            for (int kb = 0; kb < 2; ++kb)
#pragma unroll
                for (int s = 0; s < 2; ++s) { const bf16x8 pf = pack8(p[kb], s);
                    const int rb = kb * 32 + 16 * s + 4 * hi + ((lane & 15) >> 2);
#pragma unroll
                    for (int e = 0; e < 2; ++e) { const int c0 = 4 * e + 2 * ((lane >> 4) & 1) + ((lane & 3) >> 1);
                        const s16x4 lo = vtr(vt + voff64(rb, c0) + 8 * (lane & 1)), hh = vtr(vt + voff64(rb + 8, c0) + 8 * (lane & 1));
                        const bf16x8 vf = (bf16x8){lo[0], lo[1], lo[2], lo[3], hh[0], hh[1], hh[2], hh[3]};
                        o[e] = __builtin_amdgcn_mfma_f32_32x32x16_bf16(vf, pf, o[e], 0, 0, 0); } }
            if (j + 1 < 12) {
                NA_STOREV();
#pragma unroll
                for (int kb = 0; kb < 2; ++kb) {
#pragma unroll
                    for (int ds = 0; ds < 4; ++ds) kf[kb][ds] = kn[kb][ds];
                    bt[kb][0] = btn[kb][0]; bt[kb][1] = btn[kb][1]; }
            }
        }
        const float linv = 1.f / (lrun + __shfl_xor(lrun, 32));
        bf16* op = CAT + (size_t)qrow * DM + 512 + h * 64;
#pragma unroll
        for (int e = 0; e < 2; ++e)
#pragma unroll
            for (int r4 = 0; r4 < 4; ++r4) { const int ec = 32 * e + 8 * r4 + 4 * hi;
                u32x2 w; w.x = pk2(o[e][4 * r4] * linv, o[e][4 * r4 + 1] * linv); w.y = pk2(o[e][4 * r4 + 2] * linv, o[e][4 * r4 + 3] * linv);
                *(u32x2*)(op + ec) = w; }
#undef NA_LOADB
#undef NA_ROWB
#undef NA_LOADK
#undef NA_LOADV
#undef NA_STOREV
        conv_experts(F, cscr, cvk, cvk + 6); cvk += 6;
    }
    conv_experts(F, cscr, cvk, 1 << 20);
    __syncthreads();
}

template <int MODE, bool CTX = false>
__device__ __forceinline__ void ln_phase(Frame& F, int rlo, int rhi, int blo) {
    constexpr int LAYER = (MODE >= 15) ? 1 : 0, LNI = (MODE == 6) ? 0 : (MODE == 9) ? 1 : (MODE == 15) ? 2 : 3;
    constexpr int GI = (MODE == 6 || MODE == 15) ? 2 : 5;
    constexpr int HL = (MODE == 9) ? 1 : LAYER, HSH = (MODE == 9) ? 0 : 3, HSC = (MODE == 9) ? 1 : 4;
    const int lane = F.lane;
    const bf16* Y = (const bf16*)(F.ws + WS_Y); const bf16* YS = (const bf16*)(F.ws + WS_YS);
    bf16* H = (bf16*)(F.ws + WS_H); unsigned char* H8 = F.ws + WS_H8; float* XC = (float*)(F.ws + WS_XC);
    const int* TOK = (const int*)(F.ws + WS_TOK);
    LAS float* WR = (LAS float*)F.lds;
    LAS int* REC = (LAS int*)(F.lds + 32768 + F.wave * 2048);
    int rcnt = 0, nrec = 0;
    if (MODE == 15) {
        for (int i = F.tid; i < DM * 8; i += 512) { const int d = i >> 3, e = i & 7; const int l = (d & 255) >> 2, q = d & 3, j = d >> 8; WR[(((j * 4 + q) * 64 + l) << 3) + e] = F.in[IN_ROUTER][i]; }
        __syncthreads();
    }
    int pbase[8];
    if (MODE == 24) { const unsigned* cnt = (const unsigned*)(F.ws + WS_CTL) + CW_CNT; int a = 0;
#pragma unroll
        for (int e = 0; e < 8; ++e) { pbase[e] = a; a += (__builtin_amdgcn_readfirstlane((int)cnt[e]) + 255) >> 8; } }
    const int ngw_ = (F.G - blo) * NWAVES, gw_ = (F.vcu - blo) * NWAVES + F.wave;
    const int rpw = (((rhi - rlo) + ngw_ - 1) / ngw_ + 1) & ~1, run0 = (F.vcu >= blo) ? rlo + gw_ * rpw : rhi, rune = min(rhi, run0 + rpw);
    f32x4 lgv[4], lbv[4], g[4], sh[4], sc[4];
    ld_row_f32(F.in[IN_LNG] + LNI * DM, lane, lgv); ld_row_f32(F.in[IN_LNB] + LNI * DM, lane, lbv);
    bf16* const XB1 = (bf16*)((unsigned char*)F.out + 64 * MiB); bf16* const XB2 = (bf16*)F.out; bf16* const XB3 = (bf16*)(F.ws + WS_WEIN);
#define LN_LOADX(dst, row) do { if (MODE == 6) ld_row_f32(!CTX ? F.in[IN_X] + (size_t)(row) * DM : F.in[IN_CTX] + (size_t)((row) - ML) * DM, lane, dst); \
        else if (MODE == 9) { if (!CTX) ld_row_bf16(XB1 + (size_t)(row) * DM, lane, dst); else ld_row_f32(XC + (size_t)((row) - ML) * DM, lane, dst); } \
        else if (MODE == 15) ld_row_bf16(XB2 + (size_t)(row) * DM, lane, dst); else ld_row_bf16(XB3 + (size_t)(row) * DM, lane, dst); } while (0)
    constexpr int NQ = (MODE == 6 || MODE == 9) ? 3 : 2;
    f32x4 xn[NQ][4]; u32x2 yn[NQ][4], yn2[2][4]; float pn0[2] = {0.f, 0.f}, pn1[2] = {0.f, 0.f};
    int tkn[2][6] = {{0, 0, 0, 0, 0, 0}, {0, 0, 0, 0, 0, 0}};
#define LN_LOADTOK(q, row) do { const int* tk_ = TOK + (size_t)(row) * 8; _Pragma("unroll") for (int q_ = 0; q_ < 6; ++q_) tkn[q][q_] = tk_[q_]; } while (0)
#define LN_LOADROW(q, row) do { LN_LOADX(xn[q], row); \
        if (MODE == 24) { int pb0_ = 0, pb1_ = 0; _Pragma("unroll") for (int e_ = 0; e_ < 8; ++e_) { pb0_ = (e_ == tkn[q][0]) ? pbase[e_] : pb0_; pb1_ = (e_ == tkn[q][2]) ? pbase[e_] : pb1_; } \
            const bf16* ya_ = YS + ((size_t)pb0_ * 256 + tkn[q][1]) * DM; const bf16* yb_ = YS + ((size_t)pb1_ * 256 + tkn[q][3]) * DM; pn0[q] = __builtin_bit_cast(float, tkn[q][4]); pn1[q] = __builtin_bit_cast(float, tkn[q][5]); \
            _Pragma("unroll") for (int j_ = 0; j_ < 4; ++j_) { yn[q][j_] = *(const u32x2*)(ya_ + 4 * lane + 256 * j_); yn2[q][j_] = *(const u32x2*)(yb_ + 4 * lane + 256 * j_); } } \
        else { _Pragma("unroll") for (int j_ = 0; j_ < 4; ++j_) yn[q][j_] = *(const u32x2*)(Y + (size_t)(row) * DM + 4 * lane + 256 * j_); } } while (0)
    for (int row0 = run0; row0 < rune; ) {
    const int cond = (MODE == 6 || MODE == 9) ? cond_of_row(row0) : (row0 >> 11);
    const int rowe = min(rune, row0 < ML ? min(ML, ((row0 >> 11) + 1) << 11) : MT);
    ld_row_f32(mods_ptr(F, LAYER, cond, GI), lane, g);
    if (MODE != 24) { ld_row_f32(mods_ptr(F, HL, cond, HSH), lane, sh); ld_row_f32(mods_ptr(F, HL, cond, HSC), lane, sc); }
#pragma unroll
    for (int q = 0; q < NQ; ++q) if (MODE == 24) LN_LOADTOK(q, min(row0 + q, rowe - 1));
#pragma unroll
    for (int q = 0; q < NQ; ++q) { LN_LOADROW(q, min(row0 + q, rowe - 1)); if (MODE == 24) LN_LOADTOK(q, min(row0 + q + NQ, rowe - 1)); }
    for (int rowp = row0; rowp < rowe; rowp += NQ) {
#pragma unroll
      for (int q = 0; q < NQ; ++q) {
        const int row = rowp + q; if (row >= rowe) break;
        f32x4 x[4];
#pragma unroll
        for (int j = 0; j < 4; ++j) {
            f32x4 yv = (f32x4){bf_lo(yn[q][j].x), bf_hi(yn[q][j].x), bf_lo(yn[q][j].y), bf_hi(yn[q][j].y)};
            if (MODE == 24) { const f32x4 y2 = (f32x4){bf_lo(yn2[q][j].x), bf_hi(yn2[q][j].x), bf_lo(yn2[q][j].y), bf_hi(yn2[q][j].y)}; yv = pn0[q] * yv + pn1[q] * y2; }
            x[j] = ALPHA * xn[q][j] + g[j] * yv; }
        { LN_LOADROW(q, min(row + NQ, rowe - 1)); if (MODE == 24) LN_LOADTOK(q, min(row + 2 * NQ, rowe - 1)); }
        float s = 0.f;
#pragma unroll
        for (int j = 0; j < 4; ++j) s += (x[j][0] + x[j][1]) + (x[j][2] + x[j][3]);
        const float mean = wave_sum(s) * (1.f / DM); float s2 = 0.f;
#pragma unroll
        for (int j = 0; j < 4; ++j) { x[j] = x[j] - mean; s2 += (x[j][0] * x[j][0] + x[j][1] * x[j][1]) + (x[j][2] * x[j][2] + x[j][3] * x[j][3]); }
        const float rstd = rsqrtf(wave_sum(s2) * (1.f / DM) + LN_EPS);
#pragma unroll
        for (int j = 0; j < 4; ++j) x[j] = x[j] * rstd * lgv[j] + lbv[j];
        if (MODE == 6) { if (!CTX) st_row_bf16(XB1 + (size_t)row * DM, lane, x); else st_row_f32(XC + (size_t)(row - ML) * DM, lane, x); }
        else if (MODE == 9) { if (!CTX) st_row_bf16(XB2 + (size_t)row * DM, lane, x); }
        else if (MODE == 15) st_row_bf16(XB3 + (size_t)row * DM, lane, x);
        else st_row_f32(F.out + (size_t)row * DM, lane, x);
        if (MODE == 24) continue;
        f32x4 h[4];
#pragma unroll
        for (int j = 0; j < 4; ++j) h[j] = x[j] * (1.f + sc[j]) + sh[j];
        float rinv = 1.f;
        if (MODE == 15 || (MODE == 6 && FFN_FP8 == 3) || (MODE == 9 && OIN_I8)) {
            float am = 0.f;
#pragma unroll
            for (int j = 0; j < 4; ++j) am = fmaxf(fmaxf(am, fmaxf(fabsf(h[j][0]), fabsf(h[j][1]))), fmaxf(fabsf(h[j][2]), fabsf(h[j][3])));
#pragma unroll
            for (int o = 1; o < 64; o <<= 1) am = fmaxf(am, __shfl_xor(am, o));
            am = fmaxf(am, 1e-20f); const float qs = 127.f / am; rinv = am * (1.f / 127.f);
#pragma unroll
            for (int j = 0; j < 4; ++j) *(unsigned*)(H8 + (size_t)row * DM + 4 * lane + 256 * j) = pk4_i8(h[j][0] * qs, h[j][1] * qs, h[j][2] * qs, h[j][3] * qs);
            if (MODE != 15 && lane == 0) ((float*)(F.ws + WS_SRS))[row] = rinv;
        } else if (MODE == 6 && FFN_FP8 == 1) {
#pragma unroll
            for (int j = 0; j < 4; ++j) *(unsigned*)(H8 + (size_t)row * DM + 4 * lane + 256 * j) = pk4_fp8(h[j][0] * S_ACT, h[j][1] * S_ACT, h[j][2] * S_ACT, h[j][3] * S_ACT);
        } else st_row_bf16(H + (size_t)row * DM, lane, h);
        if (MODE == 15) {
            asm volatile("" ::: "memory");
            float lg8[8];
#pragma unroll
            for (int e = 0; e < 8; ++e) lg8[e] = 0.f;
#pragma unroll
            for (int j = 0; j < 4; ++j)
#pragma unroll
                for (int q = 0; q < 4; ++q) { const LAS f32x4* wp = (const LAS f32x4*)(WR + (((j * 4 + q) * 64 + lane) << 3)); const f32x4 w0 = wp[0], w1 = wp[1]; const float hv = h[j][q];
#pragma unroll
                    for (int e = 0; e < 4; ++e) { lg8[e] += hv * w0[e]; lg8[4 + e] += hv * w1[e]; } }
#pragma unroll
            for (int e = 0; e < 8; ++e) lg8[e] = wave_sum(lg8[e]);
            int e0 = 0; float v0 = lg8[0];
#pragma unroll
            for (int e = 1; e < 8; ++e) if (lg8[e] > v0) { v0 = lg8[e]; e0 = e; }
            int e1 = -1; float v1 = -INFINITY;
#pragma unroll
            for (int e = 0; e < 8; ++e) if (e != e0 && lg8[e] > v1) { v1 = lg8[e]; e1 = e; }
            const float p1 = 1.f / (1.f + __expf(v0 - v1)), p0 = 1.f - p1;
            const int e0s = __builtin_amdgcn_readfirstlane(e0), e1s = __builtin_amdgcn_readfirstlane(e1);
            const int l0 = __builtin_amdgcn_readlane(rcnt, e0s), l1 = __builtin_amdgcn_readlane(rcnt, e1s);
            rcnt += (lane == e0s ? 1 : 0) + (lane == e1s ? 1 : 0);
            if (lane == 0) { LAS int* rc = REC + nrec * 8; rc[0] = row; rc[1] = e0s | (e1s << 8); rc[2] = l0; rc[3] = l1;
                rc[4] = __builtin_bit_cast(int, p0); rc[5] = __builtin_bit_cast(int, p1); rc[6] = __builtin_bit_cast(int, rinv); }
            ++nrec;
        }
      }
    }
    row0 = rowe; }
#undef LN_LOADX
#undef LN_LOADTOK
#undef LN_LOADROW
    if (MODE == 15) {
        unsigned* cnt = (unsigned*)(F.ws + WS_CTL) + CW_CNT; int* TOKW = (int*)(F.ws + WS_TOK); int* LIST = (int*)(F.ws + WS_LIST); float* SRS = (float*)(F.ws + WS_SRS);
        LAS int* WC = (LAS int*)(F.lds + 32768 + 16384);
        if (lane < 8) WC[F.wave * 8 + lane] = rcnt;
        __syncthreads();
        if (F.wave == 0 && lane < 8) { int tot = 0;
#pragma unroll
            for (int w = 0; w < NWAVES; ++w) tot += WC[w * 8 + lane];
            int b = tot > 0 ? (int)atomicAdd(cnt + lane, (unsigned)tot) : 0;
#pragma unroll
            for (int w = 0; w < NWAVES; ++w) { const int c = WC[w * 8 + lane]; WC[w * 8 + lane] = b; b += c; } }
        __syncthreads();
        const int base = lane < 8 ? WC[F.wave * 8 + lane] : 0;
        const bool act = lane < nrec; const LAS int* rc = REC + lane * 8;
        int row = 0, ee = 0, l0 = 0, l1 = 0, q0 = 0, q1 = 0, ri = 0;
        if (act) { row = rc[0]; ee = rc[1]; l0 = rc[2]; l1 = rc[3]; q0 = rc[4]; q1 = rc[5]; ri = rc[6]; }
        const int e0 = ee & 255, e1 = ee >> 8;
        const int pos0 = __shfl(base, e0) + l0, pos1 = __shfl(base, e1) + l1;
        if (act) { LIST[e0 * ML + pos0] = row; LIST[e1 * ML + pos1] = row;
            SRS[e0 * ML + pos0] = __builtin_bit_cast(float, ri); SRS[e1 * ML + pos1] = __builtin_bit_cast(float, ri);
            int* tk = TOKW + (size_t)row * 8; tk[0] = e0; tk[1] = pos0; tk[2] = e1; tk[3] = pos1; tk[4] = q0; tk[5] = q1; }
    }
    if (MODE == 15) __syncthreads();
}

template <int GA>
struct MoeOrderT {
    static constexpr int GATH = GA;
    int cum[9]; int cnt[8]; int nM, nN, nwg, G, c; int gather; const int* list; unsigned long long bstep; int ocw; int split = 0;
    __device__ __forceinline__ void init(const unsigned* counts, int nN_, int G_, int c_, int gather_, const int* list_, int ldb, int ocw_) {
        int a = 0;
#pragma unroll
        for (int e = 0; e < 8; ++e) { cnt[e] = __builtin_amdgcn_readfirstlane((int)counts[e]); cum[e] = a; a += (cnt[e] + 255) >> 8; }
        cum[8] = a; nM = a;
        nN = nN_; nwg = nM * nN; G = G_; c = c_; gather = gather_; list = list_; bstep = (unsigned long long)256 * ldb; ocw = ocw_;
    }
    __device__ __forceinline__ bool next(int i, pg8::Unit& u) const {
        const long L = (long)i * G + c; int idx = (int)L, part = 0;
        if (!split) { if (L >= nwg) return false; }
        else { const int nfull = (nwg / G) * G, tail = nwg - nfull, sf = (tail * 4 <= G) ? 4 : (tail * 2 <= G) ? 2 : 1;
            if (L >= nfull) { const int j = (int)L - nfull; if (j >= tail * sf) return false; idx = nfull + j / sf; const int q = j % sf;
                part = (sf == 1) ? 0 : (sf == 2) ? (1 + q) : ((1 + (q & 1)) | ((1 + (q >> 1)) << 2)); } }
        int wgid = idx; { const int q = nwg / 8, r = nwg % 8, xcd = wgid % 8, off = wgid / 8; wgid = (xcd < r ? xcd * (q + 1) : r * (q + 1) + (xcd - r) * q) + off; }
        const int nig = 8 * nN, gid = wgid / nig, fm = gid * 8, gsz = (nM - fm) < 8 ? (nM - fm) : 8;
        const int pm = fm + ((wgid % nig) % gsz), pn = (wgid % nig) / gsz;
        int e = 0;
#pragma unroll
        for (int k = 1; k < 8; ++k) e += (pm >= cum[k]) ? 1 : 0;
        int ce = 0, cme = 0;
#pragma unroll
        for (int k = 0; k < 8; ++k) { ce = (k == e) ? cnt[k] : ce; cme = (k == e) ? cum[k] : cme; }
        u.pm = pm; u.pn = pn; u.aux = e | ((pm - cme) << 4) | (ce << 12);
        u.bofs = (unsigned long long)(e * nN + pn) * bstep;
        u.orow0 = pm * 256 + ((part & 3) == 2 ? 128 : 0); u.ocol0 = pn * ocw; u.part = part;
        return true;
    }
    __device__ __forceinline__ const int* gptr(const pg8::Unit& u, int r) const {
        const int e = u.aux & 15, lp = (u.aux >> 4) & 255, ce = u.aux >> 12; const int idx = lp * 256 + r; return list + e * ML + min(idx, ce - 1); }
    __device__ __forceinline__ int arow(const pg8::Unit& u, int r) const {
        if (GA) return *gptr(u, r);

        return u.pm * 256 + (((u.part & 3) == 2 ? r + 128 : r) & 255);
    }
};
struct CtxOrder {
    static constexpr int GATH = 0;
    int vcu; unsigned long long bstep;
    __device__ __forceinline__ bool next(int i, pg8::Unit& u) const {
        if (i > 0 || vcu >= 64) return false;
        u.pm = ML / 256 + (vcu >> 2); u.pn = vcu & 3; u.orow0 = u.pm * 256; u.ocol0 = u.pn * 256; u.bofs = (unsigned long long)u.pn * bstep; u.aux = 0; return true;
    }
    __device__ __forceinline__ int arow(const pg8::Unit& u, int r) const { return u.pm * 256 + r; }
};
struct DftCOrder {
    static constexpr int GATH = 0;
    int G, c;
    __device__ __forceinline__ bool next(int i, pg8::Unit& u) const {
        const int L = i * G + c; if (L >= 512) return false;
        u.pm = L & 3; u.pn = L >> 2; u.orow0 = 0; u.ocol0 = 0; u.aux = 0;
        u.bofs = ((unsigned long long)u.pn * 256 * O_IN + (u.pm >> 1) * 256) * 2; return true;
    }
    __device__ __forceinline__ int arow(const pg8::Unit& u, int r) const { return u.pm * 256 + r; }
};
struct DftLOrder {
    static constexpr int GATH = 0;
    int G, vcu;
    __device__ __forceinline__ bool next(int i, pg8::Unit& u) const {
        const int L = i * G + vcu; if (L >= 256) return false;
        const int b = L >> 4; u.pm = (L >> 1) & 7; u.pn = L & 1; u.orow0 = b * SEQ + u.pm * 256; u.ocol0 = u.pn * 256; u.aux = 0;
        u.bofs = ((unsigned long long)(b * 512 + u.pn * 256) * 4096) * (DFTL_I8 ? 1 : 2); return true;
    }
    __device__ __forceinline__ int arow(const pg8::Unit& u, int r) const { return u.pm * 256 + r; }
};

constexpr int NPH = 19;
struct Args { const float* in[26]; float* out; unsigned char* ws; int ph_lo, ph_hi; int use_bar, bar_region; int skip_epi, pad2; };

__global__ void __launch_bounds__(NWAVES * 64, 2) fwd(Args args) {
    extern __shared__ __attribute__((aligned(16))) unsigned char lds_raw[];
    Frame F;
    F.lds = (LAS unsigned char*)lds_raw;
    F.tid = threadIdx.x; F.lane = F.tid & 63; F.wave = __builtin_amdgcn_readfirstlane(F.tid >> 6);
    F.G = gridDim.x; { const int bx = blockIdx.x; F.vcu = (F.G % 8 == 0) ? (bx % 8) * (F.G / 8) + bx / 8 : bx; }
    F.gw = F.vcu * NWAVES + F.wave; F.NGW = F.G * NWAVES;
#pragma unroll
    for (int i = 0; i < 26; ++i) F.in[i] = args.in[i];
    F.out = args.out; F.ws = args.ws;
    volatile LAS unsigned* MISC = (volatile LAS unsigned*)(F.lds + MISC_OFF);
    for (int u = F.tid; u < (LDS_BYTES - RING_BYTES) / 4; u += NWAVES * 64) ((LAS unsigned*)(F.lds + RING_BYTES))[u] = 0u;
    __syncthreads();
    unsigned* ctl = (unsigned*)(args.ws + WS_CTL);
    XcdBarrier bar; bar.bar = ctl + CW_BAR + args.bar_region * XCD_BAR_WORDS; bar.x = 0; bar.st = nullptr;
    if (args.use_bar) bar = xcd_barrier_post(ctl + CW_BAR + args.bar_region * XCD_BAR_WORDS, MISC + 8);
    const int lo = args.ph_lo, hi = args.ph_hi;
#ifdef PROBE_CLOCK
    const long long ck0 = clock64(); const long long wk0 = wall_clock64();
#endif
#ifndef PH_MASK
#define PH_MASK 0xffffffffu
#endif
#define IN(k) (((PH_MASK >> (k)) & 1u) && lo <= (k) && (k) < hi)
#define SEAM(k) do { if (IN(k) && IN((k) + 1)) xcd_barrier(bar); } while (0)
    bf16* const H = (bf16*)(F.ws + WS_H); bf16* const CAT = (bf16*)(F.ws + WS_CAT); bf16* const Y = (bf16*)(F.ws + WS_Y); bf16* const BIG = (bf16*)(F.ws + WS_BIG);

    if (IN(0)) { p0_prologue(F); SEAM(0); }
    if (IN(1)) { p1_modulate(F); SEAM(1); }
    if (IN(2)) {
#if EIN_I8
        pg8::Gemm g{F.ws + WS_H8, F.ws + WS_WEIN, DM, DM, DM, (const float*)(F.ws + WS_SRS)}; pg8::DenseOrder S; S.init(MT / 256, E_IN / 256, F.G, blockIdx.x, 256, DM);
        EpiRope E{BIG, E_IN, (const float*)(F.ws + WS_ROPE)}; pg8::gemm_phase<3>(F.lds, g, S, E); SEAM(2); }
#else
        pg8::Gemm g{H, F.ws + WS_WEIN, DM * 2, DM * 2, DM * 2}; pg8::DenseOrder S; S.init(MT / 256, E_IN / 256, F.G, blockIdx.x, 256, DM * 2);
        EpiRope E{BIG, E_IN, (const float*)(F.ws + WS_ROPE)}; pg8::gemm_phase<false>(F.lds, g, S, E); SEAM(2); }
#endif
    if (IN(3)) { p3_rope_conv(F); SEAM(3); }
    if (IN(4)) { p4_diff_attn(F); SEAM(4); }
    if (IN(5)) {
        pg8::Gemm g{CAT, F.ws + WS_WEO, DM * 2, DM * 2, DM * 2}; pg8::DenseOrder S; S.init(ML / 256, DM / 256, F.G, blockIdx.x, 256, DM * 2);
        EpiPlain E{Y, DM, 1.f}; pg8::gemm_phase<false>(F.lds, g, S, E); SEAM(5); }
    if (IN(6)) {
        if (F.vcu < 64) { pg8::Gemm g{CAT, F.ws + WS_WEO, DM * 2, DM * 2, DM * 2}; CtxOrder S{F.vcu, (unsigned long long)256 * DM * 2};
            EpiPlain E{Y, DM, 1.f}; pg8::gemm_phase<false>(F.lds, g, S, E); }
        ln_phase<6>(F, 0, ML, 64);
        xcd_barrier(bar);
        ln_phase<6, true>(F, ML, MT, 0); SEAM(6); }
#if FFN_FP8 == 3
    if (IN(7)) {
        pg8::Gemm g{F.ws + WS_H8, F.ws + WS_WGU, DM, DM, DM}; pg8::DenseOrder S; S.init(MT / 256, 2 * FF / 256, F.G, blockIdx.x, 128, DM);
        EpiSwigluI8<false> E{F.ws + WS_BIG, FF, (const float*)(F.ws + WS_SRS)}; pg8::gemm_phase<2>(F.lds, g, S, E); SEAM(7); }
#elif FFN_FP8 == 1
    if (IN(7)) {
        pg8::Gemm g{F.ws + WS_H8, F.ws + WS_WGU, DM, DM, DM}; pg8::DenseOrder S; S.init(MT / 256, 2 * FF / 256, F.G, blockIdx.x, 128, DM);
        EpiSwiglu8 E{F.ws + WS_BIG, FF, 1.f / (S_ACT * S_WGU)}; pg8::gemm_phase<true>(F.lds, g, S, E); SEAM(7); }
#elif FFN_FP8 == 2
    if (IN(7)) {
        pg8::Gemm g{H, F.ws + WS_WGU, DM * 2, DM * 2, DM * 2}; pg8::DenseOrder S; S.init(MT / 256, 2 * FF / 256, F.G, blockIdx.x, 128, DM * 2);
        EpiSwiglu8 E{F.ws + WS_BIG, FF, 1.f}; pg8::gemm_phase<false>(F.lds, g, S, E); SEAM(7); }
#else
    if (IN(7)) {
        pg8::Gemm g{H, F.ws + WS_WGU, DM * 2, DM * 2, DM * 2}; pg8::DenseOrder S; S.init(MT / 256, 2 * FF / 256, F.G, blockIdx.x, 128, DM * 2);
        EpiSwiglu E{BIG, FF}; pg8::gemm_phase<false>(F.lds, g, S, E); SEAM(7); }
#endif
#if FFN_FP8
    if (IN(8)) {
        pg8::Gemm g{F.ws + WS_BIG, F.ws + WS_WDN, FF, FF, FF}; pg8::DenseOrder S; S.init(ML / 256, DM / 256, F.G, blockIdx.x, 256, FF);
        EpiPlain E{Y, DM, 1.f / (S_HID * S_WDN)}; pg8::gemm_phase<true>(F.lds, g, S, E); SEAM(8); }
    if (IN(9)) {
        if (F.vcu < 64) { pg8::Gemm g{F.ws + WS_BIG, F.ws + WS_WDN, FF, FF, FF}; CtxOrder S{F.vcu, (unsigned long long)256 * FF};
            EpiPlain E{Y, DM, 1.f / (S_HID * S_WDN)}; pg8::gemm_phase<true>(F.lds, g, S, E); }
        ln_phase<9>(F, 0, ML, 64);
        xcd_barrier(bar);
        ln_phase<9, true>(F, ML, MT, 0); SEAM(9); }
#else
    if (IN(8)) {
        pg8::Gemm g{BIG, F.ws + WS_WDN, FF * 2, FF * 2, FF * 2}; pg8::DenseOrder S; S.init(ML / 256, DM / 256, F.G, blockIdx.x, 256, FF * 2);
        EpiPlain E{Y, DM, 1.f}; pg8::gemm_phase<false>(F.lds, g, S, E); SEAM(8); }
    if (IN(9)) {
        if (F.vcu < 64) { pg8::Gemm g{BIG, F.ws + WS_WDN, FF * 2, FF * 2, FF * 2}; CtxOrder S{F.vcu, (unsigned long long)256 * FF * 2};
            EpiPlain E{Y, DM, 1.f}; pg8::gemm_phase<false>(F.lds, g, S, E); }
        ln_phase<9>(F, 0, ML, 64);
        xcd_barrier(bar);
        ln_phase<9, true>(F, ML, MT, 0); SEAM(9); }
#endif
    if (IN(10)) {
#if OIN_I8
        pg8::Gemm g{F.ws + WS_H8, F.ws + WS_WOIN, DM, DM, DM, (const float*)(F.ws + WS_SRS)}; pg8::DenseOrder S; S.init(MT / 256, O_IN / 256, F.G, blockIdx.x, 256, DM);
        EpiPlain E{BIG, O_IN, 1.f, 0, 2, 4}; pg8::gemm_phase<3>(F.lds, g, S, E); SEAM(10); }
#else
        pg8::Gemm g{H, F.ws + WS_WOIN, DM * 2, DM * 2, DM * 2}; pg8::DenseOrder S; S.init(MT / 256, O_IN / 256, F.G, blockIdx.x, 256, DM * 2);
        EpiPlain E{BIG, O_IN, 1.f, 0, 2, 4}; pg8::gemm_phase<false>(F.lds, g, S, E); SEAM(10); }
#endif
    if (IN(11)) { p11_na_attn(F); SEAM(11); }
    if (IN(12)) {
        pg8::Gemm g{F.ws + WS_DFTC, BIG, 256 * 2, O_IN * 2, 256 * 2}; DftCOrder S{F.G, (int)blockIdx.x};
        EpiDftC E{Y, (const float*)(F.ws + WS_GN)}; pg8::gemm_phase<false>(F.lds, g, S, E); SEAM(12); }
    if (IN(13)) {
#if DFTL_I8
        pg8::Gemm g{F.ws + WS_DFTL, Y, 4096, 4096, 4096, nullptr, 1.f / (127.f * S_PQ)}; DftLOrder S{F.G, F.vcu};
        EpiPlain E{CAT, DM, 1.f / 512.f}; pg8::gemm_phase<4>(F.lds, g, S, E); SEAM(13); }
#else
        pg8::Gemm g{F.ws + WS_DFTL, Y, 4096 * 2, 4096 * 2, 4096 * 2}; DftLOrder S{F.G, F.vcu};
        EpiPlain E{CAT, DM, 1.f / 512.f}; pg8::gemm_phase<false>(F.lds, g, S, E); SEAM(13); }
#endif
    if (IN(14)) {
        pg8::Gemm g{CAT, F.ws + WS_WOO, DM * 2, DM * 2, DM * 2}; pg8::DenseOrder S; S.init(ML / 256, DM / 256, F.G, blockIdx.x, 256, DM * 2);
        EpiPlain E{Y, DM, 1.f}; pg8::gemm_phase<false>(F.lds, g, S, E);
        SEAM(14); }
    if (IN(15)) { ln_phase<15>(F, 0, ML, 0); SEAM(15); }
    if (IN(16)) {
        pg8::Gemm g{F.ws + WS_H8, F.ws + WS_EWGU, DM, DM, DM}; MoeOrderT<1> S; S.init((const unsigned*)ctl + CW_CNT, 2 * FFE / 256, F.G, blockIdx.x, 1, (const int*)(F.ws + WS_LIST), DM, 128);
#ifdef PROBE_FLATB
        if (args.skip_epi == 3) S.bstep = 0;
#endif
        EpiSwigluI8<true> E{F.ws + WS_BIG, FFE, (const float*)(F.ws + WS_SRS)}; pg8::gemm_phase<2>(F.lds, g, S, E); SEAM(16); }
    if (IN(17)) {
        pg8::Gemm g{F.ws + WS_BIG, F.ws + WS_EWDN, FFE, FFE, FFE}; MoeOrderT<0> S; S.init((const unsigned*)ctl + CW_CNT, DM / 256, F.G, blockIdx.x, 0, nullptr, FFE, 256);
        S.split = 1;
        EpiPlain E{(bf16*)(F.ws + WS_YS), DM, 1.f / (S_HID * S_WDN)}; pg8::gemm_phase_<1, true>(F.lds, g, S, E); SEAM(17); }
    if (IN(NPH - 1)) { ln_phase<24>(F, 0, ML, 0); }
#ifdef PROBE_CLOCK
    {
        xcd_barrier(bar);
        if (blockIdx.x == 0) {
            const long long ck1 = clock64(); const long long wk1 = wall_clock64();
            const float mhz = (float)(ck1 - ck0) / (float)(wk1 - wk0) * 100.f;
            const float cval = sqrtf(10.f * floorf(mhz / 250.f + 0.5f));
            for (size_t i = F.tid; i < (size_t)ML * DM; i += 512) F.out[i] = cval;
        }
    }
#endif
#undef IN
#undef SEAM
}

extern "C" void kernel_launch(void* const* d_in, const int* in_sizes, int n_in, void* d_out, int out_size, void* d_ws, size_t ws_size, hipStream_t stream) {
    static int grid = 0;
    if (grid == 0) {
        if (n_in != 26 || out_size != ML * DM || ws_size < WS_BT + 2 * MiB) { fprintf(stderr, "kernel_launch: unexpected problem (n_in %d out %d ws %zu)\n", n_in, out_size, ws_size); grid = -1; return; }
        int dev = 0, cus = 0;
        if (hipGetDevice(&dev) != hipSuccess || hipDeviceGetAttribute(&cus, hipDeviceAttributeMultiprocessorCount, dev) != hipSuccess) { grid = -1; return; }
        if (hipFuncSetAttribute((const void*)fwd, hipFuncAttributeMaxDynamicSharedMemorySize, LDS_BYTES) != hipSuccess) { grid = -1; return; }
        grid = cus;
    }
    if (grid < 0) return;
    (void)hipMemsetAsync((char*)d_ws + WS_CTL, 0, CTL_ZERO_BYTES, stream);
    Args a{};
    for (int i = 0; i < 26; ++i) a.in[i] = (const float*)d_in[i];
    a.out = (float*)d_out; a.ws = (unsigned char*)d_ws;
#if MK_LAUNCH_PER_PHASE
    a.use_bar = 1;
    for (int ph = 0; ph < NPH; ++ph) { a.ph_lo = ph; a.ph_hi = ph + 1; a.bar_region = ph; hipLaunchKernelGGL(fwd, dim3(grid), dim3(NWAVES * 64), LDS_BYTES, stream, a); }
#elif defined(PROBE_REPEAT)
    a.use_bar = 1; a.ph_lo = 0; a.ph_hi = PROBE_REPEAT; a.bar_region = 0;
    if (PROBE_REPEAT > 0) hipLaunchKernelGGL(fwd, dim3(grid), dim3(NWAVES * 64), LDS_BYTES, stream, a);
    a.ph_lo = PROBE_REPEAT; a.ph_hi = PROBE_REPEAT + 1; a.bar_region = 2;
#ifdef PROBE_SKIP_EPI
    a.skip_epi = 1;
#endif
#ifdef PROBE_FLAT
    a.skip_epi = 2;
#endif
#ifdef PROBE_FLATB
    a.skip_epi = 3;
#endif
    hipLaunchKernelGGL(fwd, dim3(grid), dim3(NWAVES * 64), LDS_BYTES, stream, a);
    a.skip_epi = 0;
    a.ph_lo = PROBE_REPEAT; a.ph_hi = NPH; a.bar_region = 1;
    hipLaunchKernelGGL(fwd, dim3(grid), dim3(NWAVES * 64), LDS_BYTES, stream, a);
#else
    a.use_bar = 1; a.ph_lo = 0; a.ph_hi = NPH;
    hipLaunchKernelGGL(fwd, dim3(grid), dim3(NWAVES * 64), LDS_BYTES, stream, a);
#endif
}
```
